# Optimizing an MI355X kernel written in HIP

```python
import math
import jax, jax.numpy as jnp
from jax import lax
import numpy as np

D_MODEL = 2048
BATCH = 16
SEQ = 2048
DEPTH = 2

D_MIX = D_MODEL
DA_WIDTH = D_MIX // 2
DA_HEADS = 8
DA_HEAD_V = DA_WIDTH // DA_HEADS
DA_HEAD_QK = DA_HEAD_V // 2
GLA_WIDTH = D_MIX - DA_WIDTH
GLA_HEADS = 4
GLA_KEY_DIM = GLA_WIDTH // 2
GLA_HEAD_K = GLA_KEY_DIM // GLA_HEADS
GLA_HEAD_V = GLA_WIDTH // GLA_HEADS
GLA_GATE_RANK = 16
GLA_GATE_NORMALIZER = 16.0
GLA_CHUNK = 64
Q_BLOCK = 128
D_FF = ((8 * D_MODEL // 3 + 255) // 256) * 256
CONV_WIDTH = 3
NORM_EPS = 1e-6
N_MOD = 6
PROJ_SIZES = (DA_WIDTH, DA_WIDTH, DA_WIDTH,
              GLA_KEY_DIM, GLA_KEY_DIM, GLA_WIDTH,
              GLA_WIDTH, GLA_GATE_RANK)
N_PROJ = sum(PROJ_SIZES)
PROJ_SPLITS = tuple(int(s) for s in np.cumsum(PROJ_SIZES)[:-1])

kernel_name = "hybrid_diffattn_gla_convffn_adaln"


def _alibi_slopes(n):
    start = 2.0 ** (-8.0 / n)
    return np.array([start ** (i + 1) for i in range(n)], dtype=np.float32)


def _lambda_init(layer_idx):
    return 0.8 - 0.6 * math.exp(-0.3 * layer_idx)


def rms_norm(x, g):
    xf = x.astype(jnp.float32)
    y = xf * lax.rsqrt(jnp.mean(xf * xf, axis=-1, keepdims=True) + NORM_EPS)
    return (y * g.astype(jnp.float32)).astype(x.dtype)


def diff_attention(q, k, v, lam, slopes):
    T = q.shape[3]
    scale = DA_HEAD_QK ** -0.5
    outs = []
    for i in range(T // Q_BLOCK):
        q0, q1 = i * Q_BLOCK, (i + 1) * Q_BLOCK
        qb = q[:, :, :, q0:q1]
        kb = k[:, :, :, :q1]
        vb = v[:, :, :q1]
        s = jnp.einsum('bhmqd,bhmkd->bhmqk', qb, kb).astype(jnp.float32) * scale
        dist = (jnp.arange(q0, q1)[:, None] - jnp.arange(q1)[None, :]).astype(jnp.float32)
        bias = jnp.where(dist[None] >= 0, -slopes[:, None, None] * dist[None], -jnp.inf)
        p = jax.nn.softmax(s + bias[None, :, None], axis=-1)
        pd = p[:, :, 0] - lam * p[:, :, 1]
        outs.append(jnp.einsum('bhqk,bhkd->bhqd', pd.astype(vb.dtype), vb))
    return jnp.concatenate(outs, axis=2)


def gla_chunked(q, k, v, log_a):
    B, H, T, dk = q.shape
    dv = v.shape[-1]
    nc = T // GLA_CHUNK

    def to_chunks(a):
        return jnp.moveaxis(a.reshape(B, H, nc, GLA_CHUNK, a.shape[-1]), 2, 0)

    qc, kc, vc = (to_chunks(a.astype(jnp.float32)) for a in (q, k, v))
    bc = jnp.cumsum(to_chunks(log_a.astype(jnp.float32)), axis=-2)
    causal = jnp.tril(jnp.ones((GLA_CHUNK, GLA_CHUNK), dtype=bool))

    def step(S, inp):
        qi, ki, vi, bi = inp
        diff = bi[:, :, :, None, :] - bi[:, :, None, :, :]
        decay = jnp.exp(jnp.where(causal[None, None, :, :, None], diff, -jnp.inf))
        A = jnp.einsum('bhtsd,bhsd->bhts', qi[:, :, :, None, :] * decay, ki)
        o = jnp.einsum('bhts,bhsv->bhtv', A, vi) \
            + jnp.einsum('bhtd,bhdv->bhtv', qi * jnp.exp(bi), S)
        b_last = bi[:, :, -1:, :]
        S_new = jnp.exp(b_last[:, :, 0, :])[..., None] * S \
            + jnp.einsum('bhsd,bhsv->bhdv', ki * jnp.exp(b_last - bi), vi)
        return S_new, o

    S0 = jnp.zeros((B, H, dk, dv), jnp.float32)
    _, oc = lax.scan(step, S0, (qc, kc, vc, bc))
    return jnp.moveaxis(oc, 0, 2).reshape(B, H, T, dv)


def causal_dwconv(x, w, b):
    T = x.shape[1]
    xp = jnp.pad(x, ((0, 0), (CONV_WIDTH - 1, 0), (0, 0)))
    y = b.astype(x.dtype)
    for j in range(CONV_WIDTH):
        y = y + xp[:, j:j + T] * w[j].astype(x.dtype)
    return y


def setup_inputs(seed: int = 0) -> dict:
    key = jax.random.key(seed)
    ks = jax.random.split(key, 20)
    n = jax.random.normal
    f = jnp.float32
    return {
        "x": n(ks[0], (BATCH, SEQ, D_MODEL), f),
        "c": n(ks[1], (BATCH, D_MODEL), f),
        "w_ada": n(ks[2], (DEPTH, D_MODEL, N_MOD * D_MODEL), f) * D_MODEL ** -0.5,
        "b_ada": n(ks[3], (DEPTH, N_MOD * D_MODEL), f) * 0.02,
        "g_mix_norm": 1.0 + 0.02 * n(ks[4], (DEPTH, D_MODEL), f),
        "w_in": n(ks[5], (DEPTH, D_MODEL, N_PROJ), f) * D_MODEL ** -0.5,
        "diff_lambda": 0.1 * n(ks[6], (DEPTH, 4, DA_HEAD_QK), f),
        "g_diff_subln": 1.0 + 0.02 * n(ks[7], (DEPTH, DA_HEAD_V), f),
        "w_gk_up": n(ks[8], (DEPTH, GLA_GATE_RANK, GLA_KEY_DIM), f) * GLA_GATE_RANK ** -0.5,
        "b_gk": 0.02 * n(ks[9], (DEPTH, GLA_KEY_DIM), f),
        "g_gla_norm": 1.0 + 0.02 * n(ks[10], (DEPTH, GLA_HEAD_V), f),
        "w_o": n(ks[11], (DEPTH, D_MIX, D_MODEL), f) * D_MIX ** -0.5,
        "g_ffn_norm": 1.0 + 0.02 * n(ks[12], (DEPTH, D_MODEL), f),
        "w_up": n(ks[13], (DEPTH, D_MODEL, 2 * D_FF), f) * D_MODEL ** -0.5,
        "w_conv": n(ks[14], (DEPTH, CONV_WIDTH, D_FF), f) * CONV_WIDTH ** -0.5,
        "b_conv": 0.02 * n(ks[15], (DEPTH, D_FF), f),
        "w_down": n(ks[16], (DEPTH, D_FF, D_MODEL), f) * D_FF ** -0.5,
        "g_final": 1.0 + 0.02 * n(ks[17], (D_MODEL,), f),
    }


def reference(x, c, w_ada, b_ada, g_mix_norm, w_in, diff_lambda, g_diff_subln, w_gk_up, b_gk,
              g_gla_norm, w_o, g_ffn_norm, w_up, w_conv, b_conv, w_down, g_final):
    B, T, _ = x.shape
    slopes = jnp.asarray(_alibi_slopes(DA_HEADS))
    c_act = jax.nn.silu(c)
    for l in range(DEPTH):
        mod = (c_act @ w_ada[l] + b_ada[l])[:, None, :]
        sh1, sc1, gt1, sh2, sc2, gt2 = jnp.split(mod, N_MOD, axis=-1)

        h = rms_norm(x, g_mix_norm[l]) * (1.0 + sc1) + sh1
        proj = h @ w_in[l]
        dq, dk, dv, gq, gk, gv, gg, g_low = jnp.split(proj, PROJ_SPLITS, axis=-1)

        lam_init = _lambda_init(l)
        lq1, lk1, lq2, lk2 = (diff_lambda[l, i].astype(jnp.float32) for i in range(4))
        lam = jnp.exp(jnp.sum(lq1 * lk1)) - jnp.exp(jnp.sum(lq2 * lk2)) + lam_init
        qd = dq.reshape(B, T, DA_HEADS, 2, DA_HEAD_QK).transpose(0, 2, 3, 1, 4)
        kd = dk.reshape(B, T, DA_HEADS, 2, DA_HEAD_QK).transpose(0, 2, 3, 1, 4)
        vd = dv.reshape(B, T, DA_HEADS, DA_HEAD_V).transpose(0, 2, 1, 3)
        od = diff_attention(qd, kd, vd, lam, slopes)
        od = rms_norm(od, g_diff_subln[l]) * (1.0 - lam_init)
        od = od.transpose(0, 2, 1, 3).reshape(B, T, DA_WIDTH)

        log_a = jax.nn.log_sigmoid((g_low @ w_gk_up[l] + b_gk[l]).astype(jnp.float32)) / GLA_GATE_NORMALIZER
        qg = (gq * GLA_HEAD_K ** -0.5).reshape(B, T, GLA_HEADS, GLA_HEAD_K).transpose(0, 2, 1, 3)
        kg = gk.reshape(B, T, GLA_HEADS, GLA_HEAD_K).transpose(0, 2, 1, 3)
        vg = gv.reshape(B, T, GLA_HEADS, GLA_HEAD_V).transpose(0, 2, 1, 3)
        ag = log_a.reshape(B, T, GLA_HEADS, GLA_HEAD_K).transpose(0, 2, 1, 3)
        og = gla_chunked(qg, kg, vg, ag).astype(x.dtype).transpose(0, 2, 1, 3)
        og = rms_norm(og, g_gla_norm[l]) * jax.nn.silu(gg.reshape(B, T, GLA_HEADS, GLA_HEAD_V))
        og = og.reshape(B, T, GLA_WIDTH)

        mix = jnp.concatenate([od, og], axis=-1) @ w_o[l]
        x = x + gt1 * mix

        h2 = rms_norm(x, g_ffn_norm[l]) * (1.0 + sc2) + sh2
        u, g = jnp.split(h2 @ w_up[l], 2, axis=-1)
        act = jax.nn.gelu(causal_dwconv(g, w_conv[l], b_conv[l]), approximate=False) * u
        x = x + gt2 * (act @ w_down[l])
    return rms_norm(x, g_final)
```

```cpp
#include <hip/hip_runtime.h>
#include <cstdio>
#include <cstdint>
namespace pg8 {
#define PG8_LAS __attribute__((address_space(3)))
typedef unsigned short bf16_t;
typedef short bf16x8 __attribute__((ext_vector_type(8)));
typedef float f32x4 __attribute__((ext_vector_type(4)));
typedef unsigned u32x4 __attribute__((ext_vector_type(4)));
constexpr int BM = 256, BK = 64, HALF = 128, HTB = HALF * BK * 2  , STAGE_BYTES = 8 * HTB, NXCD = 8, WGM = 8;

__host__ __device__ __forceinline__ int lds_byte(int r, int c) { const int st = (r >> 4) * 2 + (c >> 5), rr = r & 15, cc = c & 31, ob = rr * 64 + cc * 2; return st * 1024 + (ob ^ (((ob >> 9) & 1) << 5)); }
__host__ __device__ __forceinline__ void stage_rc(int b, int& R, int& C) { const int st = b / 1024, sb = b % 1024, swz = sb ^ (((sb >> 9) & 1) << 5); R = (st >> 1) * 16 + swz / 64; C = (st & 1) * 32 + (swz % 64) / 2; }
__host__ __device__ __forceinline__ int perm32(int rho) { const int n = rho >> 4, i = rho & 15; return 8 * (i >> 2) + 4 * n + (i & 3); }

struct Unit { int pm, pn; };
struct Gemm { const bf16_t* A; const bf16_t* Bt; int M, N, K; };

struct StaticOrder {
    int nM, nN, nwg, G, c;
    __host__ __device__ void init(int M, int N, int G_, int c_) { nM = M / BM; nN = N / BM; nwg = nM * nN; G = G_; c = c_; }
    __host__ __device__ bool next(int i, Unit& u) const {
        const long L = (long)i * G + c; if (L >= nwg) return false;
        int wgid = (int)L; { const int q = nwg / NXCD, r = nwg % NXCD, xcd = wgid % NXCD, off = wgid / NXCD; wgid = (xcd < r ? xcd * (q + 1) : r * (q + 1) + (xcd - r) * q) + off; }
        const int nig = WGM * nN, gid = wgid / nig, fm = gid * WGM, gsz = (nM - fm) < WGM ? (nM - fm) : WGM;
        u.pm = fm + ((wgid % nig) % gsz); u.pn = (wgid % nig) / gsz; return true;
    }
    __device__ __forceinline__ void a_ready(const Unit&) const {}
    __device__ __forceinline__ void done(const Unit&) const {}
};

__device__ __forceinline__ unsigned cvt_pk_bf16(float lo, float hi) { unsigned r; asm volatile("v_cvt_pk_bf16_f32 %0, %1, %2" : "=v"(r) : "v"(lo), "v"(hi)); return r; }
typedef float f32x2 __attribute__((ext_vector_type(2)));
__device__ __forceinline__ f32x2 gelu_pk(f32x2 v) {
    const f32x2 av = __builtin_elementwise_abs(v), d = av * 0.2316418882f + 1.0f;
    f32x2 t; t.x = __builtin_amdgcn_rcpf(d.x); t.y = __builtin_amdgcn_rcpf(d.y);
    f32x2 q = t * 0.5307027145f + (-0.7265760135f); q = q * t + 0.7107068705f; q = q * t + (-0.142248368f); q = q * t + 0.127414796f; q = q * t;
    const f32x2 s = (v * v) * (-0.72134752044f);
    f32x2 e; e.x = __builtin_amdgcn_exp2f(s.x); e.y = __builtin_amdgcn_exp2f(s.y);
    const f32x2 m = v * (q * e), r = v - m;
    f32x2 o; o.x = v.x < 0.f ? m.x : r.x; o.y = v.y < 0.f ? m.y : r.y; return o;
}

constexpr float QSCALE = 0.125f * 1.4426950408889634f;
constexpr float GQSCALE = 0.08838834764831845f;
constexpr int NPW = 6656;

struct EpiProj {
    static constexpr bool PERM = true, AFTER_DRAIN = false;
    bf16_t* O; const float* bgk;
    __device__ __forceinline__ void operator()(const f32x4 (&acc)[2][2][4][2], const Unit& u, int wr, int wc, int fr, int fq) const {
        const int row0 = u.pm * BM + wr * 64 + fr, col0 = u.pn * BM + wc * 32 + 8 * fq, pn = u.pn;
        int mode = 0; float sc = 1.f;
        if (pn < 4) sc = QSCALE; else if (pn >= 12 && pn < 14) sc = GQSCALE; else if (pn >= 20 && pn < 24) mode = 1; else if (pn >= 24) mode = 2;
        f32x4 bv[2][2];
#pragma unroll
        for (int bj = 0; bj < 2; ++bj)
#pragma unroll
            for (int n = 0; n < 2; ++n) bv[bj][n] = (mode == 2) ? *(const f32x4*)(bgk + (col0 - 6144) + bj * HALF + 4 * n) : (f32x4){0.f, 0.f, 0.f, 0.f};
#pragma unroll
        for (int ai = 0; ai < 2; ++ai)
#pragma unroll
            for (int m = 0; m < 4; ++m) { bf16_t* rowp = O + (size_t)(row0 + ai * HALF + m * 16) * NPW + col0;
#pragma unroll
                for (int bj = 0; bj < 2; ++bj) { f32x4 v0 = acc[ai][bj][m][0] + bv[bj][0], v1 = acc[ai][bj][m][1] + bv[bj][1];
                    if (mode == 0) { v0 = v0 * sc; v1 = v1 * sc; }
                    else if (mode == 1) {
#pragma unroll
                        for (int e = 0; e < 4; ++e) { v0[e] = v0[e] * __builtin_amdgcn_rcpf(1.f + __builtin_amdgcn_exp2f(-1.4426950408889634f * v0[e])); v1[e] = v1[e] * __builtin_amdgcn_rcpf(1.f + __builtin_amdgcn_exp2f(-1.4426950408889634f * v1[e])); }
                    } else {
#pragma unroll
                        for (int e = 0; e < 4; ++e) {
                            { const float x = v0[e], ax = __builtin_fabsf(x); v0[e] = (__builtin_fminf(x, 0.f) - 0.6931471805599453f * __builtin_amdgcn_logf(1.f + __builtin_amdgcn_exp2f(-1.4426950408889634f * ax))) * 0.0625f; }
                            { const float x = v1[e], ax = __builtin_fabsf(x); v1[e] = (__builtin_fminf(x, 0.f) - 0.6931471805599453f * __builtin_amdgcn_logf(1.f + __builtin_amdgcn_exp2f(-1.4426950408889634f * ax))) * 0.0625f; } }
                    }
                    u32x4 w; w.x = cvt_pk_bf16(v0[0], v0[1]); w.y = cvt_pk_bf16(v0[2], v0[3]); w.z = cvt_pk_bf16(v1[0], v1[1]); w.w = cvt_pk_bf16(v1[2], v1[3]);
                    *(u32x4*)(rowp + bj * HALF) = w; } }
    }
};

struct EpiRes {
    static constexpr bool PERM = false, AFTER_DRAIN = false;
    const float* xin; float* out; const float* gate; float gs;
    __device__ __forceinline__ void operator()(const f32x4 (&acc)[2][2][4][2], const Unit& u, int wr, int wc, int fr, int fq) const {
        const int col0 = u.pn * BM + wc * 32 + 4 * fq; const float* g = gate + (size_t)(u.pm >> 3) * 12288;
        f32x4 gv[2][2];
#pragma unroll
        for (int bj = 0; bj < 2; ++bj)
#pragma unroll
            for (int n = 0; n < 2; ++n) gv[bj][n] = *(const f32x4*)(g + col0 + bj * HALF + n * 16) * gs;
#pragma unroll
        for (int ai = 0; ai < 2; ++ai)
#pragma unroll
            for (int m = 0; m < 4; ++m) { const size_t off = (size_t)(u.pm * BM + ai * HALF + wr * 64 + m * 16 + fr) * 2048 + col0;
#pragma unroll
                for (int bj = 0; bj < 2; ++bj)
#pragma unroll
                    for (int n = 0; n < 2; ++n) { const f32x4 xi = *(const f32x4*)(xin + off + bj * HALF + n * 16); *(f32x4*)(out + off + bj * HALF + n * 16) = xi + gv[bj][n] * acc[ai][bj][m][n]; }
                if (m & 1) asm volatile("" ::: "memory"); }
    }
};

__device__ __forceinline__ float dpp_shr1(float oldv, float src) { return __builtin_bit_cast(float, __builtin_amdgcn_update_dpp(__builtin_bit_cast(int, oldv), __builtin_bit_cast(int, src), 0x111, 0xF, 0xF, false)); }
__device__ __forceinline__ float dpp_shr2(float oldv, float src) { return __builtin_bit_cast(float, __builtin_amdgcn_update_dpp(__builtin_bit_cast(int, oldv), __builtin_bit_cast(int, src), 0x112, 0xF, 0xF, false)); }
__device__ __forceinline__ float dpp_ror1(float src) { return __builtin_bit_cast(float, __builtin_amdgcn_update_dpp(0, __builtin_bit_cast(int, src), 0x121, 0xF, 0xF, false)); }
__device__ __forceinline__ float dpp_ror2(float src) { return __builtin_bit_cast(float, __builtin_amdgcn_update_dpp(0, __builtin_bit_cast(int, src), 0x122, 0xF, 0xF, false)); }
struct EpiUp {
    static constexpr bool PERM = true, AFTER_DRAIN = false;
    bf16_t* act; const float* wconv; const float* bconv; float* glast; float* gfirst; float* ufirst; PG8_LAS float* bnd;
    __device__ __forceinline__ void operator()(const f32x4 (&acc)[2][2][4][2], const Unit& u, int wr, int wc, int fr, int fq) const {
        const int cl = wc * 32 + 8 * fq, c0 = u.pn * 128 + cl;
        f32x4 w0[2], w1[2], w2[2], cb[2];
#pragma unroll
        for (int n = 0; n < 2; ++n) { w0[n] = *(const f32x4*)(wconv + c0 + 4 * n); w1[n] = *(const f32x4*)(wconv + 5632 + c0 + 4 * n); w2[n] = *(const f32x4*)(wconv + 2 * 5632 + c0 + 4 * n); cb[n] = *(const f32x4*)(bconv + c0 + 4 * n); }
        if (fr >= 14) {
#pragma unroll
            for (int ai = 0; ai < 2; ++ai)
#pragma unroll
                for (int n = 0; n < 2; ++n) *(PG8_LAS f32x4*)(bnd + ((2 * ai + wr) * 2 + (fr - 14)) * 128 + cl + 4 * n) = acc[ai][1][3][n];
            if (wr == 1) {
#pragma unroll
                for (int n = 0; n < 2; ++n) *(f32x4*)(glast + ((size_t)u.pm * 2 + (fr - 14)) * 5632 + c0 + 4 * n) = acc[1][1][3][n]; }
        }
        if (wr == 0 && fr < 2) {
#pragma unroll
            for (int n = 0; n < 2; ++n) { *(f32x4*)(gfirst + ((size_t)u.pm * 2 + fr) * 5632 + c0 + 4 * n) = acc[0][1][0][n]; *(f32x4*)(ufirst + ((size_t)u.pm * 2 + fr) * 5632 + c0 + 4 * n) = acc[0][0][0][n]; }
        }
        asm volatile("s_waitcnt lgkmcnt(0)" ::: "memory"); __builtin_amdgcn_s_barrier(); asm volatile("" ::: "memory");
#pragma unroll
        for (int ai = 0; ai < 2; ++ai) {
            const int bp = 2 * ai + wr - 1;
            f32x4 h1[2], h2[2];
#pragma unroll
            for (int n = 0; n < 2; ++n) { if (bp >= 0) { h1[n] = *(const PG8_LAS f32x4*)(bnd + (bp * 2 + 1) * 128 + cl + 4 * n); h2[n] = *(const PG8_LAS f32x4*)(bnd + (bp * 2 + 0) * 128 + cl + 4 * n); } else { h1[n] = (f32x4){0.f, 0.f, 0.f, 0.f}; h2[n] = (f32x4){0.f, 0.f, 0.f, 0.f}; } }
#pragma unroll
            for (int m = 0; m < 4; ++m) {
                unsigned pk[4];
#pragma unroll
                for (int n = 0; n < 2; ++n) {
                    float a[4];
#pragma unroll
                    for (int e = 0; e < 4; ++e) {
                        const float cur = acc[ai][1][m][n][e]; float o1, o2;
                        if (m == 0) { o1 = h1[n][e]; o2 = (fr == 0) ? h2[n][e] : h1[n][e]; }
                        else { o1 = dpp_ror1(acc[ai][1][m - 1][n][e]); o2 = dpp_ror2(acc[ai][1][m - 1][n][e]); }
                        const float g1 = dpp_shr1(o1, cur), g2 = dpp_shr2(o2, cur);
                        a[e] = w0[n][e] * g2 + w1[n][e] * g1 + w2[n][e] * cur + cb[n][e];
                    }
                    const f32x2 ga = gelu_pk((f32x2){a[0], a[1]}), gb = gelu_pk((f32x2){a[2], a[3]});
                    pk[2 * n] = cvt_pk_bf16(ga.x * acc[ai][0][m][n][0], ga.y * acc[ai][0][m][n][1]); pk[2 * n + 1] = cvt_pk_bf16(gb.x * acc[ai][0][m][n][2], gb.y * acc[ai][0][m][n][3]);
                }
                u32x4 w; w.x = pk[0]; w.y = pk[1]; w.z = pk[2]; w.w = pk[3];
                *(u32x4*)(act + (size_t)(u.pm * BM + ai * HALF + wr * 64 + m * 16 + fr) * 5632 + c0) = w;
                asm volatile("" ::: "memory");
            }
        }
    }
};
template <class Epi, class Sched, bool ALIGN_EPI = false, bool SP2 = false>
__device__ __forceinline__ void gemm_phase(PG8_LAS unsigned char* lds, const Gemm g, const Sched& S, const Epi& E) {
    int tid_o = threadIdx.x; asm volatile("" : "+v"(tid_o));
    const int tid = tid_o, wid = __builtin_amdgcn_readfirstlane(tid >> 6), lane = tid & 63, wr = wid >> 2, wc = wid & 3, fr = lane & 15, fq = lane >> 4;
    const int K = g.K, nt = K / BK;
    unsigned voffA[2], voffB[2];
#pragma unroll
    for (int i = 0; i < 2; ++i) { int R, C; stage_rc(tid * 16 + i * 8192, R, C); const int Rb = Epi::PERM ? ((R & ~31) + perm32(R & 31)) : R;
        voffA[i] = (unsigned)(R * K + C) * 2u; voffB[i] = (unsigned)(Rb * K + C) * 2u; }
    const size_t kstep = (size_t)(BK * 2);
    const size_t hstep = (size_t)HALF * K * 2;
    const size_t tstep = 2 * hstep;
    const unsigned ldsw = (unsigned)wid * 1024u;
    const int aoff = lds_byte(wr * 64 + fr, fq * 8), boff = lds_byte(wc * 32 + fr, fq * 8);
#define PG8_SA(b, h) (((b) * 2 + (h)) * HTB)
#define PG8_SB(b, h) ((4 + (b) * 2 + (h)) * HTB)
#define PG8_STAGE(bufoff, gbase, voff) do { _Pragma("unroll") for (int _i = 0; _i < 2; ++_i) \
        __builtin_amdgcn_global_load_lds((const unsigned*)((const char*)(gbase) + (voff)[_i]), (PG8_LAS unsigned*)(lds + (bufoff) + ldsw + _i * 8192), 16, 0, 0); } while (0)
#define PG8_LDA(dst, b, h) do { _Pragma("unroll") for (int m = 0; m < 4; ++m) _Pragma("unroll") for (int k = 0; k < 2; ++k) dst[m][k] = *(const PG8_LAS bf16x8*)(lds + PG8_SA(b, h) + aoff + m * 2048 + k * 1024); } while (0)
#define PG8_LDB(dst, b, h) do { _Pragma("unroll") for (int n = 0; n < 2; ++n) _Pragma("unroll") for (int k = 0; k < 2; ++k) dst[n][k] = *(const PG8_LAS bf16x8*)(lds + PG8_SB(b, h) + boff + n * 2048 + k * 1024); } while (0)
#define PG8_MMA(ai, bj, At, Bt) do { __builtin_amdgcn_s_setprio(1); _Pragma("unroll") for (int m = 0; m < 4; ++m) _Pragma("unroll") for (int n = 0; n < 2; ++n) _Pragma("unroll") for (int k = 0; k < 2; ++k) \
        acc[ai][bj][m][n] = __builtin_amdgcn_mfma_f32_16x16x32_bf16(Bt[n][k], At[m][k], acc[ai][bj][m][n], 0, 0, 0); __builtin_amdgcn_s_setprio(0); } while (0)
#define PG8_WAIT_V(n) asm volatile("s_waitcnt vmcnt(" #n ")" ::: "memory")
#define PG8_WAIT_L(n) asm volatile("s_waitcnt lgkmcnt(" #n ")" ::: "memory")
#define PG8_BAR __builtin_amdgcn_s_barrier()
#define PG8_SCHED __builtin_amdgcn_sched_barrier(0)
    Unit cur, nxt; int ui = 0;
    if (!S.next(0, cur)) return;
    f32x4 acc[2][2][4][2];
#pragma unroll
    for (int a = 0; a < 2; ++a)
#pragma unroll
        for (int b = 0; b < 2; ++b)
#pragma unroll
            for (int m = 0; m < 4; ++m)
#pragma unroll
                for (int n = 0; n < 2; ++n) acc[a][b][m][n] = (f32x4){0.f, 0.f, 0.f, 0.f};
    bf16x8 At[4][2], B0[2][2], B1[2][2];
    const char* cA = (const char*)g.A + (size_t)cur.pm * tstep; const char* cB = (const char*)g.Bt + (size_t)cur.pn * tstep;
    S.a_ready(cur);
    if constexpr (SP2) {
        PG8_STAGE(PG8_SB(0, 0), cB, voffB); PG8_STAGE(PG8_SB(0, 1), cB + hstep, voffB); PG8_STAGE(PG8_SA(0, 0), cA, voffA); PG8_STAGE(PG8_SA(0, 1), cA + hstep, voffA);
        if (wr == 1) PG8_BAR;
        PG8_WAIT_V(2); PG8_BAR;
        PG8_STAGE(PG8_SB(1, 0), cB + kstep, voffB); PG8_STAGE(PG8_SA(1, 0), cA + kstep, voffA); PG8_STAGE(PG8_SB(1, 1), cB + hstep + kstep, voffB);
        PG8_WAIT_V(6); PG8_BAR;
    } else {
        PG8_STAGE(PG8_SB(0, 0), cB, voffB); PG8_STAGE(PG8_SA(0, 0), cA, voffA); PG8_STAGE(PG8_SB(0, 1), cB + hstep, voffB); PG8_STAGE(PG8_SA(0, 1), cA + hstep, voffA);
        if (wr == 1) PG8_BAR;
        PG8_WAIT_V(4); PG8_BAR;
        PG8_STAGE(PG8_SB(1, 0), cB + kstep, voffB); PG8_STAGE(PG8_SA(1, 0), cA + kstep, voffA); PG8_STAGE(PG8_SB(1, 1), cB + hstep + kstep, voffB);
        PG8_WAIT_V(6); PG8_BAR;
    }
    for (;;) {
        const bool has_next = S.next(ui + 1, nxt);
        const char* nA = has_next ? (const char*)g.A + (size_t)nxt.pm * tstep : cA; const char* nB = has_next ? (const char*)g.Bt + (size_t)nxt.pn * tstep : cB;
        for (int t = 0; t < nt; t += 2) {
            const bool last = (t == nt - 2);
            const char* a1 = cA + (size_t)(t + 1) * kstep;
            const char* a2 = last ? nA : cA + (size_t)(t + 2) * kstep; const char* b2 = last ? nB : cB + (size_t)(t + 2) * kstep;
            const char* a3 = a2 + kstep; const char* b3 = b2 + kstep;
            if (last && has_next) S.a_ready(nxt);
            if constexpr (SP2) {
            PG8_LDB(B0, 0, 0); PG8_LDB(B1, 0, 1); PG8_SCHED; PG8_LDA(At, 0, 0); PG8_STAGE(PG8_SA(1, 1), a1 + hstep, voffA);
            PG8_WAIT_V(8); PG8_WAIT_L(0); PG8_BAR; PG8_MMA(0, 0, At, B0); PG8_MMA(0, 1, At, B1); PG8_BAR; PG8_SCHED;
            PG8_LDA(At, 0, 1); PG8_STAGE(PG8_SB(0, 0), b2, voffB); PG8_STAGE(PG8_SB(0, 1), b2 + hstep, voffB); PG8_STAGE(PG8_SA(0, 0), a2, voffA);
            PG8_WAIT_V(8); PG8_WAIT_L(0); PG8_BAR; PG8_MMA(1, 0, At, B0); PG8_MMA(1, 1, At, B1); PG8_BAR; PG8_SCHED;
            PG8_LDB(B0, 1, 0); PG8_LDB(B1, 1, 1); PG8_SCHED; PG8_LDA(At, 1, 0); PG8_STAGE(PG8_SA(0, 1), a2 + hstep, voffA);
            PG8_WAIT_V(8); PG8_WAIT_L(0); PG8_BAR; PG8_MMA(0, 0, At, B0); PG8_MMA(0, 1, At, B1); PG8_BAR; PG8_SCHED;
            PG8_LDA(At, 1, 1); PG8_STAGE(PG8_SB(1, 0), b3, voffB); PG8_STAGE(PG8_SB(1, 1), b3 + hstep, voffB); PG8_STAGE(PG8_SA(1, 0), a3, voffA);
            PG8_WAIT_V(8); PG8_WAIT_L(0); PG8_BAR; PG8_MMA(1, 0, At, B0); PG8_MMA(1, 1, At, B1); PG8_BAR; PG8_SCHED;
            } else {
            PG8_LDB(B0, 0, 0); PG8_SCHED; PG8_LDA(At, 0, 0); PG8_STAGE(PG8_SA(1, 1), a1 + hstep, voffA);
            PG8_WAIT_L(8); PG8_BAR; PG8_WAIT_L(0); PG8_MMA(0, 0, At, B0); PG8_BAR; PG8_SCHED;
            PG8_LDB(B1, 0, 1); PG8_STAGE(PG8_SB(0, 0), b2, voffB);
            PG8_BAR; PG8_WAIT_L(0); PG8_MMA(0, 1, At, B1); PG8_BAR;
            PG8_LDA(At, 0, 1); PG8_STAGE(PG8_SA(0, 0), a2, voffA);
            PG8_BAR; PG8_WAIT_L(0); PG8_MMA(1, 0, At, B0); PG8_BAR; PG8_SCHED;
            PG8_STAGE(PG8_SB(0, 1), b2 + hstep, voffB);
            PG8_WAIT_V(6); PG8_BAR; PG8_MMA(1, 1, At, B1); PG8_BAR;
            PG8_LDB(B0, 1, 0); PG8_SCHED; PG8_LDA(At, 1, 0); PG8_STAGE(PG8_SA(0, 1), a2 + hstep, voffA);
            PG8_WAIT_L(8); PG8_BAR; PG8_WAIT_L(0); PG8_MMA(0, 0, At, B0); PG8_BAR; PG8_SCHED;
            PG8_LDB(B1, 1, 1); PG8_STAGE(PG8_SB(1, 0), b3, voffB);
            PG8_BAR; PG8_WAIT_L(0); PG8_MMA(0, 1, At, B1); PG8_BAR;
            PG8_LDA(At, 1, 1); PG8_STAGE(PG8_SA(1, 0), a3, voffA);
            PG8_BAR; PG8_WAIT_L(0); PG8_MMA(1, 0, At, B0); PG8_BAR; PG8_SCHED;
            PG8_STAGE(PG8_SB(1, 1), b3 + hstep, voffB);
            PG8_WAIT_V(6); PG8_BAR; PG8_MMA(1, 1, At, B1); PG8_BAR;
            }
        }
        if constexpr (ALIGN_EPI) { if (wr == 0) PG8_BAR; }
        if constexpr (!Epi::AFTER_DRAIN) { E(acc, cur, wr, wc, fr, fq); S.done(cur); }
        if (!has_next) break;
#pragma unroll
        for (int a = 0; a < 2; ++a)
#pragma unroll
            for (int b = 0; b < 2; ++b)
#pragma unroll
                for (int m = 0; m < 4; ++m)
#pragma unroll
                    for (int n = 0; n < 2; ++n) acc[a][b][m][n] = (f32x4){0.f, 0.f, 0.f, 0.f};
        cur = nxt; cA = nA; cB = nB; ++ui;
        if constexpr (ALIGN_EPI) { if (wr == 1) PG8_BAR; }
    }
    PG8_WAIT_V(0);
    if constexpr (!ALIGN_EPI) { if (wr == 0) PG8_BAR; }
    PG8_BAR;
    if constexpr (Epi::AFTER_DRAIN) { E.fused(acc, cur, wr, wc, fr, fq, lds, wid, lane); S.done(cur); }
#undef PG8_SA
#undef PG8_SB
#undef PG8_STAGE
#undef PG8_LDA
#undef PG8_LDB
#undef PG8_MMA
#undef PG8_WAIT_V
#undef PG8_WAIT_L
#undef PG8_BAR
#undef PG8_SCHED
}
}

constexpr int NB = 16, T = 2048, D = 2048, M = NB * T, NP = 6656, NIN = 6160, FF = 5632, NUP = 2 * FF, NMOD = 12288;
constexpr float EPS = 1e-6f, LOG2E = 1.4426950408889634f;
constexpr int NWAVES = 8;
constexpr size_t MiB = 1u << 20;
constexpr size_t WS_CTL = 0, CTL_ZERO_BYTES = 1 * MiB;
constexpr size_t WS_MOD = 1 * MiB;
constexpr size_t WS_SCAL = 3 * MiB;
constexpr size_t WS_WIN = 4 * MiB;
constexpr size_t WS_WO = 56 * MiB;
constexpr size_t WS_WUP = 72 * MiB;
constexpr size_t WS_WDN = 160 * MiB;
constexpr size_t WS_HALO = 204 * MiB;
constexpr size_t HALO_ONE = (size_t)128 * 2 * 5632 * 4;
constexpr size_t WS_HN = 224 * MiB;
constexpr size_t WS_PROJ = 352 * MiB;
constexpr size_t WS_END = 768 * MiB;
static_assert(WS_WIN + (size_t)2 * NP * D * 2 <= WS_WO && WS_WO + (size_t)2 * D * D * 2 <= WS_WUP && WS_WUP + (size_t)2 * NUP * D * 2 <= WS_WDN && WS_WDN + (size_t)2 * D * FF * 2 <= WS_HALO &&
              WS_HALO + 3 * HALO_ONE <= WS_HN && WS_HN + (size_t)M * D * 2 <= WS_PROJ && WS_PROJ + (size_t)M * NP * 2 <= WS_END, "d_ws map");
constexpr int CW_TMO = 0, CW_CODE = 1, CW_BAR = 4096, CW_QUEUE = 16384;
constexpr int RING_OFF = 0, RING_BYTES = 131072, BND_OFF = RING_BYTES, LDSCTL_OFF = BND_OFF + 4096, LDS_BYTES = 147456;

#define GAS __attribute__((address_space(1)))
#define LAS __attribute__((address_space(3)))
typedef unsigned short bf16;
typedef unsigned v4u __attribute__((ext_vector_type(4)));
typedef unsigned v2u __attribute__((ext_vector_type(2)));
typedef float f32x4 __attribute__((ext_vector_type(4)));
typedef GAS unsigned gu32;
#define RLX_AGENT __ATOMIC_RELAXED, __HIP_MEMORY_SCOPE_AGENT
#define LDS_WAIT() asm volatile("s_waitcnt lgkmcnt(0)" ::: "memory")
__device__ __forceinline__ unsigned f2bf(float f) { unsigned u = __builtin_bit_cast(unsigned, f); return (u + 0x7fffu + ((u >> 16) & 1u)) >> 16; }
__device__ __forceinline__ unsigned pk2(float lo, float hi) { return f2bf(lo) | (f2bf(hi) << 16); }
__device__ __forceinline__ float bf2f(unsigned short h) { return __builtin_bit_cast(float, (unsigned)h << 16); }
__device__ __forceinline__ float bflo(unsigned w) { return __builtin_bit_cast(float, w << 16); }
__device__ __forceinline__ float bfhi(unsigned w) { return __builtin_bit_cast(float, w & 0xffff0000u); }
#define DPPF(v, ctrl) __builtin_bit_cast(float, __builtin_amdgcn_update_dpp(0, __builtin_bit_cast(int, (v)), (ctrl), 0xF, 0xF, true))
__device__ __forceinline__ float wave_sum(float v) {
    v += DPPF(v, 0xB1);
    v += DPPF(v, 0x4E);
    v += DPPF(v, 0x141);
    v += DPPF(v, 0x140);
    v += __builtin_bit_cast(float, __builtin_amdgcn_ds_swizzle(__builtin_bit_cast(int, v), 0x401F));
    float a = v, b = v;
    asm volatile("s_nop 1\n\tv_permlane32_swap_b32_e32 %0, %1\n\ts_nop 1" : "+v"(a), "+v"(b));
    return a + b;
}
struct Args { const float* in[18]; float* out; unsigned char* ws; int ph_lo, ph_hi, pad0, pad1; };
typedef const __attribute__((address_space(4))) Args CArgs;
#define ARGS() ({ CArgs* p_ = (CArgs*)__builtin_amdgcn_kernarg_segment_ptr(); asm volatile("" : "+s"(p_)); p_; })
#define XB_TMO      128
#define XB_XCNT(j)  (256  + 64 * (j))
#define XB_XSUB(j)  (1280 + 64 * (j))
#define XB_XGEN(j)  (2304 + 64 * (j))
#define XB_TOP      3328
#define XB_TOPGEN   3392
#define XCD_BAR_WORDS 3456
#define XB_SPIN_CAP (1u << 18)

__device__ __forceinline__ unsigned xb_ld(unsigned* p)              { return __hip_atomic_load(p, __ATOMIC_RELAXED, __HIP_MEMORY_SCOPE_AGENT); }
__device__ __forceinline__ unsigned xb_add(unsigned* p, unsigned v) { return __hip_atomic_fetch_add(p, v, __ATOMIC_RELAXED, __HIP_MEMORY_SCOPE_AGENT); }
__device__ __forceinline__ unsigned xb_xcc_id() { return (unsigned)__builtin_amdgcn_s_getreg((3 << 11) | 20) & 0xFu; }
#define XB_SPIN(cond, bar) do { unsigned _sp = 0; while (cond) { __builtin_amdgcn_s_sleep(1); \
    if ((++_sp & 255u) == 0u) { if (xb_ld(&(bar)[XB_TMO])) break; if (_sp > XB_SPIN_CAP) { atomicAdd(&(bar)[XB_TMO], 1u); break; } } } } while (0)

struct XcdBarrier {
    unsigned* bar; unsigned x;
    volatile LAS unsigned* st;
};

__device__ __forceinline__ XcdBarrier xcd_barrier_post(unsigned* bar, volatile LAS unsigned* st) {
    XcdBarrier b; b.bar = bar; b.x = xb_xcc_id(); b.st = st;
    if (threadIdx.x == 0) (void)xb_add(&bar[XB_XCNT(b.x)], 1u);
    return b;
}
__device__ __forceinline__ void xcd_barrier_complete(unsigned* bar, unsigned x, unsigned& nloc, unsigned& nx) {
    const unsigned G = gridDim.x * gridDim.y * gridDim.z;
    unsigned sum, cnt, mine, sp = 0u;
    for (;;) {
        sum = 0u; cnt = 0u; mine = 0u;
#pragma unroll
        for (unsigned j = 0; j < 16; ++j) { const unsigned c = xb_ld(&bar[XB_XCNT(j)]); sum += c; cnt += (c > 0u) ? 1u : 0u; mine = (j == x) ? c : mine; }
        if (sum == G) break;
        __builtin_amdgcn_s_sleep(1);
        if ((++sp & 255u) == 0u) { if (xb_ld(&bar[XB_TMO])) break; if (sp > XB_SPIN_CAP) { atomicAdd(&bar[XB_TMO], 1u); break; } }
    }
    nloc = mine > 0u ? mine : 1u; nx = cnt > 0u ? cnt : 1u;
}

__device__ __forceinline__ void xcd_barrier(const XcdBarrier& b) {
    asm volatile("s_waitcnt vmcnt(0)" ::: "memory");
    __syncthreads();
    if (threadIdx.x == 0) {
        unsigned* bar = b.bar;
        __builtin_amdgcn_s_waitcnt(0);
        unsigned nloc = b.st[0], nx = b.st[1];
        if (nloc == 0u) { xcd_barrier_complete(bar, b.x, nloc, nx); b.st[0] = nloc; b.st[1] = nx; }
        const unsigned old = xb_add(&bar[XB_XSUB(b.x)], 1u);
        const unsigned gen = old / nloc;
        if (old + 1u == (gen + 1u) * nloc) {
            __builtin_amdgcn_fence(__ATOMIC_RELEASE, "agent");
            asm volatile("s_waitcnt vmcnt(0)" ::: "memory");
            const unsigned og = xb_add(&bar[XB_TOP], 1u);
            const unsigned tg = og / nx;
            if (og + 1u == (tg + 1u) * nx) xb_add(&bar[XB_TOPGEN], 1u);
            else XB_SPIN(xb_ld(&bar[XB_TOPGEN]) == tg, bar);
            __builtin_amdgcn_fence(__ATOMIC_ACQUIRE, "agent");
            xb_add(&bar[XB_XGEN(b.x)], 1u);
            asm volatile("s_waitcnt vmcnt(0)" ::: "memory");
        } else {
            XB_SPIN(xb_ld(&bar[XB_XGEN(b.x)]) == gen, bar);
            __builtin_amdgcn_fence(__ATOMIC_ACQUIRE, "agent");
            asm volatile("s_waitcnt vmcnt(0)" ::: "memory");
        }
    }
    __syncthreads();
}


__device__ __forceinline__ void p0_write_item(bf16* WT, int K, int dst_row, int k0, LAS float* scr, int lane) {
    LDS_WAIT(); asm volatile("" ::: "memory");
    const int c = lane & 7;
#pragma unroll
    for (int j = 0; j < 4; ++j) { const int n = (lane >> 3) + 8 * j; const LAS float* s = scr + (8 * c) * 33 + n;
        v4u o; o.x = pk2(s[0 * 33], s[1 * 33]); o.y = pk2(s[2 * 33], s[3 * 33]); o.z = pk2(s[4 * 33], s[5 * 33]); o.w = pk2(s[6 * 33], s[7 * 33]);
        *(GAS v4u*)(WT + (size_t)(dst_row + n) * K + k0 + 8 * c) = o; }
    LDS_WAIT(); asm volatile("" ::: "memory");
}
__device__ __forceinline__ void p0_transpose_item(const float* W, int ldw, int K, bf16* WT, int dst_row, int k0, int n0, LAS float* scr, int lane) {
#pragma unroll 8
    for (int i = 0; i < 32; ++i) { const int kk = 2 * i + (lane >> 5); scr[kk * 33 + (lane & 31)] = W[(size_t)(k0 + kk) * ldw + n0 + (lane & 31)]; }
    p0_write_item(WT, K, dst_row, k0, scr, lane);
}
__device__ __forceinline__ void p0_weff_item(const float* Win, const float* Wgk, bf16* WT, int k0, int n0, LAS float* scr, int lane) {
    const int n = lane & 31;
    float g[16];
#pragma unroll
    for (int r = 0; r < 16; ++r) g[r] = Wgk[r * 512 + n0 + n];
#pragma unroll 4
    for (int i = 0; i < 32; ++i) { const int kk = 2 * i + (lane >> 5); const float* wr = Win + (size_t)(k0 + kk) * NIN + 6144; float s = 0.f;
#pragma unroll
        for (int r = 0; r < 16; ++r) s += wr[r] * g[r];
        scr[kk * 33 + n] = s; }
    p0_write_item(WT, D, 6144 + n0, k0, scr, lane);
}

__device__ __forceinline__ void p0_prologue(const CArgs* ap, LAS unsigned char* lds, int tid, int lane, int wave, int vcu, int G) {
    unsigned char* ws = ap->ws;
    float* MOD = (float*)(ws + WS_MOD); float* SCAL = (float*)(ws + WS_SCAL);
    if (blockIdx.x < 96) {
        const int l = blockIdx.x / 48, cg = blockIdx.x % 48;
        LAS float* cs = (LAS float*)(lds + wave * 16384);
        const float* c = ap->in[1];
        for (int i = 0; i < 64; ++i) { const int e = lane + 64 * i, bb = e & 15, kk = e >> 4; const float cv = c[bb * D + 256 * wave + kk]; cs[kk * 16 + bb] = cv / (1.f + __expf(-cv)); }
        LDS_WAIT(); asm volatile("" ::: "memory");
        const float* W = ap->in[2] + (size_t)l * D * NMOD + (size_t)(256 * wave) * NMOD + 256 * cg + 4 * lane;
        f32x4 acc[16];
#pragma unroll
        for (int i = 0; i < 16; ++i) acc[i] = (f32x4){0.f, 0.f, 0.f, 0.f};
#pragma unroll 4
        for (int kk = 0; kk < 256; ++kk) { const f32x4 w = __builtin_nontemporal_load((const f32x4*)(W + (size_t)kk * NMOD));
#pragma unroll
            for (int q4 = 0; q4 < 4; ++q4) { const f32x4 c4 = *(const LAS f32x4*)(cs + kk * 16 + 4 * q4);
                acc[4 * q4 + 0] += c4.x * w; acc[4 * q4 + 1] += c4.y * w; acc[4 * q4 + 2] += c4.z * w; acc[4 * q4 + 3] += c4.w * w; } }
        __syncthreads();
        LAS float* red = (LAS float*)lds;
#pragma unroll
        for (int bb = 0; bb < 16; ++bb) *(LAS f32x4*)(red + (wave * 16 + bb) * 256 + 4 * lane) = acc[bb];
        __syncthreads();
        for (int i = 0; i < 8; ++i) { const int o = tid + 512 * i, bb = o >> 8, col = o & 255; float s = ap->in[3][l * NMOD + 256 * cg + col];
#pragma unroll
            for (int w = 0; w < 8; ++w) s += red[(w * 16 + bb) * 256 + col];
            MOD[(size_t)(l * 16 + bb) * NMOD + 256 * cg + col] = s; }
        __syncthreads();
    }
    if (blockIdx.x == 96 && wave == 0) {
        for (int l = 0; l < 2; ++l) { const float* dl = ap->in[6] + l * 256; float s1 = dl[lane] * dl[64 + lane], s2 = dl[128 + lane] * dl[192 + lane];
            s1 = wave_sum(s1); s2 = wave_sum(s2);
            if (lane == 0) SCAL[l] = __expf(s1) - __expf(s2) + (l == 0 ? 0.2f : 0.35550906759096926f); }
    }
    LAS float* scr = (LAS float*)(lds + wave * 16384);
    const int gw = vcu * NWAVES + wave, NGW = G * NWAVES;
    constexpr int I_IN = 32 * 192, I_EFF = 32 * 16, I_O = 32 * 64, I_UP = 32 * 352, I_DN = 88 * 64, I_L = I_IN + I_EFF + I_O + I_UP + I_DN;
    for (int it = gw; it < 2 * I_L; it += NGW) {
        const int l = it / I_L; int r = it % I_L;
        bf16* WINt = (bf16*)(ws + WS_WIN) + (size_t)l * NP * D; bf16* WOt = (bf16*)(ws + WS_WO) + (size_t)l * D * D;
        bf16* WUPt = (bf16*)(ws + WS_WUP) + (size_t)l * NUP * D; bf16* WDNt = (bf16*)(ws + WS_WDN) + (size_t)l * D * FF;
        const float* w_in = ap->in[5] + (size_t)l * D * NIN;
        if (r < I_IN) { const int kb = r / 192, nb = r % 192; p0_transpose_item(w_in, NIN, D, WINt, 32 * nb, 64 * kb, 32 * nb, scr, lane); continue; } r -= I_IN;
        if (r < I_EFF) { const int kb = r / 16, nb = r % 16; p0_weff_item(w_in, ap->in[8] + (size_t)l * 16 * 512, WINt, 64 * kb, 32 * nb, scr, lane); continue; } r -= I_EFF;
        if (r < I_O) { const int kb = r / 64, nb = r % 64; p0_transpose_item(ap->in[11] + (size_t)l * D * D, D, D, WOt, 32 * nb, 64 * kb, 32 * nb, scr, lane); continue; } r -= I_O;
        if (r < I_UP) { const int kb = r / 352, nb = r % 352, n0 = 32 * nb; const int n1 = n0 < FF ? n0 : n0 - FF; const int dst = 256 * (n1 / 128) + (n1 % 128) + (n0 < FF ? 0 : 128);
            p0_transpose_item(ap->in[13] + (size_t)l * D * NUP, NUP, D, WUPt, dst, 64 * kb, n0, scr, lane); continue; } r -= I_UP;
        { const int kb = r / 64, nb = r % 64; p0_transpose_item(ap->in[16] + (size_t)l * FF * D, D, FF, WDNt, 32 * nb, 64 * kb, 32 * nb, scr, lane); }
    }
}

__device__ __forceinline__ void norm_phase(const float* xin, const float* g, const float* modl, int sh_chunk, int sc_chunk, bf16* outp, int gw, int NGW, int lane) {
    for (int rb = gw; rb < M / 16; rb += NGW) {
        const int b = rb >> 7; const float* mb = modl + (size_t)b * NMOD;
        f32x4 A[8], S[8];
#pragma unroll
        for (int j = 0; j < 8; ++j) { const int col = 4 * lane + 256 * j; const f32x4 gv = *(const f32x4*)(g + col), sc = *(const f32x4*)(mb + sc_chunk * D + col); A[j] = gv * (1.f + sc); S[j] = *(const f32x4*)(mb + sh_chunk * D + col); }
        for (int r = 0; r < 16; ++r) {
            const size_t row = (size_t)rb * 16 + r; const GAS f32x4* xr = (const GAS f32x4*)(xin + row * D) + lane;
            f32x4 v[8]; float s = 0.f;
#pragma unroll
            for (int j = 0; j < 8; ++j) { v[j] = xr[64 * j]; s += (v[j].x * v[j].x + v[j].y * v[j].y) + (v[j].z * v[j].z + v[j].w * v[j].w); }
            const float rstd = 1.f / sqrtf(wave_sum(s) * (1.f / D) + EPS);
            GAS v2u* o8 = (GAS v2u*)(outp + row * D) + lane;
#pragma unroll
            for (int j = 0; j < 8; ++j) { const f32x4 y = v[j] * rstd * A[j] + S[j]; v2u w; w.x = pk2(y.x, y.y); w.y = pk2(y.z, y.w); o8[64 * j] = w; }
        }
    }
}
__device__ __forceinline__ void final_norm_phase(float* x, const float* g, int gw, int NGW, int lane) {
    f32x4 A[8];
#pragma unroll
    for (int j = 0; j < 8; ++j) A[j] = *(const f32x4*)(g + 4 * lane + 256 * j);
    for (int row = gw; row < M; row += NGW) {
        GAS f32x4* xr = (GAS f32x4*)(x + (size_t)row * D) + lane;
        f32x4 v[8]; float s = 0.f;
#pragma unroll
        for (int j = 0; j < 8; ++j) { v[j] = xr[64 * j]; s += (v[j].x * v[j].x + v[j].y * v[j].y) + (v[j].z * v[j].z + v[j].w * v[j].w); }
        const float rstd = 1.f / sqrtf(wave_sum(s) * (1.f / D) + EPS);
#pragma unroll
        for (int j = 0; j < 8; ++j) xr[64 * j] = v[j] * rstd * A[j];
    }
}
__device__ __forceinline__ void fixup_phase(const float* glast, const float* gfirst, const float* ufirst, const float* wconv, const float* bconv, bf16* act, int gtid, int nthreads) {
    constexpr int PER_ROW = FF / 4, TOTAL = 112 * 2 * PER_ROW;
    for (int idx = gtid; idx < TOTAL; idx += nthreads) {
        const int c = (idx % PER_ROW) * 4, rr = (idx / PER_ROW) & 1, pmi = idx / (2 * PER_ROW), pm = (pmi / 7) * 8 + (pmi % 7) + 1;
        const f32x4 gl0 = *(const f32x4*)(glast + ((size_t)(pm - 1) * 2 + 0) * FF + c), gl1 = *(const f32x4*)(glast + ((size_t)(pm - 1) * 2 + 1) * FF + c);
        const f32x4 gf0 = *(const f32x4*)(gfirst + ((size_t)pm * 2 + 0) * FF + c), gf1 = *(const f32x4*)(gfirst + ((size_t)pm * 2 + 1) * FF + c);
        const f32x4 uu = *(const f32x4*)(ufirst + ((size_t)pm * 2 + rr) * FF + c);
        const f32x4 w0 = *(const f32x4*)(wconv + c), w1 = *(const f32x4*)(wconv + FF + c), w2 = *(const f32x4*)(wconv + 2 * FF + c), cb = *(const f32x4*)(bconv + c);
        const f32x4 y = rr == 0 ? (w0 * gl0 + w1 * gl1 + w2 * gf0 + cb) : (w0 * gl1 + w1 * gf0 + w2 * gf1 + cb);
        const pg8::f32x2 ga = pg8::gelu_pk((pg8::f32x2){y.x, y.y}), gb = pg8::gelu_pk((pg8::f32x2){y.z, y.w});
        v2u w; w.x = pk2(ga.x * uu.x, ga.y * uu.y); w.y = pk2(gb.x * uu.z, gb.y * uu.w);
        *(GAS v2u*)(act + (size_t)(256 * pm + rr) * FF + c) = w;
    }
}

__device__ __forceinline__ void attn_naive_unit(const bf16* P, bf16* CAT, int b, int h, int qb, float lam, float subscale, const float* gsub, LAS float* xch, int tid) {
    const int wave = tid >> 6, lane = tid & 63, mp = wave >> 2, dvh = (wave >> 1) & 1, rloc = (wave & 1) * 64 + lane, row = 128 * qb + rloc;
    const float slope2 = exp2f(-(float)(h + 1)) * LOG2E;
    const bf16* prow = P + (size_t)(b * T + row) * NP + h * 128 + mp * 64;
    float q[64];
#pragma unroll
    for (int d8 = 0; d8 < 8; ++d8) { const v4u w = *(const v4u*)(prow + 8 * d8); q[8 * d8 + 0] = bflo(w.x); q[8 * d8 + 1] = bfhi(w.x); q[8 * d8 + 2] = bflo(w.y); q[8 * d8 + 3] = bfhi(w.y); q[8 * d8 + 4] = bflo(w.z); q[8 * d8 + 5] = bfhi(w.z); q[8 * d8 + 6] = bflo(w.w); q[8 * d8 + 7] = bfhi(w.w); }
    float o[64];
#pragma unroll
    for (int i = 0; i < 64; ++i) o[i] = 0.f;
    float m = -1e30f, l = 0.f;
    const int kmax = __builtin_amdgcn_readfirstlane(128 * qb + (wave & 1) * 64 + 63);
    const bf16* kbase = P + (size_t)(b * T) * NP + 1024 + h * 128 + mp * 64;
    const bf16* vbase = P + (size_t)(b * T) * NP + 2048 + h * 128 + dvh * 64;
    for (int kv = 0; kv <= kmax; ++kv) {
        const bf16* kr = kbase + (size_t)kv * NP; float s = 0.f;
#pragma unroll
        for (int d8 = 0; d8 < 8; ++d8) { const v4u w = *(const v4u*)(kr + 8 * d8);
            s += q[8 * d8 + 0] * bflo(w.x) + q[8 * d8 + 1] * bfhi(w.x) + q[8 * d8 + 2] * bflo(w.y) + q[8 * d8 + 3] * bfhi(w.y) + q[8 * d8 + 4] * bflo(w.z) + q[8 * d8 + 5] * bfhi(w.z) + q[8 * d8 + 6] * bflo(w.w) + q[8 * d8 + 7] * bfhi(w.w); }
        s += slope2 * (float)(kv - row);
        if (kv <= row) {
            if (s > m) { const float al = exp2f(m - s); l *= al;
#pragma unroll
                for (int i = 0; i < 64; ++i) o[i] *= al;
                m = s; }
            const float p = exp2f(s - m); l += p;
            const bf16* vr = vbase + (size_t)kv * NP;
#pragma unroll
            for (int d8 = 0; d8 < 8; ++d8) { const v4u w = *(const v4u*)(vr + 8 * d8);
                o[8 * d8 + 0] += p * bflo(w.x); o[8 * d8 + 1] += p * bfhi(w.x); o[8 * d8 + 2] += p * bflo(w.y); o[8 * d8 + 3] += p * bfhi(w.y); o[8 * d8 + 4] += p * bflo(w.z); o[8 * d8 + 5] += p * bfhi(w.z); o[8 * d8 + 6] += p * bflo(w.w); o[8 * d8 + 7] += p * bfhi(w.w); }
        }
    }
    const float inv = 1.f / l;
    LAS float* ssx = xch + 128 * 128;
    if (mp == 1) {
#pragma unroll
        for (int i = 0; i < 64; ++i) xch[(dvh * 64 + i) * 128 + rloc] = o[i] * inv; }
    __syncthreads();
    if (mp == 0) {
        float ss = 0.f;
#pragma unroll
        for (int i = 0; i < 64; ++i) { o[i] = o[i] * inv - lam * xch[(dvh * 64 + i) * 128 + rloc]; ss += o[i] * o[i]; }
        ssx[dvh * 128 + rloc] = ss;
    }
    __syncthreads();
    if (mp == 0) {
        const float rstd = subscale / sqrtf((ssx[rloc] + ssx[128 + rloc]) * (1.f / 128.f) + EPS);
        bf16* orow = CAT + (size_t)(b * T + row) * D + h * 128 + dvh * 64; const float* gs = gsub + dvh * 64;
#pragma unroll
        for (int d8 = 0; d8 < 8; ++d8) { v4u w; w.x = pk2(o[8 * d8 + 0] * rstd * gs[8 * d8 + 0], o[8 * d8 + 1] * rstd * gs[8 * d8 + 1]); w.y = pk2(o[8 * d8 + 2] * rstd * gs[8 * d8 + 2], o[8 * d8 + 3] * rstd * gs[8 * d8 + 3]);
            w.z = pk2(o[8 * d8 + 4] * rstd * gs[8 * d8 + 4], o[8 * d8 + 5] * rstd * gs[8 * d8 + 5]); w.w = pk2(o[8 * d8 + 6] * rstd * gs[8 * d8 + 6], o[8 * d8 + 7] * rstd * gs[8 * d8 + 7]);
            *(GAS v4u*)(orow + 8 * d8) = w; }
    }
    __syncthreads();
}
__device__ __forceinline__ void gla_naive_unit(const bf16* P, bf16* CAT, int b, int h, float ogs, const float* gn, LAS float* lf, int tid) {
    const int e = tid & 255, dh = tid >> 8, wave = tid >> 6, lane = tid & 63;
    LAS float* sa = lf; LAS float* sk = lf + 2048; LAS float* sq = lf + 4096; LAS float* op = lf + 6144; LAS float* wss = lf + 6144 + 8192; LAS float* sv = lf + 6144 + 8192 + 64;
    float S[64];
#pragma unroll
    for (int i = 0; i < 64; ++i) S[i] = 0.f;
    const float gne = gn[e] * ogs;
    for (int t0 = 0; t0 < T; t0 += 16) {
        const bf16* pr0 = P + (size_t)(b * T + t0) * NP;
#pragma unroll
        for (int i = 0; i < 4; ++i) { const int idx = tid + 512 * i, tt = idx >> 7, d = idx & 127; const bf16* pr = pr0 + (size_t)tt * NP;
            sa[idx] = exp2f(LOG2E * bf2f(pr[6144 + h * 128 + d])); sk[idx] = bf2f(pr[3584 + h * 128 + d]); sq[idx] = bf2f(pr[3072 + h * 128 + d]); }
#pragma unroll
        for (int i = 0; i < 8; ++i) { const int tt = 2 * i + dh; sv[tt * 256 + e] = bf2f(pr0[(size_t)tt * NP + 4096 + h * 256 + e]); }
        __syncthreads();
#pragma unroll 1
        for (int tt = 0; tt < 16; ++tt) { float acc = 0.f; const float vv = sv[tt * 256 + e];
#pragma unroll
            for (int d4 = 0; d4 < 16; ++d4) { const f32x4 a4 = *(const LAS f32x4*)(sa + tt * 128 + 64 * dh + 4 * d4), k4 = *(const LAS f32x4*)(sk + tt * 128 + 64 * dh + 4 * d4), q4 = *(const LAS f32x4*)(sq + tt * 128 + 64 * dh + 4 * d4);
#pragma unroll
                for (int c = 0; c < 4; ++c) { S[4 * d4 + c] = a4[c] * S[4 * d4 + c] + k4[c] * vv; acc += q4[c] * S[4 * d4 + c]; } }
            op[(dh * 16 + tt) * 256 + e] = acc; }
        __syncthreads();
        if (dh == 0) {
#pragma unroll 1
            for (int tt = 0; tt < 16; ++tt) { const float o = op[tt * 256 + e] + op[(16 + tt) * 256 + e]; const float s2 = wave_sum(o * o); if (lane == 0) wss[wave * 16 + tt] = s2; } }
        __syncthreads();
        if (dh == 0) {
#pragma unroll 1
            for (int tt = 0; tt < 16; ++tt) { const float o = op[tt * 256 + e] + op[(16 + tt) * 256 + e];
                const float tot = (wss[tt] + wss[16 + tt]) + (wss[32 + tt] + wss[48 + tt]); const float rstd = 1.f / sqrtf(tot * (1.f / 256.f) + EPS);
                const float gate = bf2f(pr0[(size_t)tt * NP + 5120 + h * 256 + e]);
                CAT[(size_t)(b * T + t0 + tt) * D + 1024 + h * 256 + e] = (bf16)f2bf(o * rstd * gne * gate); } }
    }
    __syncthreads();
}

#ifdef DBG_CHECK
constexpr int CW_DBG = 32768;
__device__ __forceinline__ float dbg_dot(const bf16* arow, const float* w, int ldw, int K, int lane, bool roundw) {
    float s = 0.f;
    for (int k = lane; k < K; k += 64) { const float wv = w[(size_t)k * ldw]; s += bf2f(arow[k]) * (roundw ? bf2f((unsigned short)f2bf(wv)) : wv); }
    return wave_sum(s);
}
__device__ __forceinline__ void dbg_fail(gu32* ctl, int which, float got, float exp, float rtol, float atol) {
    if (!(__builtin_fabsf(got - exp) <= rtol * __builtin_fabsf(exp) + atol)) __hip_atomic_fetch_add(ctl + CW_DBG + which, 1u, RLX_AGENT);
}
__device__ __forceinline__ float dbg_logsig(float x) { return (x < 0.f ? x : 0.f) - log1pf(expf(-fabsf(x))); }
__global__ void __launch_bounds__(64) dbg_kernel(Args a, int which, int l) {
    const int lane = threadIdx.x; unsigned char* ws = a.ws; gu32* ctl = (gu32*)(ws + WS_CTL);
    const float* MOD = (const float*)(ws + WS_MOD); const bf16* HN = (const bf16*)(ws + WS_HN); const bf16* PROJ = (const bf16*)(ws + WS_PROJ); const bf16* CAT = HN; const bf16* ACT = PROJ;
    float* STASH = (float*)(ws + WS_SCAL) + 64;
    const int rows8[8] = {0, 1, 255, 256, 2047, 2048, 12345, 32767};
    if (which == 0) {
        const float t1 = wave_sum((float)(lane + 1)); dbg_fail(ctl, 0, t1, 2080.f, 0.f, 0.01f);
        { float v = (float)(lane + 1); v += DPPF(v, 0xB1); v += DPPF(v, 0x4E); v += DPPF(v, 0x141); v += DPPF(v, 0x140); const int r = lane >> 4; dbg_fail(ctl, 21, v, (float)(16 * (16 * r) + 136), 0.f, 0.01f); }
        { const float v = __builtin_bit_cast(float, __builtin_amdgcn_ds_swizzle(__builtin_bit_cast(int, (float)lane), 0x401F)); dbg_fail(ctl, 22, v, (float)(lane ^ 16), 0.f, 0.01f); }
        { float a_ = (float)lane, b_ = (float)lane; asm volatile("s_nop 1\n\tv_permlane32_swap_b32_e32 %0, %1\n\ts_nop 1" : "+v"(a_), "+v"(b_));
          dbg_fail(ctl, 23, a_ + b_, (float)((lane & 31) + (lane & 31) + 32), 0.f, 0.01f); dbg_fail(ctl, 25, a_, (float)(lane & 31), 0.f, 0.01f); }
        { const float v = __shfl_xor((float)lane, 16); dbg_fail(ctl, 24, v, (float)(lane ^ 16), 0.f, 0.01f); }
    } else if (which == 10) {
        const int bs[3] = {0, 7, 15}, js[5] = {0, 255, 256, 5000, 12287};
        for (int ll = 0; ll < 2; ++ll) for (int bi = 0; bi < 3; ++bi) for (int ji = 0; ji < 5; ++ji) { const int b = bs[bi], j = js[ji]; float s = 0.f;
            for (int k = lane; k < D; k += 64) { const float cv = a.in[1][b * D + k]; s += cv / (1.f + expf(-cv)) * a.in[2][((size_t)ll * D + k) * NMOD + j]; }
            s = wave_sum(s) + a.in[3][ll * NMOD + j];
            if (lane == 0) dbg_fail(ctl, 10, MOD[(size_t)(ll * 16 + b) * NMOD + j], s, 1e-3f, 1e-3f); }
    } else if (which == 1) {
        const float* xin = (l == 0) ? a.in[0] : a.out; const int cs[4] = {0, 5, 1000, 2047};
        for (int ri = 0; ri < 8; ++ri) { const int r = rows8[ri], b = r / T; float s = 0.f;
            for (int k = lane; k < D; k += 64) { const float v = xin[(size_t)r * D + k]; s += v * v; }
            const float rstd = 1.f / sqrtf(wave_sum(s) / D + EPS);
            for (int ci = 0; ci < 4; ++ci) { const int c = cs[ci]; const float* mb = MOD + (size_t)(l * 16 + b) * NMOD;
                const float e = xin[(size_t)r * D + c] * rstd * a.in[4][l * D + c] * (1.f + mb[D + c]) + mb[c];
                if (lane == 0) dbg_fail(ctl, 1, bf2f(HN[(size_t)r * D + c]), e, 0.01f, 0.01f); } }
    } else if (which == 2) {
        const int cs[10] = {5, 700, 1030, 2100, 3100, 3600, 4200, 5200, 1023, 6143};
        for (int ri = 0; ri < 8; ++ri) for (int ci = 0; ci < 10; ++ci) { const int r = rows8[ri], c = cs[ci];
            float e = dbg_dot(HN + (size_t)r * D, a.in[5] + (size_t)l * D * NIN + c, NIN, D, lane, true);
            if (c < 1024) e *= pg8::QSCALE; else if (c >= 3072 && c < 3584) e *= pg8::GQSCALE; else if (c >= 5120) e = e / (1.f + expf(-e));
            if (lane == 0) dbg_fail(ctl, 2, bf2f(PROJ[(size_t)r * NP + c]), e, 0.02f, 0.02f); }
    } else if (which == 3) {
        const int js[5] = {0, 6, 255, 256, 511};
        for (int ri = 0; ri < 8; ++ri) { const int r = rows8[ri]; float gl[16];
#pragma unroll
            for (int q = 0; q < 16; ++q) gl[q] = dbg_dot(HN + (size_t)r * D, a.in[5] + (size_t)l * D * NIN + 6144 + q, NIN, D, lane, false);
            for (int ji = 0; ji < 5; ++ji) { const int j = js[ji]; float xg = a.in[9][l * 512 + j];
#pragma unroll
                for (int q = 0; q < 16; ++q) xg += gl[q] * a.in[8][(size_t)l * 16 * 512 + q * 512 + j];
                if (lane == 0) dbg_fail(ctl, 3, bf2f(PROJ[(size_t)r * NP + 6144 + j]), dbg_logsig(xg) * 0.0625f, 0.05f, 1e-3f); } }
    } else if (which == 4) {
        const int bs[3] = {0, 5, 15}, ts[3] = {0, 77, 300}, hs[3] = {0, 3, 7};
        const float lam = ((const float*)(ws + WS_SCAL))[l], sub = 1.f - (l == 0 ? 0.2f : 0.35550906759096926f);
        for (int si = 0; si < 3; ++si) { const int b = bs[si], t = ts[si], h = hs[si]; const float slope = exp2f(-(float)(h + 1));
            float od0 = 0.f, od1 = 0.f;
            for (int mp = 0; mp < 2; ++mp) {
                const bf16* qrow = PROJ + (size_t)(b * T + t) * NP + h * 128 + mp * 64;
                const bf16* kb = PROJ + (size_t)(b * T) * NP + 1024 + h * 128 + mp * 64;
#define DBG_SCORE(kv) ({ const bf16* kr_ = kb + (size_t)(kv) * NP; float s_ = 0.f; for (int d = 0; d < 64; ++d) s_ += bf2f(qrow[d]) * bf2f(kr_[d]); s_ / 1.4426950408889634f - slope * (float)(t - (kv)); })
                float mx = -1e30f;
                for (int kv = lane; kv <= t; kv += 64) mx = fmaxf(mx, DBG_SCORE(kv));
                for (int o = 1; o < 64; o <<= 1) mx = fmaxf(mx, __shfl_xor(mx, o));
                float den = 0.f;
                for (int kv = lane; kv <= t; kv += 64) den += expf(DBG_SCORE(kv) - mx);
                den = wave_sum(den);
                for (int ch = 0; ch < 4; ++ch) {
                    float acc[32];
#pragma unroll
                    for (int i = 0; i < 32; ++i) acc[i] = 0.f;
                    for (int kv = lane; kv <= t; kv += 64) { const float p = expf(DBG_SCORE(kv) - mx); const bf16* vr = PROJ + (size_t)(b * T + kv) * NP + 2048 + h * 128 + ch * 32;
#pragma unroll
                        for (int i = 0; i < 32; ++i) acc[i] += p * bf2f(vr[i]); }
#pragma unroll
                    for (int i = 0; i < 32; ++i) { const float v = wave_sum(acc[i]) / den, cv = (mp == 0) ? v : -lam * v; const int idx = ch * 32 + i;
                        if (lane == (idx & 63)) { if (idx < 64) od0 += cv; else od1 += cv; } }
                }
#undef DBG_SCORE
            }
            const float rstd = sub / sqrtf(wave_sum(od0 * od0 + od1 * od1) / 128.f + EPS);
            dbg_fail(ctl, 4, bf2f(CAT[(size_t)(b * T + t) * D + h * 128 + lane]), od0 * rstd * a.in[7][l * 128 + lane], 0.03f, 0.02f);
            dbg_fail(ctl, 4, bf2f(CAT[(size_t)(b * T + t) * D + h * 128 + 64 + lane]), od1 * rstd * a.in[7][l * 128 + 64 + lane], 0.03f, 0.02f);
        }
    } else if (which == 5) {
        const int bs[3] = {0, 9, 15}, ts[3] = {0, 70, 200}, hs[3] = {0, 2, 3};
        for (int si = 0; si < 3; ++si) { const int b = bs[si], t = ts[si], h = hs[si];
            const bf16* qrow = PROJ + (size_t)(b * T + t) * NP + 3072 + h * 128; const float q0 = bf2f(qrow[lane]), q1 = bf2f(qrow[64 + lane]);
            float c0 = 0.f, c1 = 0.f, o[4] = {0.f, 0.f, 0.f, 0.f};
            for (int s = t; s >= 0; --s) { const bf16* pr = PROJ + (size_t)(b * T + s) * NP;
                const float w = wave_sum(q0 * bf2f(pr[3584 + h * 128 + lane]) * expf(c0) + q1 * bf2f(pr[3584 + h * 128 + 64 + lane]) * expf(c1));
#pragma unroll
                for (int i = 0; i < 4; ++i) o[i] += w * bf2f(pr[4096 + h * 256 + 4 * lane + i]);
                c0 += bf2f(pr[6144 + h * 128 + lane]); c1 += bf2f(pr[6144 + h * 128 + 64 + lane]); }
            const float rstd = 1.f / sqrtf(wave_sum(o[0] * o[0] + o[1] * o[1] + o[2] * o[2] + o[3] * o[3]) / 256.f + EPS);
#pragma unroll
            for (int i = 0; i < 4; ++i) { const int e = 4 * lane + i; const float gate = bf2f(PROJ[(size_t)(b * T + t) * NP + 5120 + h * 256 + e]);
                dbg_fail(ctl, 5, bf2f(CAT[(size_t)(b * T + t) * D + 1024 + h * 256 + e]), o[i] * rstd * a.in[10][l * 256 + e] * gate, 0.03f, 0.02f); }
        }
    } else if (which == 6) {
        const float* xin = (l == 0) ? a.in[0] : STASH + 256; const int cs[5] = {0, 1, 17, 300, 2047};
        for (int ri = 0; ri < 8; ++ri) for (int ci = 0; ci < 5; ++ci) { const int r = rows8[ri], c = cs[ci], b = r / T;
            const float d = dbg_dot(CAT + (size_t)r * D, a.in[11] + (size_t)l * D * D + c, D, D, lane, true);
            const float xo = (l == 0) ? xin[(size_t)r * D + c] : xin[ri * 8 + ci];
            if (lane == 0) dbg_fail(ctl, 6, a.out[(size_t)r * D + c], xo + MOD[(size_t)(l * 16 + b) * NMOD + 2 * D + c] * d, 0.01f, 0.01f); }
    } else if (which == 7) {
        const int pms[5] = {0, 1, 7, 8, 9}, lr[17] = {0, 1, 2, 15, 16, 17, 63, 64, 65, 127, 128, 129, 191, 192, 193, 254, 255}, cs[9] = {0, 3, 4, 9, 37, 100, 127, 133, 5631};
        const float* wu = a.in[13] + (size_t)l * D * NUP;
        for (int pi = 0; pi < 5; ++pi) for (int ri = 0; ri < 17; ++ri) for (int ci = 0; ci < 9; ++ci) { const int r = 256 * pms[pi] + lr[ri], c = cs[ci], t = r % T;
            const float u = dbg_dot(HN + (size_t)r * D, wu + c, NUP, D, lane, true), g0 = dbg_dot(HN + (size_t)r * D, wu + FF + c, NUP, D, lane, true);
            const float g1 = t >= 1 ? dbg_dot(HN + (size_t)(r - 1) * D, wu + FF + c, NUP, D, lane, true) : 0.f, g2 = t >= 2 ? dbg_dot(HN + (size_t)(r - 2) * D, wu + FF + c, NUP, D, lane, true) : 0.f;
            const float* wc = a.in[14] + (size_t)l * 3 * FF; const float y = wc[c] * g2 + wc[FF + c] * g1 + wc[2 * FF + c] * g0 + a.in[15][l * FF + c];
            const float e = 0.5f * y * (1.f + erff(y * 0.70710678f)) * u;
            if (lane == 0) dbg_fail(ctl, 7, bf2f(ACT[(size_t)r * FF + c]), e, 0.03f, 0.02f); }
    } else if (which == 8) {
        const int cs[5] = {0, 1, 17, 300, 2047};
        for (int ri = 0; ri < 8; ++ri) for (int ci = 0; ci < 5; ++ci) if (lane == 0) STASH[ri * 8 + ci] = a.out[(size_t)rows8[ri] * D + cs[ci]];
    } else if (which == 9) {
        const int cs[5] = {0, 1, 17, 300, 2047};
        for (int ri = 0; ri < 8; ++ri) for (int ci = 0; ci < 5; ++ci) { const int r = rows8[ri], c = cs[ci], b = r / T;
            const float d = dbg_dot(ACT + (size_t)r * FF, a.in[16] + (size_t)l * FF * D + c, D, FF, lane, true);
            if (lane == 0) { dbg_fail(ctl, 9, a.out[(size_t)r * D + c], STASH[ri * 8 + ci] + MOD[(size_t)(l * 16 + b) * NMOD + 5 * D + c] * d, 0.01f, 0.01f); STASH[256 + ri * 8 + ci] = a.out[(size_t)r * D + c]; } }
    }
}
__global__ void dbg_emit(Args a, int lo_bit) {
    gu32* ctl = (gu32*)(a.ws + WS_CTL); unsigned mask = 0;
    for (int i = 0; i < 6; ++i) if (ctl[CW_DBG + lo_bit + i]) mask |= 1u << i;
    if (threadIdx.x == 0 && blockIdx.x == 0) a.out[0] += 10.f + (float)mask;
}
#endif

#ifndef MK_PER_PHASE
#define MK_PER_PHASE 0
#endif
#ifndef DBG_SIGNS
#define DBG_SIGNS 0,0,0,0,0,0
#endif
__device__ const float DBG_A[6] = {DBG_SIGNS};
constexpr int N_PHASES = 18;
constexpr int GLA_UNITS = 64, ATT_UNITS = 2048, MIX_UNITS = GLA_UNITS + ATT_UNITS;

__global__ void __launch_bounds__(NWAVES * 64, 2) fwd_kernel(Args a_unused) {
    extern __shared__ __attribute__((aligned(16))) unsigned char lds_raw[];
    LAS unsigned char* lds = (LAS unsigned char*)lds_raw;
#define TIDS() int tid = threadIdx.x; asm volatile("" : "+v"(tid)); const int lane = tid & 63, wave = __builtin_amdgcn_readfirstlane(tid >> 6); (void)lane; (void)wave
#define G_ ((int)gridDim.x)
#define BX_ ((int)blockIdx.x)
#define VCU_ ((G_ % 8 == 0) ? (BX_ % 8) * (G_ / 8) + BX_ / 8 : BX_)
#define GW_ (VCU_ * NWAVES + wave)
#define NGW_ (G_ * NWAVES)
#define MISC_ ((volatile LAS unsigned*)(lds + LDSCTL_OFF))
    for (int u = threadIdx.x; u < (LDS_BYTES - LDSCTL_OFF) / 4; u += NWAVES * 64) ((LAS unsigned*)(lds + LDSCTL_OFF))[u] = 0u;
    __syncthreads();
#if !MK_PER_PHASE
    { CArgs* A = ARGS(); (void)xcd_barrier_post((unsigned*)((gu32*)(A->ws + WS_CTL) + CW_BAR), MISC_ + 8); }
#define GRID_BAR() do { CArgs* A_ = ARGS(); XcdBarrier b_; b_.bar = (unsigned*)((gu32*)(A_->ws + WS_CTL) + CW_BAR); b_.x = xb_xcc_id(); b_.st = MISC_ + 8; xcd_barrier(b_); } while (0)
#define IN(k) true
#else
#define GRID_BAR() do { } while (0)
    const int lo = ARGS()->ph_lo, hi = ARGS()->ph_hi;
#define IN(k) (lo <= (k) && (k) < hi)
#endif
#ifdef ONLY_OFF
#define INL(o) ((o) == ONLY_OFF && IN(pb + (o)))
#else
#define INL(o) IN(pb + (o))
#endif

    if (IN(0)) { TIDS(); p0_prologue(ARGS(), lds, tid, lane, wave, VCU_, G_); GRID_BAR(); }

    for (int l = 0; l < 2; ++l) {
        const int pb = 1 + 8 * l;
        if (INL(0)) { TIDS(); CArgs* A = ARGS(); unsigned char* ws = A->ws;
            norm_phase((l == 0) ? A->in[0] : A->out, A->in[4] + l * D, (const float*)(ws + WS_MOD) + (size_t)l * 16 * NMOD, 0, 1, (bf16*)(ws + WS_HN), GW_, NGW_, lane); GRID_BAR(); }
        if (INL(1)) { TIDS(); CArgs* A = ARGS(); unsigned char* ws = A->ws;
            pg8::Gemm g{(const bf16*)(ws + WS_HN), (const bf16*)(ws + WS_WIN) + (size_t)l * NP * D, M, NP, D}; pg8::StaticOrder S; S.init(M, NP, G_, BX_);
            pg8::EpiProj E{(bf16*)(ws + WS_PROJ), A->in[9] + l * 512};
            pg8::gemm_phase<pg8::EpiProj, pg8::StaticOrder, true, true>(lds + RING_OFF, g, S, E);
            GRID_BAR();
        }
        if (INL(2)) { TIDS(); CArgs* A = ARGS(); unsigned char* ws = A->ws;
            const bf16* PROJ = (const bf16*)(ws + WS_PROJ); bf16* CAT = (bf16*)(ws + WS_HN); gu32* ctl = (gu32*)(ws + WS_CTL);
            const float lam = ((const float*)(ws + WS_SCAL))[l], subscale = (1.f - (l == 0 ? 0.2f : 0.35550906759096926f)) * (1.f + DBG_A[3 * l + 0]); const float ogs = 1.f + DBG_A[3 * l + 1];
            volatile LAS unsigned* qslot = MISC_ + 16;
            for (;;) {
                if (tid == 0) *qslot = __hip_atomic_fetch_add(ctl + CW_QUEUE + 64 * l, 1u, RLX_AGENT);
                __syncthreads();
                const unsigned u = *qslot;
                __syncthreads();
                if (u >= (unsigned)MIX_UNITS) break;
                if (u < (unsigned)GLA_UNITS) {
#ifndef NO_GLA
                    gla_naive_unit(PROJ, CAT, (int)u >> 2, (int)u & 3, ogs, A->in[10] + l * 256, (LAS float*)(lds + RING_OFF), tid);
#endif
                } else {
#ifndef NO_ATT
                    const int idx = (int)u - GLA_UNITS, qb = 15 - idx / 128, bh = idx % 128;
                    attn_naive_unit(PROJ, CAT, bh >> 3, bh & 7, qb, lam, subscale, A->in[7] + l * 128, (LAS float*)(lds + RING_OFF), tid);
#endif
                }
            }
            GRID_BAR();
        }
        if (INL(3)) { TIDS(); CArgs* A = ARGS(); unsigned char* ws = A->ws;
            pg8::Gemm g{(const bf16*)(ws + WS_HN), (const bf16*)(ws + WS_WO) + (size_t)l * D * D, M, D, D}; pg8::StaticOrder S; S.init(M, D, G_, BX_);
            pg8::EpiRes E{(l == 0) ? A->in[0] : A->out, A->out, (const float*)(ws + WS_MOD) + (size_t)l * 16 * NMOD + 2 * D, 1.f};
            pg8::gemm_phase<pg8::EpiRes, pg8::StaticOrder, true, true>(lds + RING_OFF, g, S, E);
            GRID_BAR();
        }
        if (INL(4)) { TIDS(); CArgs* A = ARGS(); unsigned char* ws = A->ws;
            norm_phase(A->out, A->in[12] + l * D, (const float*)(ws + WS_MOD) + (size_t)l * 16 * NMOD, 3, 4, (bf16*)(ws + WS_HN), GW_, NGW_, lane); GRID_BAR(); }
        if (INL(5)) { TIDS(); CArgs* A = ARGS(); unsigned char* ws = A->ws;
            pg8::Gemm g{(const bf16*)(ws + WS_HN), (const bf16*)(ws + WS_WUP) + (size_t)l * NUP * D, M, NUP, D}; pg8::StaticOrder S; S.init(M, NUP, G_, BX_);
            pg8::EpiUp E{(bf16*)(ws + WS_PROJ), A->in[14] + (size_t)l * 3 * FF, A->in[15] + l * FF, (float*)(ws + WS_HALO), (float*)(ws + WS_HALO + HALO_ONE), (float*)(ws + WS_HALO + 2 * HALO_ONE), (LAS float*)(lds + BND_OFF)};
            pg8::gemm_phase<pg8::EpiUp, pg8::StaticOrder, true, true>(lds + RING_OFF, g, S, E);
            GRID_BAR();
        }
        if (INL(6)) { TIDS(); CArgs* A = ARGS(); unsigned char* ws = A->ws;
            fixup_phase((const float*)(ws + WS_HALO), (const float*)(ws + WS_HALO + HALO_ONE), (const float*)(ws + WS_HALO + 2 * HALO_ONE), A->in[14] + (size_t)l * 3 * FF, A->in[15] + l * FF, (bf16*)(ws + WS_PROJ), BX_ * (NWAVES * 64) + tid, G_ * NWAVES * 64); GRID_BAR(); }
        if (INL(7)) { TIDS(); CArgs* A = ARGS(); unsigned char* ws = A->ws;
            pg8::Gemm g{(const bf16*)(ws + WS_PROJ), (const bf16*)(ws + WS_WDN) + (size_t)l * D * FF, M, D, FF}; pg8::StaticOrder S; S.init(M, D, G_, BX_);
            pg8::EpiRes E{A->out, A->out, (const float*)(ws + WS_MOD) + (size_t)l * 16 * NMOD + 5 * D, 1.f + DBG_A[3 * l + 2]};
            pg8::gemm_phase<pg8::EpiRes, pg8::StaticOrder, true, true>(lds + RING_OFF, g, S, E);
            GRID_BAR();
        }
    }
    if (IN(17)) { TIDS(); CArgs* A = ARGS(); final_norm_phase(A->out, A->in[17], GW_, NGW_, lane); }
#undef IN
#undef INL
#undef GRID_BAR
}

extern "C" void kernel_launch(void* const* d_in, const int* in_sizes, int n_in, void* d_out, int out_size, void* d_ws, size_t ws_size, hipStream_t stream) {
    static int grid = 0;
    if (grid == 0) {
        if (n_in != 18 || in_sizes[0] != M * D || out_size != M * D || ws_size < WS_END) { fprintf(stderr, "kernel_launch: unexpected shapes / workspace (%d inputs, ws %zu); nothing launched\n", n_in, ws_size); grid = -1; return; }
        int dev = 0, cus = 0, per_cu = 0;
        if (hipGetDevice(&dev) != hipSuccess || hipDeviceGetAttribute(&cus, hipDeviceAttributeMultiprocessorCount, dev) != hipSuccess) { grid = -1; return; }
        if (hipFuncSetAttribute((const void*)fwd_kernel, hipFuncAttributeMaxDynamicSharedMemorySize, LDS_BYTES) != hipSuccess) { fprintf(stderr, "kernel_launch: hipFuncSetAttribute failed\n"); grid = -1; return; }
        if (hipOccupancyMaxActiveBlocksPerMultiprocessor(&per_cu, (const void*)fwd_kernel, NWAVES * 64, LDS_BYTES) != hipSuccess || per_cu < 1) { fprintf(stderr, "kernel_launch: occupancy query reports %d\n", per_cu); }
        (void)hipGetLastError();
        grid = cus;
    }
    if (grid < 0) return;
    if (hipMemsetAsync((char*)d_ws + WS_CTL, 0, CTL_ZERO_BYTES, stream) != hipSuccess) return;
    Args a{};
    for (int i = 0; i < 18; ++i) a.in[i] = (const float*)d_in[i];
    a.out = (float*)d_out; a.ws = (unsigned char*)d_ws;
#if MK_PER_PHASE
    for (int p = 0; p < N_PHASES; ++p) { a.ph_lo = p; a.ph_hi = p + 1; hipLaunchKernelGGL(fwd_kernel, dim3(grid), dim3(NWAVES * 64), LDS_BYTES, stream, a);
#ifdef DBG_CHECK
#define DBGK(w) hipLaunchKernelGGL(dbg_kernel, dim3(1), dim3(64), 0, stream, a, (w), DBG_LAYER)
        const int pb = 1 + 8 * DBG_LAYER;
        if (p == 0) { DBGK(0); DBGK(10); }
        if (p == pb + 0) DBGK(1);
        if (p == pb + 1) { DBGK(2); DBGK(3); }
        if (p == pb + 2) { DBGK(4); DBGK(5); }
        if (p == pb + 3) { DBGK(6); DBGK(8); }
        if (p == pb + 6) DBGK(7);
        if (p == pb + 7) DBGK(9);
        if (p == N_PHASES - 1) hipLaunchKernelGGL(dbg_emit, dim3(1), dim3(64), 0, stream, a, DBG_LO);
#endif
    }
#else
    a.ph_lo = 0; a.ph_hi = N_PHASES;
    hipLaunchKernelGGL(fwd_kernel, dim3(grid), dim3(NWAVES * 64), LDS_BYTES, stream, a);
#endif
}
```

```cpp
#include <hip/hip_runtime.h>
#include <cstdio>
#include <cstdint>
namespace pg8 {
#define PG8_LAS __attribute__((address_space(3)))
typedef unsigned short bf16_t;
typedef short bf16x8 __attribute__((ext_vector_type(8)));
typedef float f32x4 __attribute__((ext_vector_type(4)));
typedef unsigned u32x4 __attribute__((ext_vector_type(4)));
constexpr int BM = 256, BK = 64, HALF = 128, HTB = HALF * BK * 2  , STAGE_BYTES = 8 * HTB, NXCD = 8, WGM = 8;

__host__ __device__ __forceinline__ int lds_byte(int r, int c) { const int st = (r >> 4) * 2 + (c >> 5), rr = r & 15, cc = c & 31, ob = rr * 64 + cc * 2; return st * 1024 + (ob ^ (((ob >> 9) & 1) << 5)); }
__host__ __device__ __forceinline__ void stage_rc(int b, int& R, int& C) { const int st = b / 1024, sb = b % 1024, swz = sb ^ (((sb >> 9) & 1) << 5); R = (st >> 1) * 16 + swz / 64; C = (st & 1) * 32 + (swz % 64) / 2; }
__host__ __device__ __forceinline__ int perm32(int rho) { const int n = rho >> 4, i = rho & 15; return 8 * (i >> 2) + 4 * n + (i & 3); }

struct Unit { int pm, pn; };
struct Gemm { const bf16_t* A; const bf16_t* Bt; int M, N, K; };

struct StaticOrder {
    int nM, nN, nwg, G, c;
    __host__ __device__ void init(int M, int N, int G_, int c_) { nM = M / BM; nN = N / BM; nwg = nM * nN; G = G_; c = c_; }
    __host__ __device__ bool next(int i, Unit& u) const {
        const long L = (long)i * G + c; if (L >= nwg) return false;
        int wgid = (int)L; { const int q = nwg / NXCD, r = nwg % NXCD, xcd = wgid % NXCD, off = wgid / NXCD; wgid = (xcd < r ? xcd * (q + 1) : r * (q + 1) + (xcd - r) * q) + off; }
        const int nig = WGM * nN, gid = wgid / nig, fm = gid * WGM, gsz = (nM - fm) < WGM ? (nM - fm) : WGM;
        u.pm = fm + ((wgid % nig) % gsz); u.pn = (wgid % nig) / gsz; return true;
    }
    __device__ __forceinline__ void a_ready(const Unit&) const {}
    __device__ __forceinline__ void done(const Unit&) const {}
};

__device__ __forceinline__ unsigned cvt_pk_bf16(float lo, float hi) { unsigned r; asm volatile("v_cvt_pk_bf16_f32 %0, %1, %2" : "=v"(r) : "v"(lo), "v"(hi)); return r; }
typedef float f32x2 __attribute__((ext_vector_type(2)));
__device__ __forceinline__ f32x2 gelu_pk(f32x2 v) {
    const f32x2 av = __builtin_elementwise_abs(v), d = av * 0.2316418882f + 1.0f;
    f32x2 t; t.x = __builtin_amdgcn_rcpf(d.x); t.y = __builtin_amdgcn_rcpf(d.y);
    f32x2 q = t * 0.5307027145f + (-0.7265760135f); q = q * t + 0.7107068705f; q = q * t + (-0.142248368f); q = q * t + 0.127414796f; q = q * t;
    const f32x2 s = (v * v) * (-0.72134752044f);
    f32x2 e; e.x = __builtin_amdgcn_exp2f(s.x); e.y = __builtin_amdgcn_exp2f(s.y);
    const f32x2 m = v * (q * e), r = v - m;
    f32x2 o; o.x = v.x < 0.f ? m.x : r.x; o.y = v.y < 0.f ? m.y : r.y; return o;
}

constexpr float QSCALE = 0.125f * 1.4426950408889634f;
constexpr float GQSCALE = 0.08838834764831845f;
constexpr int NPW = 6656;

struct EpiProj {
    static constexpr bool PERM = true, AFTER_DRAIN = false;
    bf16_t* O; const float* bgk;
    __device__ __forceinline__ void operator()(const f32x4 (&acc)[2][2][4][2], const Unit& u, int wr, int wc, int fr, int fq) const {
        const int row0 = u.pm * BM + wr * 64 + fr, col0 = u.pn * BM + wc * 32 + 8 * fq, pn = u.pn;
        int mode = 0; float sc = 1.f;
        if (pn < 4) sc = QSCALE; else if (pn >= 12 && pn < 14) sc = GQSCALE; else if (pn >= 20 && pn < 24) mode = 1; else if (pn >= 24) mode = 2;
        f32x4 bv[2][2];
#pragma unroll
        for (int bj = 0; bj < 2; ++bj)
#pragma unroll
            for (int n = 0; n < 2; ++n) bv[bj][n] = (mode == 2) ? *(const f32x4*)(bgk + (col0 - 6144) + bj * HALF + 4 * n) : (f32x4){0.f, 0.f, 0.f, 0.f};
#pragma unroll
        for (int ai = 0; ai < 2; ++ai)
#pragma unroll
            for (int m = 0; m < 4; ++m) { bf16_t* rowp = O + (size_t)(row0 + ai * HALF + m * 16) * NPW + col0;
#pragma unroll
                for (int bj = 0; bj < 2; ++bj) { f32x4 v0 = acc[ai][bj][m][0] + bv[bj][0], v1 = acc[ai][bj][m][1] + bv[bj][1];
                    if (mode == 0) { v0 = v0 * sc; v1 = v1 * sc; }
                    else if (mode == 1) {
#pragma unroll
                        for (int e = 0; e < 4; ++e) { v0[e] = v0[e] * __builtin_amdgcn_rcpf(1.f + __builtin_amdgcn_exp2f(-1.4426950408889634f * v0[e])); v1[e] = v1[e] * __builtin_amdgcn_rcpf(1.f + __builtin_amdgcn_exp2f(-1.4426950408889634f * v1[e])); }
                    } else {
#pragma unroll
                        for (int e = 0; e < 4; ++e) {
                            { const float x = v0[e], ax = __builtin_fabsf(x); v0[e] = (__builtin_fminf(x, 0.f) - 0.6931471805599453f * __builtin_amdgcn_logf(1.f + __builtin_amdgcn_exp2f(-1.4426950408889634f * ax))) * 0.0625f; }
                            { const float x = v1[e], ax = __builtin_fabsf(x); v1[e] = (__builtin_fminf(x, 0.f) - 0.6931471805599453f * __builtin_amdgcn_logf(1.f + __builtin_amdgcn_exp2f(-1.4426950408889634f * ax))) * 0.0625f; } }
                    }
                    u32x4 w; w.x = cvt_pk_bf16(v0[0], v0[1]); w.y = cvt_pk_bf16(v0[2], v0[3]); w.z = cvt_pk_bf16(v1[0], v1[1]); w.w = cvt_pk_bf16(v1[2], v1[3]);
                    *(u32x4*)(rowp + bj * HALF) = w; } }
    }
};

struct EpiRes {
    static constexpr bool PERM = false, AFTER_DRAIN = false;
    const float* xin; float* out; const float* gate; float gs;
    __device__ __forceinline__ void operator()(const f32x4 (&acc)[2][2][4][2], const Unit& u, int wr, int wc, int fr, int fq) const {
        const int col0 = u.pn * BM + wc * 32 + 4 * fq; const float* g = gate + (size_t)(u.pm >> 3) * 12288;
        f32x4 gv[2][2];
#pragma unroll
        for (int bj = 0; bj < 2; ++bj)
#pragma unroll
            for (int n = 0; n < 2; ++n) gv[bj][n] = *(const f32x4*)(g + col0 + bj * HALF + n * 16) * gs;
#pragma unroll
        for (int ai = 0; ai < 2; ++ai)
#pragma unroll
            for (int m = 0; m < 4; ++m) { const size_t off = (size_t)(u.pm * BM + ai * HALF + wr * 64 + m * 16 + fr) * 2048 + col0;
#pragma unroll
                for (int bj = 0; bj < 2; ++bj)
#pragma unroll
                    for (int n = 0; n < 2; ++n) { const f32x4 xi = *(const f32x4*)(xin + off + bj * HALF + n * 16); *(f32x4*)(out + off + bj * HALF + n * 16) = xi + gv[bj][n] * acc[ai][bj][m][n]; }
                if (m & 1) asm volatile("" ::: "memory"); }
    }
};

__device__ __forceinline__ float dpp_shr1(float oldv, float src) { return __builtin_bit_cast(float, __builtin_amdgcn_update_dpp(__builtin_bit_cast(int, oldv), __builtin_bit_cast(int, src), 0x111, 0xF, 0xF, false)); }
__device__ __forceinline__ float dpp_shr2(float oldv, float src) { return __builtin_bit_cast(float, __builtin_amdgcn_update_dpp(__builtin_bit_cast(int, oldv), __builtin_bit_cast(int, src), 0x112, 0xF, 0xF, false)); }
__device__ __forceinline__ float dpp_ror1(float src) { return __builtin_bit_cast(float, __builtin_amdgcn_update_dpp(0, __builtin_bit_cast(int, src), 0x121, 0xF, 0xF, false)); }
__device__ __forceinline__ float dpp_ror2(float src) { return __builtin_bit_cast(float, __builtin_amdgcn_update_dpp(0, __builtin_bit_cast(int, src), 0x122, 0xF, 0xF, false)); }
struct EpiUp {
    static constexpr bool PERM = true, AFTER_DRAIN = false;
    bf16_t* act; const float* wconv; const float* bconv; float* glast; float* gfirst; float* ufirst; PG8_LAS float* bnd;
    __device__ __forceinline__ void operator()(const f32x4 (&acc)[2][2][4][2], const Unit& u, int wr, int wc, int fr, int fq) const {
        const int cl = wc * 32 + 8 * fq, c0 = u.pn * 128 + cl;
        f32x4 w0[2], w1[2], w2[2], cb[2];
#pragma unroll
        for (int n = 0; n < 2; ++n) { w0[n] = *(const f32x4*)(wconv + c0 + 4 * n); w1[n] = *(const f32x4*)(wconv + 5632 + c0 + 4 * n); w2[n] = *(const f32x4*)(wconv + 2 * 5632 + c0 + 4 * n); cb[n] = *(const f32x4*)(bconv + c0 + 4 * n); }
        if (fr >= 14) {
#pragma unroll
            for (int ai = 0; ai < 2; ++ai)
#pragma unroll
                for (int n = 0; n < 2; ++n) *(PG8_LAS f32x4*)(bnd + ((2 * ai + wr) * 2 + (fr - 14)) * 128 + cl + 4 * n) = acc[ai][1][3][n];
            if (wr == 1) {
#pragma unroll
                for (int n = 0; n < 2; ++n) *(f32x4*)(glast + ((size_t)u.pm * 2 + (fr - 14)) * 5632 + c0 + 4 * n) = acc[1][1][3][n]; }
        }
        if (wr == 0 && fr < 2) {
#pragma unroll
            for (int n = 0; n < 2; ++n) { *(f32x4*)(gfirst + ((size_t)u.pm * 2 + fr) * 5632 + c0 + 4 * n) = acc[0][1][0][n]; *(f32x4*)(ufirst + ((size_t)u.pm * 2 + fr) * 5632 + c0 + 4 * n) = acc[0][0][0][n]; }
        }
        asm volatile("s_waitcnt lgkmcnt(0)" ::: "memory"); __builtin_amdgcn_s_barrier(); asm volatile("" ::: "memory");
#pragma unroll
        for (int ai = 0; ai < 2; ++ai) {
            const int bp = 2 * ai + wr - 1;
            f32x4 h1[2], h2[2];
#pragma unroll
            for (int n = 0; n < 2; ++n) { if (bp >= 0) { h1[n] = *(const PG8_LAS f32x4*)(bnd + (bp * 2 + 1) * 128 + cl + 4 * n); h2[n] = *(const PG8_LAS f32x4*)(bnd + (bp * 2 + 0) * 128 + cl + 4 * n); } else { h1[n] = (f32x4){0.f, 0.f, 0.f, 0.f}; h2[n] = (f32x4){0.f, 0.f, 0.f, 0.f}; } }
#pragma unroll
            for (int m = 0; m < 4; ++m) {
                unsigned pk[4];
#pragma unroll
                for (int n = 0; n < 2; ++n) {
                    float a[4];
#pragma unroll
                    for (int e = 0; e < 4; ++e) {
                        const float cur = acc[ai][1][m][n][e]; float o1, o2;
                        if (m == 0) { o1 = h1[n][e]; o2 = (fr == 0) ? h2[n][e] : h1[n][e]; }
                        else { o1 = dpp_ror1(acc[ai][1][m - 1][n][e]); o2 = dpp_ror2(acc[ai][1][m - 1][n][e]); }
                        const float g1 = dpp_shr1(o1, cur), g2 = dpp_shr2(o2, cur);
                        a[e] = w0[n][e] * g2 + w1[n][e] * g1 + w2[n][e] * cur + cb[n][e];
                    }
                    const f32x2 ga = gelu_pk((f32x2){a[0], a[1]}), gb = gelu_pk((f32x2){a[2], a[3]});
                    pk[2 * n] = cvt_pk_bf16(ga.x * acc[ai][0][m][n][0], ga.y * acc[ai][0][m][n][1]); pk[2 * n + 1] = cvt_pk_bf16(gb.x * acc[ai][0][m][n][2], gb.y * acc[ai][0][m][n][3]);
                }
                u32x4 w; w.x = pk[0]; w.y = pk[1]; w.z = pk[2]; w.w = pk[3];
                *(u32x4*)(act + (size_t)(u.pm * BM + ai * HALF + wr * 64 + m * 16 + fr) * 5632 + c0) = w;
                asm volatile("" ::: "memory");
            }
        }
    }
};
template <class Epi, class Sched, bool ALIGN_EPI = false, bool SP2 = false>
__device__ __forceinline__ void gemm_phase(PG8_LAS unsigned char* lds, const Gemm g, const Sched& S, const Epi& E) {
    int tid_o = threadIdx.x; asm volatile("" : "+v"(tid_o));
    const int tid = tid_o, wid = __builtin_amdgcn_readfirstlane(tid >> 6), lane = tid & 63, wr = wid >> 2, wc = wid & 3, fr = lane & 15, fq = lane >> 4;
    const int K = g.K, nt = K / BK;
    unsigned voffA[2], voffB[2];
#pragma unroll
    for (int i = 0; i < 2; ++i) { int R, C; stage_rc(tid * 16 + i * 8192, R, C); const int Rb = Epi::PERM ? ((R & ~31) + perm32(R & 31)) : R;
        voffA[i] = (unsigned)(R * K + C) * 2u; voffB[i] = (unsigned)(Rb * K + C) * 2u; }
    const size_t kstep = (size_t)(BK * 2);
    const size_t hstep = (size_t)HALF * K * 2;
    const size_t tstep = 2 * hstep;
    const unsigned ldsw = (unsigned)wid * 1024u;
    const int aoff = lds_byte(wr * 64 + fr, fq * 8), boff = lds_byte(wc * 32 + fr, fq * 8);
#define PG8_SA(b, h) (((b) * 2 + (h)) * HTB)
#define PG8_SB(b, h) ((4 + (b) * 2 + (h)) * HTB)
#define PG8_STAGE(bufoff, gbase, voff) do { _Pragma("unroll") for (int _i = 0; _i < 2; ++_i) \
        __builtin_amdgcn_global_load_lds((const unsigned*)((const char*)(gbase) + (voff)[_i]), (PG8_LAS unsigned*)(lds + (bufoff) + ldsw + _i * 8192), 16, 0, 0); } while (0)
#define PG8_LDA(dst, b, h) do { _Pragma("unroll") for (int m = 0; m < 4; ++m) _Pragma("unroll") for (int k = 0; k < 2; ++k) dst[m][k] = *(const PG8_LAS bf16x8*)(lds + PG8_SA(b, h) + aoff + m * 2048 + k * 1024); } while (0)
#define PG8_LDB(dst, b, h) do { _Pragma("unroll") for (int n = 0; n < 2; ++n) _Pragma("unroll") for (int k = 0; k < 2; ++k) dst[n][k] = *(const PG8_LAS bf16x8*)(lds + PG8_SB(b, h) + boff + n * 2048 + k * 1024); } while (0)
#define PG8_MMA(ai, bj, At, Bt) do { __builtin_amdgcn_s_setprio(1); _Pragma("unroll") for (int m = 0; m < 4; ++m) _Pragma("unroll") for (int n = 0; n < 2; ++n) _Pragma("unroll") for (int k = 0; k < 2; ++k) \
        acc[ai][bj][m][n] = __builtin_amdgcn_mfma_f32_16x16x32_bf16(Bt[n][k], At[m][k], acc[ai][bj][m][n], 0, 0, 0); __builtin_amdgcn_s_setprio(0); } while (0)
#define PG8_WAIT_V(n) asm volatile("s_waitcnt vmcnt(" #n ")" ::: "memory")
#define PG8_WAIT_L(n) asm volatile("s_waitcnt lgkmcnt(" #n ")" ::: "memory")
#define PG8_BAR __builtin_amdgcn_s_barrier()
#define PG8_SCHED __builtin_amdgcn_sched_barrier(0)
    Unit cur, nxt; int ui = 0;
    if (!S.next(0, cur)) return;
    f32x4 acc[2][2][4][2];
#pragma unroll
    for (int a = 0; a < 2; ++a)
#pragma unroll
        for (int b = 0; b < 2; ++b)
#pragma unroll
            for (int m = 0; m < 4; ++m)
#pragma unroll
                for (int n = 0; n < 2; ++n) acc[a][b][m][n] = (f32x4){0.f, 0.f, 0.f, 0.f};
    bf16x8 At[4][2], B0[2][2], B1[2][2];
    const char* cA = (const char*)g.A + (size_t)cur.pm * tstep; const char* cB = (const char*)g.Bt + (size_t)cur.pn * tstep;
    S.a_ready(cur);
    if constexpr (SP2) {
        PG8_STAGE(PG8_SB(0, 0), cB, voffB); PG8_STAGE(PG8_SB(0, 1), cB + hstep, voffB); PG8_STAGE(PG8_SA(0, 0), cA, voffA); PG8_STAGE(PG8_SA(0, 1), cA + hstep, voffA);
        if (wr == 1) PG8_BAR;
        PG8_WAIT_V(2); PG8_BAR;
        PG8_STAGE(PG8_SB(1, 0), cB + kstep, voffB); PG8_STAGE(PG8_SA(1, 0), cA + kstep, voffA); PG8_STAGE(PG8_SB(1, 1), cB + hstep + kstep, voffB);
        PG8_WAIT_V(6); PG8_BAR;
    } else {
        PG8_STAGE(PG8_SB(0, 0), cB, voffB); PG8_STAGE(PG8_SA(0, 0), cA, voffA); PG8_STAGE(PG8_SB(0, 1), cB + hstep, voffB); PG8_STAGE(PG8_SA(0, 1), cA + hstep, voffA);
        if (wr == 1) PG8_BAR;
        PG8_WAIT_V(4); PG8_BAR;
        PG8_STAGE(PG8_SB(1, 0), cB + kstep, voffB); PG8_STAGE(PG8_SA(1, 0), cA + kstep, voffA); PG8_STAGE(PG8_SB(1, 1), cB + hstep + kstep, voffB);
        PG8_WAIT_V(6); PG8_BAR;
    }
    for (;;) {
        const bool has_next = S.next(ui + 1, nxt);
        const char* nA = has_next ? (const char*)g.A + (size_t)nxt.pm * tstep : cA; const char* nB = has_next ? (const char*)g.Bt + (size_t)nxt.pn * tstep : cB;
        for (int t = 0; t < nt; t += 2) {
            const bool last = (t == nt - 2);
            const char* a1 = cA + (size_t)(t + 1) * kstep;
            const char* a2 = last ? nA : cA + (size_t)(t + 2) * kstep; const char* b2 = last ? nB : cB + (size_t)(t + 2) * kstep;
            const char* a3 = a2 + kstep; const char* b3 = b2 + kstep;
            if (last && has_next) S.a_ready(nxt);
            if constexpr (SP2) {
            PG8_LDB(B0, 0, 0); PG8_LDB(B1, 0, 1); PG8_SCHED; PG8_LDA(At, 0, 0); PG8_STAGE(PG8_SA(1, 1), a1 + hstep, voffA);
            PG8_WAIT_V(8); PG8_WAIT_L(0); PG8_BAR; PG8_MMA(0, 0, At, B0); PG8_MMA(0, 1, At, B1); PG8_BAR; PG8_SCHED;
            PG8_LDA(At, 0, 1); PG8_STAGE(PG8_SB(0, 0), b2, voffB); PG8_STAGE(PG8_SB(0, 1), b2 + hstep, voffB); PG8_STAGE(PG8_SA(0, 0), a2, voffA);
            PG8_WAIT_V(8); PG8_WAIT_L(0); PG8_BAR; PG8_MMA(1, 0, At, B0); PG8_MMA(1, 1, At, B1); PG8_BAR; PG8_SCHED;
            PG8_LDB(B0, 1, 0); PG8_LDB(B1, 1, 1); PG8_SCHED; PG8_LDA(At, 1, 0); PG8_STAGE(PG8_SA(0, 1), a2 + hstep, voffA);
            PG8_WAIT_V(8); PG8_WAIT_L(0); PG8_BAR; PG8_MMA(0, 0, At, B0); PG8_MMA(0, 1, At, B1); PG8_BAR; PG8_SCHED;
            PG8_LDA(At, 1, 1); PG8_STAGE(PG8_SB(1, 0), b3, voffB); PG8_STAGE(PG8_SB(1, 1), b3 + hstep, voffB); PG8_STAGE(PG8_SA(1, 0), a3, voffA);
            PG8_WAIT_V(8); PG8_WAIT_L(0); PG8_BAR; PG8_MMA(1, 0, At, B0); PG8_MMA(1, 1, At, B1); PG8_BAR; PG8_SCHED;
            } else {
            PG8_LDB(B0, 0, 0); PG8_SCHED; PG8_LDA(At, 0, 0); PG8_STAGE(PG8_SA(1, 1), a1 + hstep, voffA);
            PG8_WAIT_L(8); PG8_BAR; PG8_WAIT_L(0); PG8_MMA(0, 0, At, B0); PG8_BAR; PG8_SCHED;
            PG8_LDB(B1, 0, 1); PG8_STAGE(PG8_SB(0, 0), b2, voffB);
            PG8_BAR; PG8_WAIT_L(0); PG8_MMA(0, 1, At, B1); PG8_BAR;
            PG8_LDA(At, 0, 1); PG8_STAGE(PG8_SA(0, 0), a2, voffA);
            PG8_BAR; PG8_WAIT_L(0); PG8_MMA(1, 0, At, B0); PG8_BAR; PG8_SCHED;
            PG8_STAGE(PG8_SB(0, 1), b2 + hstep, voffB);
            PG8_WAIT_V(6); PG8_BAR; PG8_MMA(1, 1, At, B1); PG8_BAR;
            PG8_LDB(B0, 1, 0); PG8_SCHED; PG8_LDA(At, 1, 0); PG8_STAGE(PG8_SA(0, 1), a2 + hstep, voffA);
            PG8_WAIT_L(8); PG8_BAR; PG8_WAIT_L(0); PG8_MMA(0, 0, At, B0); PG8_BAR; PG8_SCHED;
            PG8_LDB(B1, 1, 1); PG8_STAGE(PG8_SB(1, 0), b3, voffB);
            PG8_BAR; PG8_WAIT_L(0); PG8_MMA(0, 1, At, B1); PG8_BAR;
            PG8_LDA(At, 1, 1); PG8_STAGE(PG8_SA(1, 0), a3, voffA);
            PG8_BAR; PG8_WAIT_L(0); PG8_MMA(1, 0, At, B0); PG8_BAR; PG8_SCHED;
            PG8_STAGE(PG8_SB(1, 1), b3 + hstep, voffB);
            PG8_WAIT_V(6); PG8_BAR; PG8_MMA(1, 1, At, B1); PG8_BAR;
            }
        }
        if constexpr (ALIGN_EPI) { if (wr == 0) PG8_BAR; }
        if constexpr (!Epi::AFTER_DRAIN) { E(acc, cur, wr, wc, fr, fq); S.done(cur); }
        if (!has_next) break;
#pragma unroll
        for (int a = 0; a < 2; ++a)
#pragma unroll
            for (int b = 0; b < 2; ++b)
#pragma unroll
                for (int m = 0; m < 4; ++m)
#pragma unroll
                    for (int n = 0; n < 2; ++n) acc[a][b][m][n] = (f32x4){0.f, 0.f, 0.f, 0.f};
        cur = nxt; cA = nA; cB = nB; ++ui;
        if constexpr (ALIGN_EPI) { if (wr == 1) PG8_BAR; }
    }
    PG8_WAIT_V(0);
    if constexpr (!ALIGN_EPI) { if (wr == 0) PG8_BAR; }
    PG8_BAR;
    if constexpr (Epi::AFTER_DRAIN) { E.fused(acc, cur, wr, wc, fr, fq, lds, wid, lane); S.done(cur); }
#undef PG8_SA
#undef PG8_SB
#undef PG8_STAGE
#undef PG8_LDA
#undef PG8_LDB
#undef PG8_MMA
#undef PG8_WAIT_V
#undef PG8_WAIT_L
#undef PG8_BAR
#undef PG8_SCHED
}
}

constexpr int NB = 16, T = 2048, D = 2048, M = NB * T, NP = 6656, NIN = 6160, FF = 5632, NUP = 2 * FF, NMOD = 12288;
constexpr float EPS = 1e-6f, LOG2E = 1.4426950408889634f;
constexpr int NWAVES = 8;
constexpr size_t MiB = 1u << 20;
constexpr size_t WS_CTL = 0, CTL_ZERO_BYTES = 1 * MiB;
constexpr size_t WS_MOD = 1 * MiB;
constexpr size_t WS_SCAL = 3 * MiB;
constexpr size_t WS_WIN = 4 * MiB;
constexpr size_t WS_WO = 56 * MiB;
constexpr size_t WS_WUP = 72 * MiB;
constexpr size_t WS_WDN = 160 * MiB;
constexpr size_t WS_HALO = 204 * MiB;
constexpr size_t HALO_ONE = (size_t)128 * 2 * 5632 * 4;
constexpr size_t WS_HN = 224 * MiB;
constexpr size_t WS_PROJ = 352 * MiB;
constexpr size_t WS_END = 768 * MiB;
static_assert(WS_WIN + (size_t)2 * NP * D * 2 <= WS_WO && WS_WO + (size_t)2 * D * D * 2 <= WS_WUP && WS_WUP + (size_t)2 * NUP * D * 2 <= WS_WDN && WS_WDN + (size_t)2 * D * FF * 2 <= WS_HALO &&
              WS_HALO + 3 * HALO_ONE <= WS_HN && WS_HN + (size_t)M * D * 2 <= WS_PROJ && WS_PROJ + (size_t)M * NP * 2 <= WS_END, "d_ws map");
constexpr int CW_TMO = 0, CW_CODE = 1, CW_BAR = 4096, CW_QUEUE = 16384;
constexpr int RING_OFF = 0, RING_BYTES = 131072, BND_OFF = RING_BYTES, LDSCTL_OFF = BND_OFF + 4096, LDS_BYTES = 147456;

#define GAS __attribute__((address_space(1)))
#define LAS __attribute__((address_space(3)))
typedef unsigned short bf16;
typedef unsigned v4u __attribute__((ext_vector_type(4)));
typedef unsigned v2u __attribute__((ext_vector_type(2)));
typedef float f32x4 __attribute__((ext_vector_type(4)));
typedef GAS unsigned gu32;
#define RLX_AGENT __ATOMIC_RELAXED, __HIP_MEMORY_SCOPE_AGENT
#define LDS_WAIT() asm volatile("s_waitcnt lgkmcnt(0)" ::: "memory")
__device__ __forceinline__ unsigned f2bf(float f) { unsigned u = __builtin_bit_cast(unsigned, f); return (u + 0x7fffu + ((u >> 16) & 1u)) >> 16; }
__device__ __forceinline__ unsigned pk2(float lo, float hi) { return f2bf(lo) | (f2bf(hi) << 16); }
__device__ __forceinline__ float bf2f(unsigned short h) { return __builtin_bit_cast(float, (unsigned)h << 16); }
__device__ __forceinline__ float bflo(unsigned w) { return __builtin_bit_cast(float, w << 16); }
__device__ __forceinline__ float bfhi(unsigned w) { return __builtin_bit_cast(float, w & 0xffff0000u); }
#define DPPF(v, ctrl) __builtin_bit_cast(float, __builtin_amdgcn_update_dpp(0, __builtin_bit_cast(int, (v)), (ctrl), 0xF, 0xF, true))
__device__ __forceinline__ float wave_sum(float v) {
    v += DPPF(v, 0xB1);
    v += DPPF(v, 0x4E);
    v += DPPF(v, 0x141);
    v += DPPF(v, 0x140);
    v += __builtin_bit_cast(float, __builtin_amdgcn_ds_swizzle(__builtin_bit_cast(int, v), 0x401F));
    float a = v, b = v;
    asm volatile("s_nop 1\n\tv_permlane32_swap_b32_e32 %0, %1\n\ts_nop 1" : "+v"(a), "+v"(b));
    return a + b;
}
struct Args { const float* in[18]; float* out; unsigned char* ws; int ph_lo, ph_hi, pad0, pad1; };
typedef const __attribute__((address_space(4))) Args CArgs;
#define ARGS() ({ CArgs* p_ = (CArgs*)__builtin_amdgcn_kernarg_segment_ptr(); asm volatile("" : "+s"(p_)); p_; })
#define XB_TMO      128
#define XB_XCNT(j)  (256  + 64 * (j))
#define XB_XSUB(j)  (1280 + 64 * (j))
#define XB_XGEN(j)  (2304 + 64 * (j))
#define XB_TOP      3328
#define XB_TOPGEN   3392
#define XCD_BAR_WORDS 3456
#define XB_SPIN_CAP (1u << 18)

__device__ __forceinline__ unsigned xb_ld(unsigned* p)              { return __hip_atomic_load(p, __ATOMIC_RELAXED, __HIP_MEMORY_SCOPE_AGENT); }
__device__ __forceinline__ unsigned xb_add(unsigned* p, unsigned v) { return __hip_atomic_fetch_add(p, v, __ATOMIC_RELAXED, __HIP_MEMORY_SCOPE_AGENT); }
__device__ __forceinline__ unsigned xb_xcc_id() { return (unsigned)__builtin_amdgcn_s_getreg((3 << 11) | 20) & 0xFu; }
#define XB_SPIN(cond, bar) do { unsigned _sp = 0; while (cond) { __builtin_amdgcn_s_sleep(1); \
    if ((++_sp & 255u) == 0u) { if (xb_ld(&(bar)[XB_TMO])) break; if (_sp > XB_SPIN_CAP) { atomicAdd(&(bar)[XB_TMO], 1u); break; } } } } while (0)

struct XcdBarrier {
    unsigned* bar; unsigned x;
    volatile LAS unsigned* st;
};

__device__ __forceinline__ XcdBarrier xcd_barrier_post(unsigned* bar, volatile LAS unsigned* st) {
    XcdBarrier b; b.bar = bar; b.x = xb_xcc_id(); b.st = st;
    if (threadIdx.x == 0) (void)xb_add(&bar[XB_XCNT(b.x)], 1u);
    return b;
}
__device__ __forceinline__ void xcd_barrier_complete(unsigned* bar, unsigned x, unsigned& nloc, unsigned& nx) {
    const unsigned G = gridDim.x * gridDim.y * gridDim.z;
    unsigned sum, cnt, mine, sp = 0u;
    for (;;) {
        sum = 0u; cnt = 0u; mine = 0u;
#pragma unroll
        for (unsigned j = 0; j < 16; ++j) { const unsigned c = xb_ld(&bar[XB_XCNT(j)]); sum += c; cnt += (c > 0u) ? 1u : 0u; mine = (j == x) ? c : mine; }
        if (sum == G) break;
        __builtin_amdgcn_s_sleep(1);
        if ((++sp & 255u) == 0u) { if (xb_ld(&bar[XB_TMO])) break; if (sp > XB_SPIN_CAP) { atomicAdd(&bar[XB_TMO], 1u); break; } }
    }
    nloc = mine > 0u ? mine : 1u; nx = cnt > 0u ? cnt : 1u;
}

__device__ __forceinline__ void xcd_barrier(const XcdBarrier& b) {
    asm volatile("s_waitcnt vmcnt(0)" ::: "memory");
    __syncthreads();
    if (threadIdx.x == 0) {
        unsigned* bar = b.bar;
        __builtin_amdgcn_s_waitcnt(0);
        unsigned nloc = b.st[0], nx = b.st[1];
        if (nloc == 0u) { xcd_barrier_complete(bar, b.x, nloc, nx); b.st[0] = nloc; b.st[1] = nx; }
        const unsigned old = xb_add(&bar[XB_XSUB(b.x)], 1u);
        const unsigned gen = old / nloc;
        if (old + 1u == (gen + 1u) * nloc) {
            __builtin_amdgcn_fence(__ATOMIC_RELEASE, "agent");
            asm volatile("s_waitcnt vmcnt(0)" ::: "memory");
            const unsigned og = xb_add(&bar[XB_TOP], 1u);
            const unsigned tg = og / nx;
            if (og + 1u == (tg + 1u) * nx) xb_add(&bar[XB_TOPGEN], 1u);
            else XB_SPIN(xb_ld(&bar[XB_TOPGEN]) == tg, bar);
            __builtin_amdgcn_fence(__ATOMIC_ACQUIRE, "agent");
            xb_add(&bar[XB_XGEN(b.x)], 1u);
            asm volatile("s_waitcnt vmcnt(0)" ::: "memory");
        } else {
            XB_SPIN(xb_ld(&bar[XB_XGEN(b.x)]) == gen, bar);
            __builtin_amdgcn_fence(__ATOMIC_ACQUIRE, "agent");
            asm volatile("s_waitcnt vmcnt(0)" ::: "memory");
        }
    }
    __syncthreads();
}


__device__ __forceinline__ void p0_write_item(bf16* WT, int K, int dst_row, int k0, LAS float* scr, int lane) {
    LDS_WAIT(); asm volatile("" ::: "memory");
    const int c = lane & 7;
#pragma unroll
    for (int j = 0; j < 4; ++j) { const int n = (lane >> 3) + 8 * j; const LAS float* s = scr + (8 * c) * 33 + n;
        v4u o; o.x = pk2(s[0 * 33], s[1 * 33]); o.y = pk2(s[2 * 33], s[3 * 33]); o.z = pk2(s[4 * 33], s[5 * 33]); o.w = pk2(s[6 * 33], s[7 * 33]);
        *(GAS v4u*)(WT + (size_t)(dst_row + n) * K + k0 + 8 * c) = o; }
    LDS_WAIT(); asm volatile("" ::: "memory");
}
__device__ __forceinline__ void p0_transpose_item(const float* W, int ldw, int K, bf16* WT, int dst_row, int k0, int n0, LAS float* scr, int lane) {
#pragma unroll 8
    for (int i = 0; i < 32; ++i) { const int kk = 2 * i + (lane >> 5); scr[kk * 33 + (lane & 31)] = W[(size_t)(k0 + kk) * ldw + n0 + (lane & 31)]; }
    p0_write_item(WT, K, dst_row, k0, scr, lane);
}
__device__ __forceinline__ void p0_weff_item(const float* Win, const float* Wgk, bf16* WT, int k0, int n0, LAS float* scr, int lane) {
    const int n = lane & 31;
    float g[16];
#pragma unroll
    for (int r = 0; r < 16; ++r) g[r] = Wgk[r * 512 + n0 + n];
#pragma unroll 4
    for (int i = 0; i < 32; ++i) { const int kk = 2 * i + (lane >> 5); const float* wr = Win + (size_t)(k0 + kk) * NIN + 6144; float s = 0.f;
#pragma unroll
        for (int r = 0; r < 16; ++r) s += wr[r] * g[r];
        scr[kk * 33 + n] = s; }
    p0_write_item(WT, D, 6144 + n0, k0, scr, lane);
}

__device__ __forceinline__ void p0_prologue(const CArgs* ap, LAS unsigned char* lds, int tid, int lane, int wave, int vcu, int G) {
    unsigned char* ws = ap->ws;
    float* MOD = (float*)(ws + WS_MOD); float* SCAL = (float*)(ws + WS_SCAL);
    if (blockIdx.x < 96) {
        const int l = blockIdx.x / 48, cg = blockIdx.x % 48;
        LAS float* cs = (LAS float*)(lds + wave * 16384);
        const float* c = ap->in[1];
        for (int i = 0; i < 64; ++i) { const int e = lane + 64 * i, bb = e & 15, kk = e >> 4; const float cv = c[bb * D + 256 * wave + kk]; cs[kk * 16 + bb] = cv / (1.f + __expf(-cv)); }
        LDS_WAIT(); asm volatile("" ::: "memory");
        const float* W = ap->in[2] + (size_t)l * D * NMOD + (size_t)(256 * wave) * NMOD + 256 * cg + 4 * lane;
        f32x4 acc[16];
#pragma unroll
        for (int i = 0; i < 16; ++i) acc[i] = (f32x4){0.f, 0.f, 0.f, 0.f};
#pragma unroll 4
        for (int kk = 0; kk < 256; ++kk) { const f32x4 w = __builtin_nontemporal_load((const f32x4*)(W + (size_t)kk * NMOD));
#pragma unroll
            for (int q4 = 0; q4 < 4; ++q4) { const f32x4 c4 = *(const LAS f32x4*)(cs + kk * 16 + 4 * q4);
                acc[4 * q4 + 0] += c4.x * w; acc[4 * q4 + 1] += c4.y * w; acc[4 * q4 + 2] += c4.z * w; acc[4 * q4 + 3] += c4.w * w; } }
        __syncthreads();
        LAS float* red = (LAS float*)lds;
#pragma unroll
        for (int bb = 0; bb < 16; ++bb) *(LAS f32x4*)(red + (wave * 16 + bb) * 256 + 4 * lane) = acc[bb];
        __syncthreads();
        for (int i = 0; i < 8; ++i) { const int o = tid + 512 * i, bb = o >> 8, col = o & 255; float s = ap->in[3][l * NMOD + 256 * cg + col];
#pragma unroll
            for (int w = 0; w < 8; ++w) s += red[(w * 16 + bb) * 256 + col];
            MOD[(size_t)(l * 16 + bb) * NMOD + 256 * cg + col] = s; }
        __syncthreads();
    }
    if (blockIdx.x == 96 && wave == 0) {
        for (int l = 0; l < 2; ++l) { const float* dl = ap->in[6] + l * 256; float s1 = dl[lane] * dl[64 + lane], s2 = dl[128 + lane] * dl[192 + lane];
            s1 = wave_sum(s1); s2 = wave_sum(s2);
            if (lane == 0) SCAL[l] = __expf(s1) - __expf(s2) + (l == 0 ? 0.2f : 0.35550906759096926f); }
    }
    LAS float* scr = (LAS float*)(lds + wave * 16384);
    const int gw = vcu * NWAVES + wave, NGW = G * NWAVES;
    constexpr int I_IN = 32 * 192, I_EFF = 32 * 16, I_O = 32 * 64, I_UP = 32 * 352, I_DN = 88 * 64, I_L = I_IN + I_EFF + I_O + I_UP + I_DN;
    for (int it = gw; it < 2 * I_L; it += NGW) {
        const int l = it / I_L; int r = it % I_L;
        bf16* WINt = (bf16*)(ws + WS_WIN) + (size_t)l * NP * D; bf16* WOt = (bf16*)(ws + WS_WO) + (size_t)l * D * D;
        bf16* WUPt = (bf16*)(ws + WS_WUP) + (size_t)l * NUP * D; bf16* WDNt = (bf16*)(ws + WS_WDN) + (size_t)l * D * FF;
        const float* w_in = ap->in[5] + (size_t)l * D * NIN;
        if (r < I_IN) { const int kb = r / 192, nb = r % 192; p0_transpose_item(w_in, NIN, D, WINt, 32 * nb, 64 * kb, 32 * nb, scr, lane); continue; } r -= I_IN;
        if (r < I_EFF) { const int kb = r / 16, nb = r % 16; p0_weff_item(w_in, ap->in[8] + (size_t)l * 16 * 512, WINt, 64 * kb, 32 * nb, scr, lane); continue; } r -= I_EFF;
        if (r < I_O) { const int kb = r / 64, nb = r % 64; p0_transpose_item(ap->in[11] + (size_t)l * D * D, D, D, WOt, 32 * nb, 64 * kb, 32 * nb, scr, lane); continue; } r -= I_O;
        if (r < I_UP) { const int kb = r / 352, nb = r % 352, n0 = 32 * nb; const int n1 = n0 < FF ? n0 : n0 - FF; const int dst = 256 * (n1 / 128) + (n1 % 128) + (n0 < FF ? 0 : 128);
            p0_transpose_item(ap->in[13] + (size_t)l * D * NUP, NUP, D, WUPt, dst, 64 * kb, n0, scr, lane); continue; } r -= I_UP;
        { const int kb = r / 64, nb = r % 64; p0_transpose_item(ap->in[16] + (size_t)l * FF * D, D, FF, WDNt, 32 * nb, 64 * kb, 32 * nb, scr, lane); }
    }
}

__device__ __forceinline__ void norm_phase(const float* xin, const float* g, const float* modl, int sh_chunk, int sc_chunk, bf16* outp, int gw, int NGW, int lane) {
    for (int rb = gw; rb < M / 16; rb += NGW) {
        const int b = rb >> 7; const float* mb = modl + (size_t)b * NMOD;
        f32x4 A[8], S[8];
#pragma unroll
        for (int j = 0; j < 8; ++j) { const int col = 4 * lane + 256 * j; const f32x4 gv = *(const f32x4*)(g + col), sc = *(const f32x4*)(mb + sc_chunk * D + col); A[j] = gv * (1.f + sc); S[j] = *(const f32x4*)(mb + sh_chunk * D + col); }
        for (int r = 0; r < 16; ++r) {
            const size_t row = (size_t)rb * 16 + r; const GAS f32x4* xr = (const GAS f32x4*)(xin + row * D) + lane;
            f32x4 v[8]; float s = 0.f;
#pragma unroll
            for (int j = 0; j < 8; ++j) { v[j] = xr[64 * j]; s += (v[j].x * v[j].x + v[j].y * v[j].y) + (v[j].z * v[j].z + v[j].w * v[j].w); }
            const float rstd = 1.f / sqrtf(wave_sum(s) * (1.f / D) + EPS);
            GAS v2u* o8 = (GAS v2u*)(outp + row * D) + lane;
#pragma unroll
            for (int j = 0; j < 8; ++j) { const f32x4 y = v[j] * rstd * A[j] + S[j]; v2u w; w.x = pk2(y.x, y.y); w.y = pk2(y.z, y.w); o8[64 * j] = w; }
        }
    }
}
__device__ __forceinline__ void final_norm_phase(float* x, const float* g, int gw, int NGW, int lane) {
    f32x4 A[8];
#pragma unroll
    for (int j = 0; j < 8; ++j) A[j] = *(const f32x4*)(g + 4 * lane + 256 * j);
    for (int row = gw; row < M; row += NGW) {
        GAS f32x4* xr = (GAS f32x4*)(x + (size_t)row * D) + lane;
        f32x4 v[8]; float s = 0.f;
#pragma unroll
        for (int j = 0; j < 8; ++j) { v[j] = xr[64 * j]; s += (v[j].x * v[j].x + v[j].y * v[j].y) + (v[j].z * v[j].z + v[j].w * v[j].w); }
        const float rstd = 1.f / sqrtf(wave_sum(s) * (1.f / D) + EPS);
#pragma unroll
        for (int j = 0; j < 8; ++j) xr[64 * j] = v[j] * rstd * A[j];
    }
}
__device__ __forceinline__ void fixup_phase(const float* glast, const float* gfirst, const float* ufirst, const float* wconv, const float* bconv, bf16* act, int gtid, int nthreads) {
    constexpr int PER_ROW = FF / 4, TOTAL = 112 * 2 * PER_ROW;
    for (int idx = gtid; idx < TOTAL; idx += nthreads) {
        const int c = (idx % PER_ROW) * 4, rr = (idx / PER_ROW) & 1, pmi = idx / (2 * PER_ROW), pm = (pmi / 7) * 8 + (pmi % 7) + 1;
        const f32x4 gl0 = *(const f32x4*)(glast + ((size_t)(pm - 1) * 2 + 0) * FF + c), gl1 = *(const f32x4*)(glast + ((size_t)(pm - 1) * 2 + 1) * FF + c);
        const f32x4 gf0 = *(const f32x4*)(gfirst + ((size_t)pm * 2 + 0) * FF + c), gf1 = *(const f32x4*)(gfirst + ((size_t)pm * 2 + 1) * FF + c);
        const f32x4 uu = *(const f32x4*)(ufirst + ((size_t)pm * 2 + rr) * FF + c);
        const f32x4 w0 = *(const f32x4*)(wconv + c), w1 = *(const f32x4*)(wconv + FF + c), w2 = *(const f32x4*)(wconv + 2 * FF + c), cb = *(const f32x4*)(bconv + c);
        const f32x4 y = rr == 0 ? (w0 * gl0 + w1 * gl1 + w2 * gf0 + cb) : (w0 * gl1 + w1 * gf0 + w2 * gf1 + cb);
        const pg8::f32x2 ga = pg8::gelu_pk((pg8::f32x2){y.x, y.y}), gb = pg8::gelu_pk((pg8::f32x2){y.z, y.w});
        v2u w; w.x = pk2(ga.x * uu.x, ga.y * uu.y); w.y = pk2(gb.x * uu.z, gb.y * uu.w);
        *(GAS v2u*)(act + (size_t)(256 * pm + rr) * FF + c) = w;
    }
}

__device__ __forceinline__ void attn_naive_unit(const bf16* P, bf16* CAT, int b, int h, int qb, float lam, float subscale, const float* gsub, LAS float* xch, int tid) {
    const int wave = tid >> 6, lane = tid & 63, mp = wave >> 2, dvh = (wave >> 1) & 1, rloc = (wave & 1) * 64 + lane, row = 128 * qb + rloc;
    const float slope2 = exp2f(-(float)(h + 1)) * LOG2E;
    const bf16* prow = P + (size_t)(b * T + row) * NP + h * 128 + mp * 64;
    float q[64];
#pragma unroll
    for (int d8 = 0; d8 < 8; ++d8) { const v4u w = *(const v4u*)(prow + 8 * d8); q[8 * d8 + 0] = bflo(w.x); q[8 * d8 + 1] = bfhi(w.x); q[8 * d8 + 2] = bflo(w.y); q[8 * d8 + 3] = bfhi(w.y); q[8 * d8 + 4] = bflo(w.z); q[8 * d8 + 5] = bfhi(w.z); q[8 * d8 + 6] = bflo(w.w); q[8 * d8 + 7] = bfhi(w.w); }
    float o[64];
#pragma unroll
    for (int i = 0; i < 64; ++i) o[i] = 0.f;
    float m = -1e30f, l = 0.f;
    const int kmax = __builtin_amdgcn_readfirstlane(128 * qb + (wave & 1) * 64 + 63);
    const bf16* kbase = P + (size_t)(b * T) * NP + 1024 + h * 128 + mp * 64;
    const bf16* vbase = P + (size_t)(b * T) * NP + 2048 + h * 128 + dvh * 64;
    for (int kv = 0; kv <= kmax; ++kv) {
        const bf16* kr = kbase + (size_t)kv * NP; float s = 0.f;
#pragma unroll
        for (int d8 = 0; d8 < 8; ++d8) { const v4u w = *(const v4u*)(kr + 8 * d8);
            s += q[8 * d8 + 0] * bflo(w.x) + q[8 * d8 + 1] * bfhi(w.x) + q[8 * d8 + 2] * bflo(w.y) + q[8 * d8 + 3] * bfhi(w.y) + q[8 * d8 + 4] * bflo(w.z) + q[8 * d8 + 5] * bfhi(w.z) + q[8 * d8 + 6] * bflo(w.w) + q[8 * d8 + 7] * bfhi(w.w); }
        s += slope2 * (float)(kv - row);
        if (kv <= row) {
            if (s > m) { const float al = exp2f(m - s); l *= al;
#pragma unroll
                for (int i = 0; i < 64; ++i) o[i] *= al;
                m = s; }
            const float p = exp2f(s - m); l += p;
            const bf16* vr = vbase + (size_t)kv * NP;
#pragma unroll
            for (int d8 = 0; d8 < 8; ++d8) { const v4u w = *(const v4u*)(vr + 8 * d8);
                o[8 * d8 + 0] += p * bflo(w.x); o[8 * d8 + 1] += p * bfhi(w.x); o[8 * d8 + 2] += p * bflo(w.y); o[8 * d8 + 3] += p * bfhi(w.y); o[8 * d8 + 4] += p * bflo(w.z); o[8 * d8 + 5] += p * bfhi(w.z); o[8 * d8 + 6] += p * bflo(w.w); o[8 * d8 + 7] += p * bfhi(w.w); }
        }
    }
    const float inv = 1.f / l;
    LAS float* ssx = xch + 128 * 128;
    if (mp == 1) {
#pragma unroll
        for (int i = 0; i < 64; ++i) xch[(dvh * 64 + i) * 128 + rloc] = o[i] * inv; }
    __syncthreads();
    if (mp == 0) {
        float ss = 0.f;
#pragma unroll
        for (int i = 0; i < 64; ++i) { o[i] = o[i] * inv - lam * xch[(dvh * 64 + i) * 128 + rloc]; ss += o[i] * o[i]; }
        ssx[dvh * 128 + rloc] = ss;
    }
    __syncthreads();
    if (mp == 0) {
        const float rstd = subscale / sqrtf((ssx[rloc] + ssx[128 + rloc]) * (1.f / 128.f) + EPS);
        bf16* orow = CAT + (size_t)(b * T + row) * D + h * 128 + dvh * 64; const float* gs = gsub + dvh * 64;
#pragma unroll
        for (int d8 = 0; d8 < 8; ++d8) { v4u w; w.x = pk2(o[8 * d8 + 0] * rstd * gs[8 * d8 + 0], o[8 * d8 + 1] * rstd * gs[8 * d8 + 1]); w.y = pk2(o[8 * d8 + 2] * rstd * gs[8 * d8 + 2], o[8 * d8 + 3] * rstd * gs[8 * d8 + 3]);
            w.z = pk2(o[8 * d8 + 4] * rstd * gs[8 * d8 + 4], o[8 * d8 + 5] * rstd * gs[8 * d8 + 5]); w.w = pk2(o[8 * d8 + 6] * rstd * gs[8 * d8 + 6], o[8 * d8 + 7] * rstd * gs[8 * d8 + 7]);
            *(GAS v4u*)(orow + 8 * d8) = w; }
    }
    __syncthreads();
}
__device__ __forceinline__ void gla_naive_unit(const bf16* P, bf16* CAT, int b, int h, float ogs, const float* gn, LAS float* lf, int tid) {
    const int e = tid & 255, dh = tid >> 8, wave = tid >> 6, lane = tid & 63;
    LAS float* sa = lf; LAS float* sk = lf + 2048; LAS float* sq = lf + 4096; LAS float* op = lf + 6144; LAS float* wss = lf + 6144 + 8192; LAS float* sv = lf + 6144 + 8192 + 64;
    float S[64];
#pragma unroll
    for (int i = 0; i < 64; ++i) S[i] = 0.f;
    const float gne = gn[e] * ogs;
    for (int t0 = 0; t0 < T; t0 += 16) {
        const bf16* pr0 = P + (size_t)(b * T + t0) * NP;
#pragma unroll
        for (int i = 0; i < 4; ++i) { const int idx = tid + 512 * i, tt = idx >> 7, d = idx & 127; const bf16* pr = pr0 + (size_t)tt * NP;
            sa[idx] = exp2f(LOG2E * bf2f(pr[6144 + h * 128 + d])); sk[idx] = bf2f(pr[3584 + h * 128 + d]); sq[idx] = bf2f(pr[3072 + h * 128 + d]); }
#pragma unroll
        for (int i = 0; i < 8; ++i) { const int tt = 2 * i + dh; sv[tt * 256 + e] = bf2f(pr0[(size_t)tt * NP + 4096 + h * 256 + e]); }
        __syncthreads();
#pragma unroll 1
        for (int tt = 0; tt < 16; ++tt) { float acc = 0.f; const float vv = sv[tt * 256 + e];
#pragma unroll
            for (int d4 = 0; d4 < 16; ++d4) { const f32x4 a4 = *(const LAS f32x4*)(sa + tt * 128 + 64 * dh + 4 * d4), k4 = *(const LAS f32x4*)(sk + tt * 128 + 64 * dh + 4 * d4), q4 = *(const LAS f32x4*)(sq + tt * 128 + 64 * dh + 4 * d4);
#pragma unroll
                for (int c = 0; c < 4; ++c) { S[4 * d4 + c] = a4[c] * S[4 * d4 + c] + k4[c] * vv; acc += q4[c] * S[4 * d4 + c]; } }
            op[(dh * 16 + tt) * 256 + e] = acc; }
        __syncthreads();
        if (dh == 0) {
#pragma unroll 1
            for (int tt = 0; tt < 16; ++tt) { const float o = op[tt * 256 + e] + op[(16 + tt) * 256 + e]; const float s2 = wave_sum(o * o); if (lane == 0) wss[wave * 16 + tt] = s2; } }
        __syncthreads();
        if (dh == 0) {
#pragma unroll 1
            for (int tt = 0; tt < 16; ++tt) { const float o = op[tt * 256 + e] + op[(16 + tt) * 256 + e];
                const float tot = (wss[tt] + wss[16 + tt]) + (wss[32 + tt] + wss[48 + tt]); const float rstd = 1.f / sqrtf(tot * (1.f / 256.f) + EPS);
                const float gate = bf2f(pr0[(size_t)tt * NP + 5120 + h * 256 + e]);
                CAT[(size_t)(b * T + t0 + tt) * D + 1024 + h * 256 + e] = (bf16)f2bf(o * rstd * gne * gate); } }
    }
    __syncthreads();
}

typedef short bf16x8v __attribute__((ext_vector_type(8)));
typedef short s16x4v __attribute__((ext_vector_type(4)));
typedef float f32x16 __attribute__((ext_vector_type(16)));
__device__ __forceinline__ int crow16(int r, int hh) { return (r & 3) + 8 * (r >> 2) + 4 * hh; }
__device__ __forceinline__ s16x4v tr_rd(const LAS unsigned char* p) { return __builtin_bit_cast(s16x4v, __builtin_amdgcn_ds_read_tr16_b64_v4i16((LAS s16x4v*)p)); }
__device__ __forceinline__ void half_swap(float& a, float& b) { asm volatile("s_nop 1\n\tv_permlane32_swap_b32_e32 %0, %1\n\ts_nop 1" : "+v"(a), "+v"(b)); }
__device__ __forceinline__ float half_sum(float v) { float a = v, b = v; half_swap(a, b); return a + b; }
__device__ __forceinline__ float half_max(float v) { float a = v, b = v; half_swap(a, b); return __builtin_fmaxf(a, b); }
__device__ __forceinline__ unsigned cvtpk(float lo, float hi) { unsigned r; asm volatile("v_cvt_pk_bf16_f32 %0, %1, %2" : "=v"(r) : "v"(lo), "v"(hi)); return r; }
__device__ __forceinline__ bf16x8v pack8(const f32x16& p, int s) {
    v4u w; w.x = cvtpk(p[8 * s + 0], p[8 * s + 1]); w.y = cvtpk(p[8 * s + 2], p[8 * s + 3]); w.z = cvtpk(p[8 * s + 4], p[8 * s + 5]); w.w = cvtpk(p[8 * s + 6], p[8 * s + 7]);
    return __builtin_bit_cast(bf16x8v, w);
}
constexpr int AT_KP = 272, AT_VP = 320, AT_KBYTES = 64 * AT_KP, AT_STAGE = AT_KBYTES + 64 * AT_VP;
constexpr float AT_THR = 6.f;

__device__ __forceinline__ void attn_unit(const bf16* P, bf16* CAT, int b, int h, int qb, float lam, float subscale, const float* gsub, LAS unsigned char* lds, int tid) {
    const int lane = tid & 63, wave = __builtin_amdgcn_readfirstlane(tid >> 6), mp = wave >> 2, wq = wave & 3, r32 = lane & 31, hh = lane >> 5;
    const int q0 = 128 * qb, NT = 2 * qb + 2, qg = q0 + 32 * wq + r32;
    const float slope2 = exp2f(-(float)(h + 1)) * LOG2E;
    const bf16* qrow = P + (size_t)(b * T + qg) * NP + h * 128 + mp * 64 + 8 * hh;
    bf16x8v qf[4];
#pragma unroll
    for (int ds = 0; ds < 4; ++ds) qf[ds] = *(const bf16x8v*)(qrow + 16 * ds);
    const int srow = tid >> 3, sseg = tid & 7;
    const bf16* gk = P + (size_t)(b * T + srow) * NP + 1024 + h * 128 + sseg * 16;
    LAS unsigned char* kdst = lds + srow * AT_KP + sseg * 32; LAS unsigned char* vdst = lds + AT_KBYTES + srow * AT_VP + sseg * 32;
    v4u st0 = *(const v4u*)gk, st1 = *(const v4u*)(gk + 8), st2 = *(const v4u*)(gk + 1024), st3 = *(const v4u*)(gk + 1032);
    *(LAS v4u*)kdst = st0; *(LAS v4u*)(kdst + 16) = st1; *(LAS v4u*)vdst = st2; *(LAS v4u*)(vdst + 16) = st3;
    f32x16 O[4];
#pragma unroll
    for (int d = 0; d < 4; ++d)
#pragma unroll
        for (int r = 0; r < 16; ++r) O[d][r] = 0.f;
    float cb[16];
#pragma unroll
    for (int r = 0; r < 16; ++r) cb[r] = slope2 * (float)crow16(r, hh);
    float m_ref = -1e30f, l = 0.f;
    const LAS unsigned char* kbase = lds + r32 * AT_KP + mp * 128 + hh * 16;
    const int g4 = lane >> 4, i16 = lane & 15;
    const LAS unsigned char* vbase = lds + AT_KBYTES + (4 * (g4 >> 1) + (i16 >> 2)) * AT_VP + (16 * (g4 & 1) + 4 * (i16 & 3)) * 2;
    __syncthreads();
    for (int t = 0; t < NT; ++t) {
        const int so = (t & 1) * AT_STAGE;
        if (t + 1 < NT) { const bf16* gn = gk + (size_t)(t + 1) * 64 * NP; st0 = *(const v4u*)gn; st1 = *(const v4u*)(gn + 8); st2 = *(const v4u*)(gn + 1024); st3 = *(const v4u*)(gn + 1032); }
        if (64 * t <= q0 + 32 * wq + 31) {
            f32x16 p0, p1;
            const float tb = slope2 * (float)(64 * t - q0);
#pragma unroll
            for (int r = 0; r < 16; ++r) { p0[r] = cb[r] + tb; p1[r] = p0[r] + 32.f * slope2; }
#pragma unroll
            for (int ds = 0; ds < 4; ++ds) {
                const bf16x8v k0 = *(const LAS bf16x8v*)(kbase + so + ds * 32), k1 = *(const LAS bf16x8v*)(kbase + so + 32 * AT_KP + ds * 32);
                p0 = __builtin_amdgcn_mfma_f32_32x32x16_bf16(k0, qf[ds], p0, 0, 0, 0);
                p1 = __builtin_amdgcn_mfma_f32_32x32x16_bf16(k1, qf[ds], p1, 0, 0, 0);
            }
            if (t >= NT - 2) {
#pragma unroll
                for (int r = 0; r < 16; ++r) { const int kvg = 64 * t + crow16(r, hh); if (kvg > qg) p0[r] = -1e30f; if (kvg + 32 > qg) p1[r] = -1e30f; }
            }
            float rm = __builtin_fmaxf(p0[0], p1[0]);
#pragma unroll
            for (int r = 1; r < 16; ++r) rm = __builtin_fmaxf(rm, __builtin_fmaxf(p0[r], p1[r]));
            rm = half_max(rm);
            if (__any(rm > m_ref + AT_THR)) {
                const float mn = __builtin_fmaxf(m_ref, rm), al = __builtin_amdgcn_exp2f(m_ref - mn);
                l *= al; m_ref = mn;
#pragma unroll
                for (int d = 0; d < 4; ++d)
#pragma unroll
                    for (int r = 0; r < 16; ++r) O[d][r] *= al;
            }
            float ls = 0.f;
#pragma unroll
            for (int r = 0; r < 16; ++r) { p0[r] = __builtin_amdgcn_exp2f(p0[r] - m_ref); p1[r] = __builtin_amdgcn_exp2f(p1[r] - m_ref); ls += p0[r] + p1[r]; }
            l += ls;
#pragma unroll
            for (int hf = 0; hf < 2; ++hf)
#pragma unroll
                for (int s = 0; s < 2; ++s) {
                    const bf16x8v pb = pack8(hf == 0 ? p0 : p1, s);
                    const LAS unsigned char* vp = vbase + so + (32 * hf + 16 * s) * AT_VP;
#pragma unroll
                    for (int d = 0; d < 4; ++d) {
                        const s16x4v lo = tr_rd(vp + d * 64), hi = tr_rd(vp + 8 * AT_VP + d * 64);
                        const bf16x8v va = (bf16x8v){lo[0], lo[1], lo[2], lo[3], hi[0], hi[1], hi[2], hi[3]};
                        O[d] = __builtin_amdgcn_mfma_f32_32x32x16_bf16(va, pb, O[d], 0, 0, 0);
                    }
                }
        }
        if (t + 1 < NT) { const int sn = ((t + 1) & 1) * AT_STAGE; *(LAS v4u*)(kdst + sn) = st0; *(LAS v4u*)(kdst + sn + 16) = st1; *(LAS v4u*)(vdst + sn) = st2; *(LAS v4u*)(vdst + sn + 16) = st3; }
        __syncthreads();
    }
    l = half_sum(l);
    const float inv = 1.f / l;
    LAS float* xch = (LAS float*)lds;
    if (mp == 1) {
#pragma unroll
        for (int d = 0; d < 4; ++d)
#pragma unroll
            for (int r = 0; r < 16; ++r) xch[((wq * 64 + d * 16 + r) * 64) + lane] = O[d][r] * inv; }
    __syncthreads();
    if (mp == 0) {
        float ss = 0.f;
#pragma unroll
        for (int d = 0; d < 4; ++d)
#pragma unroll
            for (int r = 0; r < 16; ++r) { const float o = O[d][r] * inv - lam * xch[((wq * 64 + d * 16 + r) * 64) + lane]; O[d][r] = o; ss += o * o; }
        ss = half_sum(ss);
        const float rstd = subscale / sqrtf(ss * (1.f / 128.f) + EPS);
        bf16* orow = CAT + (size_t)(b * T + qg) * D + h * 128;
#pragma unroll
        for (int d = 0; d < 4; ++d)
#pragma unroll
            for (int i = 0; i < 4; ++i) { const int dv0 = 32 * d + 8 * i + 4 * hh; const f32x4 gg = *(const f32x4*)(gsub + dv0);
                v2u w; w.x = pk2(O[d][4 * i + 0] * rstd * gg.x, O[d][4 * i + 1] * rstd * gg.y); w.y = pk2(O[d][4 * i + 2] * rstd * gg.z, O[d][4 * i + 3] * rstd * gg.w);
                *(GAS v2u*)(orow + dv0) = w; }
    }
    __syncthreads();
}

constexpr int GL_QT = 0, GL_KT = 24576, GL_KH = 49152, GL_V = 67584, GL_A = 104448, GL_SEG = 113664, GL_BL = 115712, GL_SS = 116224, GL_OT = 0;
constexpr int GL_QP = 192, GL_KHP = 144, GL_VP = 576, GL_AP = 144, GL_OP = 144;
static_assert(GL_SS + 2048 <= RING_BYTES && GL_KH + 128 * GL_KHP == GL_V && GL_V + 64 * GL_VP == GL_A && GL_A + 64 * GL_AP == GL_SEG, "GLA LDS map");

__device__ __forceinline__ void gla_unit(const bf16* P, bf16* CAT, int b, int h, const float* gn, LAS unsigned char* lds, int tid) {
    const int lane = tid & 63, wave = __builtin_amdgcn_readfirstlane(tid >> 6), r32 = lane & 31, hh = lane >> 5, g4 = lane >> 4, i16 = lane & 15;
    const int dk = tid & 127, jg = __builtin_amdgcn_readfirstlane(tid >> 7);
    const int vrow = tid >> 3, vseg = tid & 7;
    f32x16 S[4];
#pragma unroll
    for (int d = 0; d < 4; ++d)
#pragma unroll
        for (int r = 0; r < 16; ++r) S[d][r] = 0.f;
    const int trr = i16 >> 2, trc = 16 * (g4 & 1) + 4 * (i16 & 3);
    LAS float* seg = (LAS float*)(lds + GL_SEG); LAS float* ebl = (LAS float*)(lds + GL_BL); LAS float* ssp = (LAS float*)(lds + GL_SS);
    for (int c = 0; c < T / 64; ++c) {
        const bf16* rowbase = P + (size_t)(b * T + 64 * c) * NP;
        float la[16], qv[16], kv[16];
        { const bf16* pr = rowbase + (size_t)(16 * jg) * NP + h * 128 + dk;
#pragma unroll
          for (int jj = 0; jj < 16; ++jj) { la[jj] = bf2f(pr[(size_t)jj * NP + 6144]); qv[jj] = bf2f(pr[(size_t)jj * NP + 3072]); kv[jj] = bf2f(pr[(size_t)jj * NP + 3584]); } }
        { const bf16* pv = rowbase + (size_t)vrow * NP + 4096 + h * 256 + vseg * 32; LAS unsigned char* vd = lds + GL_V + vrow * GL_VP + vseg * 64;
          const v4u a0 = *(const v4u*)pv, a1 = *(const v4u*)(pv + 8), a2 = *(const v4u*)(pv + 16), a3 = *(const v4u*)(pv + 24);
          *(LAS v4u*)vd = a0; *(LAS v4u*)(vd + 16) = a1; *(LAS v4u*)(vd + 32) = a2; *(LAS v4u*)(vd + 48) = a3; }
#pragma unroll
        for (int jj = 1; jj < 16; ++jj) la[jj] += la[jj - 1];
        seg[jg * 128 + dk] = la[15];
        __syncthreads();
        { float pre = 0.f, tot = 0.f;
#pragma unroll
          for (int g = 0; g < 4; ++g) { const float sv = seg[g * 128 + dk]; tot += sv; if (g < jg) pre += sv; }
          const float eb_last = __builtin_amdgcn_exp2f(LOG2E * tot);
          float qt[16], kt[16], kh[16];
#pragma unroll
          for (int jj = 0; jj < 16; ++jj) { const float e = __builtin_amdgcn_exp2f(LOG2E * (pre + la[jj])), ri = __builtin_amdgcn_rcpf(e); qt[jj] = qv[jj] * e; kt[jj] = kv[jj] * ri; kh[jj] = kt[jj] * eb_last; }
          v4u w;
#define GL_PACK8(src, o) w.x = pk2(src[o + 0], src[o + 1]); w.y = pk2(src[o + 2], src[o + 3]); w.z = pk2(src[o + 4], src[o + 5]); w.w = pk2(src[o + 6], src[o + 7])
          GL_PACK8(qt, 0); *(LAS v4u*)(lds + GL_QT + dk * GL_QP + jg * 32) = w; GL_PACK8(qt, 8); *(LAS v4u*)(lds + GL_QT + dk * GL_QP + jg * 32 + 16) = w;
          GL_PACK8(kt, 0); *(LAS v4u*)(lds + GL_KT + dk * GL_QP + jg * 32) = w; GL_PACK8(kt, 8); *(LAS v4u*)(lds + GL_KT + dk * GL_QP + jg * 32 + 16) = w;
          GL_PACK8(kh, 0); *(LAS v4u*)(lds + GL_KH + dk * GL_KHP + jg * 32) = w; GL_PACK8(kh, 8); *(LAS v4u*)(lds + GL_KH + dk * GL_KHP + jg * 32 + 16) = w;
#undef GL_PACK8
          if (jg == 0) ebl[dk] = eb_last; }
        __syncthreads();
        if (wave < 3) {
            const int jb = wave >> 1, ib = (wave + 1) >> 1;
            f32x16 at;
#pragma unroll
            for (int r = 0; r < 16; ++r) at[r] = 0.f;
            const LAS unsigned char* ka = lds + GL_KT + (8 * hh + trr) * GL_QP + (32 * jb + trc) * 2;
            const LAS unsigned char* qa = lds + GL_QT + (8 * hh + trr) * GL_QP + (32 * ib + trc) * 2;
#pragma unroll
            for (int s = 0; s < 8; ++s) {
                const s16x4v k0 = tr_rd(ka + s * 16 * GL_QP), k1 = tr_rd(ka + (s * 16 + 4) * GL_QP), q0 = tr_rd(qa + s * 16 * GL_QP), q1 = tr_rd(qa + (s * 16 + 4) * GL_QP);
                const bf16x8v af = (bf16x8v){k0[0], k0[1], k0[2], k0[3], k1[0], k1[1], k1[2], k1[3]}, bfr = (bf16x8v){q0[0], q0[1], q0[2], q0[3], q1[0], q1[1], q1[2], q1[3]};
                at = __builtin_amdgcn_mfma_f32_32x32x16_bf16(af, bfr, at, 0, 0, 0);
            }
            if (jb == ib) {
#pragma unroll
                for (int r = 0; r < 16; ++r) if (crow16(r, hh) > r32) at[r] = 0.f; }
            LAS unsigned char* ad = lds + GL_A + (32 * ib + r32) * GL_AP + (32 * jb + 4 * hh) * 2;
#pragma unroll
            for (int g = 0; g < 4; ++g) { v2u w; w.x = pk2(at[4 * g + 0], at[4 * g + 1]); w.y = pk2(at[4 * g + 2], at[4 * g + 3]); *(LAS v2u*)(ad + 16 * g) = w; }
        }
        __syncthreads();
        f32x16 o[2];
        {
            bf16x8v vf[4];
            const LAS unsigned char* va = lds + GL_V + (8 * hh + trr) * GL_VP + (32 * wave + trc) * 2;
#pragma unroll
            for (int s = 0; s < 4; ++s) { const s16x4v a0 = tr_rd(va + s * 16 * GL_VP), a1 = tr_rd(va + (s * 16 + 4) * GL_VP); vf[s] = (bf16x8v){a0[0], a0[1], a0[2], a0[3], a1[0], a1[1], a1[2], a1[3]}; }
#pragma unroll
            for (int ib = 0; ib < 2; ++ib) {
#pragma unroll
                for (int r = 0; r < 16; ++r) o[ib][r] = 0.f;
                const LAS unsigned char* aa = lds + GL_A + (32 * ib + r32) * GL_AP + 16 * hh;
#pragma unroll
                for (int s = 0; s < 2 + 2 * ib; ++s) o[ib] = __builtin_amdgcn_mfma_f32_32x32x16_bf16(*(const LAS bf16x8v*)(aa + 32 * s), vf[s], o[ib], 0, 0, 0);
            }
#pragma unroll
            for (int d = 0; d < 4; ++d)
#pragma unroll
                for (int s2 = 0; s2 < 2; ++s2) {
                    const bf16x8v sb = pack8(S[d], s2);
#pragma unroll
                    for (int ib = 0; ib < 2; ++ib) {
                        const LAS unsigned char* qa = lds + GL_QT + (32 * d + 16 * s2 + 4 * hh + trr) * GL_QP + (32 * ib + trc) * 2;
                        const s16x4v q0 = tr_rd(qa), q1 = tr_rd(qa + 8 * GL_QP);
                        o[ib] = __builtin_amdgcn_mfma_f32_32x32x16_bf16((bf16x8v){q0[0], q0[1], q0[2], q0[3], q1[0], q1[1], q1[2], q1[3]}, sb, o[ib], 0, 0, 0);
                    }
                }
#pragma unroll
            for (int d = 0; d < 4; ++d) {
#pragma unroll
                for (int g = 0; g < 4; ++g) { const f32x4 e4 = *(const LAS f32x4*)(ebl + 32 * d + 8 * g + 4 * hh); S[d][4 * g + 0] *= e4.x; S[d][4 * g + 1] *= e4.y; S[d][4 * g + 2] *= e4.z; S[d][4 * g + 3] *= e4.w; }
                const LAS unsigned char* ha = lds + GL_KH + (32 * d + r32) * GL_KHP + 16 * hh;
#pragma unroll
                for (int s = 0; s < 4; ++s) S[d] = __builtin_amdgcn_mfma_f32_32x32x16_bf16(*(const LAS bf16x8v*)(ha + 32 * s), vf[s], S[d], 0, 0, 0);
            }
        }
        __syncthreads();
        { LAS unsigned char* od = lds + GL_OT + (32 * wave + r32) * GL_OP + 8 * hh;
#pragma unroll
          for (int ib = 0; ib < 2; ++ib)
#pragma unroll
              for (int g = 0; g < 4; ++g) { v2u w; w.x = pk2(o[ib][4 * g + 0], o[ib][4 * g + 1]); w.y = pk2(o[ib][4 * g + 2], o[ib][4 * g + 3]); *(LAS v2u*)(od + 64 * ib + 16 * g) = w; } }
        __syncthreads();
        { float ov[32]; float ss = 0.f;
          const LAS unsigned short* op = (const LAS unsigned short*)(lds + GL_OT + (32 * wave) * GL_OP) + lane;
#pragma unroll
          for (int e = 0; e < 32; ++e) { ov[e] = bf2f(op[e * (GL_OP / 2)]); ss += ov[e] * ov[e]; }
          ssp[wave * 64 + lane] = ss;
          __syncthreads();
          float tot = 0.f;
#pragma unroll
          for (int w8 = 0; w8 < 8; ++w8) tot += ssp[w8 * 64 + lane];
          const float rstd = 1.f / sqrtf(tot * (1.f / 256.f) + EPS);
          const bf16* gp = rowbase + (size_t)lane * NP + 5120 + h * 256 + 32 * wave; bf16* cp = CAT + (size_t)(b * T + 64 * c + lane) * D + 1024 + h * 256 + 32 * wave; const float* g32 = gn + 32 * wave;
#pragma unroll
          for (int q4 = 0; q4 < 4; ++q4) { const v4u gw = *(const v4u*)(gp + 8 * q4); v4u w;
              w.x = pk2(ov[8 * q4 + 0] * rstd * g32[8 * q4 + 0] * bflo(gw.x), ov[8 * q4 + 1] * rstd * g32[8 * q4 + 1] * bfhi(gw.x));
              w.y = pk2(ov[8 * q4 + 2] * rstd * g32[8 * q4 + 2] * bflo(gw.y), ov[8 * q4 + 3] * rstd * g32[8 * q4 + 3] * bfhi(gw.y));
              w.z = pk2(ov[8 * q4 + 4] * rstd * g32[8 * q4 + 4] * bflo(gw.z), ov[8 * q4 + 5] * rstd * g32[8 * q4 + 5] * bfhi(gw.z));
              w.w = pk2(ov[8 * q4 + 6] * rstd * g32[8 * q4 + 6] * bflo(gw.w), ov[8 * q4 + 7] * rstd * g32[8 * q4 + 7] * bfhi(gw.w));
              *(GAS v4u*)(cp + 8 * q4) = w; } }
    }
    __syncthreads();
}

#ifdef DBG_CHECK
constexpr int CW_DBG = 32768;
__device__ __forceinline__ float dbg_dot(const bf16* arow, const float* w, int ldw, int K, int lane, bool roundw) {
    float s = 0.f;
    for (int k = lane; k < K; k += 64) { const float wv = w[(size_t)k * ldw]; s += bf2f(arow[k]) * (roundw ? bf2f((unsigned short)f2bf(wv)) : wv); }
    return wave_sum(s);
}
__device__ __forceinline__ void dbg_fail(gu32* ctl, int which, float got, float exp, float rtol, float atol) {
    if (!(__builtin_fabsf(got - exp) <= rtol * __builtin_fabsf(exp) + atol)) __hip_atomic_fetch_add(ctl + CW_DBG + which, 1u, RLX_AGENT);
}
__device__ __forceinline__ float dbg_logsig(float x) { return (x < 0.f ? x : 0.f) - log1pf(expf(-fabsf(x))); }
__global__ void __launch_bounds__(64) dbg_kernel(Args a, int which, int l) {
    const int lane = threadIdx.x; unsigned char* ws = a.ws; gu32* ctl = (gu32*)(ws + WS_CTL);
    const float* MOD = (const float*)(ws + WS_MOD); const bf16* HN = (const bf16*)(ws + WS_HN); const bf16* PROJ = (const bf16*)(ws + WS_PROJ); const bf16* CAT = HN; const bf16* ACT = PROJ;
    float* STASH = (float*)(ws + WS_SCAL) + 64;
    const int rows8[8] = {0, 1, 255, 256, 2047, 2048, 12345, 32767};
    if (which == 0) {
        const float t1 = wave_sum((float)(lane + 1)); dbg_fail(ctl, 0, t1, 2080.f, 0.f, 0.01f);
        { float v = (float)(lane + 1); v += DPPF(v, 0xB1); v += DPPF(v, 0x4E); v += DPPF(v, 0x141); v += DPPF(v, 0x140); const int r = lane >> 4; dbg_fail(ctl, 21, v, (float)(16 * (16 * r) + 136), 0.f, 0.01f); }
        { const float v = __builtin_bit_cast(float, __builtin_amdgcn_ds_swizzle(__builtin_bit_cast(int, (float)lane), 0x401F)); dbg_fail(ctl, 22, v, (float)(lane ^ 16), 0.f, 0.01f); }
        { float a_ = (float)lane, b_ = (float)lane; asm volatile("s_nop 1\n\tv_permlane32_swap_b32_e32 %0, %1\n\ts_nop 1" : "+v"(a_), "+v"(b_));
          dbg_fail(ctl, 23, a_ + b_, (float)((lane & 31) + (lane & 31) + 32), 0.f, 0.01f); dbg_fail(ctl, 25, a_, (float)(lane & 31), 0.f, 0.01f); }
        { const float v = __shfl_xor((float)lane, 16); dbg_fail(ctl, 24, v, (float)(lane ^ 16), 0.f, 0.01f); }
    } else if (which == 10) {
        const int bs[3] = {0, 7, 15}, js[5] = {0, 255, 256, 5000, 12287};
        for (int ll = 0; ll < 2; ++ll) for (int bi = 0; bi < 3; ++bi) for (int ji = 0; ji < 5; ++ji) { const int b = bs[bi], j = js[ji]; float s = 0.f;
            for (int k = lane; k < D; k += 64) { const float cv = a.in[1][b * D + k]; s += cv / (1.f + expf(-cv)) * a.in[2][((size_t)ll * D + k) * NMOD + j]; }
            s = wave_sum(s) + a.in[3][ll * NMOD + j];
            if (lane == 0) dbg_fail(ctl, 10, MOD[(size_t)(ll * 16 + b) * NMOD + j], s, 1e-3f, 1e-3f); }
    } else if (which == 1) {
        const float* xin = (l == 0) ? a.in[0] : a.out; const int cs[4] = {0, 5, 1000, 2047};
        for (int ri = 0; ri < 8; ++ri) { const int r = rows8[ri], b = r / T; float s = 0.f;
            for (int k = lane; k < D; k += 64) { const float v = xin[(size_t)r * D + k]; s += v * v; }
            const float rstd = 1.f / sqrtf(wave_sum(s) / D + EPS);
            for (int ci = 0; ci < 4; ++ci) { const int c = cs[ci]; const float* mb = MOD + (size_t)(l * 16 + b) * NMOD;
                const float e = xin[(size_t)r * D + c] * rstd * a.in[4][l * D + c] * (1.f + mb[D + c]) + mb[c];
                if (lane == 0) dbg_fail(ctl, 1, bf2f(HN[(size_t)r * D + c]), e, 0.01f, 0.01f); } }
    } else if (which == 2) {
        const int cs[10] = {5, 700, 1030, 2100, 3100, 3600, 4200, 5200, 1023, 6143};
        for (int ri = 0; ri < 8; ++ri) for (int ci = 0; ci < 10; ++ci) { const int r = rows8[ri], c = cs[ci];
            float e = dbg_dot(HN + (size_t)r * D, a.in[5] + (size_t)l * D * NIN + c, NIN, D, lane, true);
            if (c < 1024) e *= pg8::QSCALE; else if (c >= 3072 && c < 3584) e *= pg8::GQSCALE; else if (c >= 5120) e = e / (1.f + expf(-e));
            if (lane == 0) dbg_fail(ctl, 2, bf2f(PROJ[(size_t)r * NP + c]), e, 0.02f, 0.02f); }
    } else if (which == 3) {
        const int js[5] = {0, 6, 255, 256, 511};
        for (int ri = 0; ri < 8; ++ri) { const int r = rows8[ri]; float gl[16];
#pragma unroll
            for (int q = 0; q < 16; ++q) gl[q] = dbg_dot(HN + (size_t)r * D, a.in[5] + (size_t)l * D * NIN + 6144 + q, NIN, D, lane, false);
            for (int ji = 0; ji < 5; ++ji) { const int j = js[ji]; float xg = a.in[9][l * 512 + j];
#pragma unroll
                for (int q = 0; q < 16; ++q) xg += gl[q] * a.in[8][(size_t)l * 16 * 512 + q * 512 + j];
                if (lane == 0) dbg_fail(ctl, 3, bf2f(PROJ[(size_t)r * NP + 6144 + j]), dbg_logsig(xg) * 0.0625f, 0.05f, 1e-3f); } }
    } else if (which == 4) {
        const int bs[3] = {0, 5, 15}, ts[3] = {0, 77, 300}, hs[3] = {0, 3, 7};
        const float lam = ((const float*)(ws + WS_SCAL))[l], sub = 1.f - (l == 0 ? 0.2f : 0.35550906759096926f);
        for (int si = 0; si < 3; ++si) { const int b = bs[si], t = ts[si], h = hs[si]; const float slope = exp2f(-(float)(h + 1));
            float od0 = 0.f, od1 = 0.f;
            for (int mp = 0; mp < 2; ++mp) {
                const bf16* qrow = PROJ + (size_t)(b * T + t) * NP + h * 128 + mp * 64;
                const bf16* kb = PROJ + (size_t)(b * T) * NP + 1024 + h * 128 + mp * 64;
#define DBG_SCORE(kv) ({ const bf16* kr_ = kb + (size_t)(kv) * NP; float s_ = 0.f; for (int d = 0; d < 64; ++d) s_ += bf2f(qrow[d]) * bf2f(kr_[d]); s_ / 1.4426950408889634f - slope * (float)(t - (kv)); })
                float mx = -1e30f;
                for (int kv = lane; kv <= t; kv += 64) mx = fmaxf(mx, DBG_SCORE(kv));
                for (int o = 1; o < 64; o <<= 1) mx = fmaxf(mx, __shfl_xor(mx, o));
                float den = 0.f;
                for (int kv = lane; kv <= t; kv += 64) den += expf(DBG_SCORE(kv) - mx);
                den = wave_sum(den);
                for (int ch = 0; ch < 4; ++ch) {
                    float acc[32];
#pragma unroll
                    for (int i = 0; i < 32; ++i) acc[i] = 0.f;
                    for (int kv = lane; kv <= t; kv += 64) { const float p = expf(DBG_SCORE(kv) - mx); const bf16* vr = PROJ + (size_t)(b * T + kv) * NP + 2048 + h * 128 + ch * 32;
#pragma unroll
                        for (int i = 0; i < 32; ++i) acc[i] += p * bf2f(vr[i]); }
#pragma unroll
                    for (int i = 0; i < 32; ++i) { const float v = wave_sum(acc[i]) / den, cv = (mp == 0) ? v : -lam * v; const int idx = ch * 32 + i;
                        if (lane == (idx & 63)) { if (idx < 64) od0 += cv; else od1 += cv; } }
                }
#undef DBG_SCORE
            }
            const float rstd = sub / sqrtf(wave_sum(od0 * od0 + od1 * od1) / 128.f + EPS);
            dbg_fail(ctl, 4, bf2f(CAT[(size_t)(b * T + t) * D + h * 128 + lane]), od0 * rstd * a.in[7][l * 128 + lane], 0.03f, 0.02f);
            dbg_fail(ctl, 4, bf2f(CAT[(size_t)(b * T + t) * D + h * 128 + 64 + lane]), od1 * rstd * a.in[7][l * 128 + 64 + lane], 0.03f, 0.02f);
        }
    } else if (which == 5) {
        const int bs[3] = {0, 9, 15}, ts[3] = {0, 70, 200}, hs[3] = {0, 2, 3};
        for (int si = 0; si < 3; ++si) { const int b = bs[si], t = ts[si], h = hs[si];
            const bf16* qrow = PROJ + (size_t)(b * T + t) * NP + 3072 + h * 128; const float q0 = bf2f(qrow[lane]), q1 = bf2f(qrow[64 + lane]);
            float c0 = 0.f, c1 = 0.f, o[4] = {0.f, 0.f, 0.f, 0.f};
            for (int s = t; s >= 0; --s) { const bf16* pr = PROJ + (size_t)(b * T + s) * NP;
                const float w = wave_sum(q0 * bf2f(pr[3584 + h * 128 + lane]) * expf(c0) + q1 * bf2f(pr[3584 + h * 128 + 64 + lane]) * expf(c1));
#pragma unroll
                for (int i = 0; i < 4; ++i) o[i] += w * bf2f(pr[4096 + h * 256 + 4 * lane + i]);
                c0 += bf2f(pr[6144 + h * 128 + lane]); c1 += bf2f(pr[6144 + h * 128 + 64 + lane]); }
            const float rstd = 1.f / sqrtf(wave_sum(o[0] * o[0] + o[1] * o[1] + o[2] * o[2] + o[3] * o[3]) / 256.f + EPS);
#pragma unroll
            for (int i = 0; i < 4; ++i) { const int e = 4 * lane + i; const float gate = bf2f(PROJ[(size_t)(b * T + t) * NP + 5120 + h * 256 + e]);
                dbg_fail(ctl, 5, bf2f(CAT[(size_t)(b * T + t) * D + 1024 + h * 256 + e]), o[i] * rstd * a.in[10][l * 256 + e] * gate, 0.03f, 0.02f); }
        }
    } else if (which == 6) {
        const float* xin = (l == 0) ? a.in[0] : STASH + 256; const int cs[5] = {0, 1, 17, 300, 2047};
        for (int ri = 0; ri < 8; ++ri) for (int ci = 0; ci < 5; ++ci) { const int r = rows8[ri], c = cs[ci], b = r / T;
            const float d = dbg_dot(CAT + (size_t)r * D, a.in[11] + (size_t)l * D * D + c, D, D, lane, true);
            const float xo = (l == 0) ? xin[(size_t)r * D + c] : xin[ri * 8 + ci];
            if (lane == 0) dbg_fail(ctl, 6, a.out[(size_t)r * D + c], xo + MOD[(size_t)(l * 16 + b) * NMOD + 2 * D + c] * d, 0.01f, 0.01f); }
    } else if (which == 7) {
        const int pms[5] = {0, 1, 7, 8, 9}, lr[17] = {0, 1, 2, 15, 16, 17, 63, 64, 65, 127, 128, 129, 191, 192, 193, 254, 255}, cs[9] = {0, 3, 4, 9, 37, 100, 127, 133, 5631};
        const float* wu = a.in[13] + (size_t)l * D * NUP;
        for (int pi = 0; pi < 5; ++pi) for (int ri = 0; ri < 17; ++ri) for (int ci = 0; ci < 9; ++ci) { const int r = 256 * pms[pi] + lr[ri], c = cs[ci], t = r % T;
            const float u = dbg_dot(HN + (size_t)r * D, wu + c, NUP, D, lane, true), g0 = dbg_dot(HN + (size_t)r * D, wu + FF + c, NUP, D, lane, true);
            const float g1 = t >= 1 ? dbg_dot(HN + (size_t)(r - 1) * D, wu + FF + c, NUP, D, lane, true) : 0.f, g2 = t >= 2 ? dbg_dot(HN + (size_t)(r - 2) * D, wu + FF + c, NUP, D, lane, true) : 0.f;
            const float* wc = a.in[14] + (size_t)l * 3 * FF; const float y = wc[c] * g2 + wc[FF + c] * g1 + wc[2 * FF + c] * g0 + a.in[15][l * FF + c];
            const float e = 0.5f * y * (1.f + erff(y * 0.70710678f)) * u;
            if (lane == 0) dbg_fail(ctl, 7, bf2f(ACT[(size_t)r * FF + c]), e, 0.03f, 0.02f); }
    } else if (which == 8) {
        const int cs[5] = {0, 1, 17, 300, 2047};
        for (int ri = 0; ri < 8; ++ri) for (int ci = 0; ci < 5; ++ci) if (lane == 0) STASH[ri * 8 + ci] = a.out[(size_t)rows8[ri] * D + cs[ci]];
    } else if (which == 9) {
        const int cs[5] = {0, 1, 17, 300, 2047};
        for (int ri = 0; ri < 8; ++ri) for (int ci = 0; ci < 5; ++ci) { const int r = rows8[ri], c = cs[ci], b = r / T;
            const float d = dbg_dot(ACT + (size_t)r * FF, a.in[16] + (size_t)l * FF * D + c, D, FF, lane, true);
            if (lane == 0) { dbg_fail(ctl, 9, a.out[(size_t)r * D + c], STASH[ri * 8 + ci] + MOD[(size_t)(l * 16 + b) * NMOD + 5 * D + c] * d, 0.01f, 0.01f); STASH[256 + ri * 8 + ci] = a.out[(size_t)r * D + c]; } }
    }
}
__global__ void dbg_emit(Args a, int lo_bit) {
    gu32* ctl = (gu32*)(a.ws + WS_CTL); unsigned mask = 0;
    for (int i = 0; i < 6; ++i) if (ctl[CW_DBG + lo_bit + i]) mask |= 1u << i;
    if (threadIdx.x == 0 && blockIdx.x == 0) a.out[0] += 10.f + (float)mask;
}
#endif

#ifndef MK_PER_PHASE
#define MK_PER_PHASE 0
#endif
#ifndef DBG_SIGNS
#define DBG_SIGNS 0,0,0,0,0,0
#endif
__device__ const float DBG_A[6] = {DBG_SIGNS};
constexpr int N_PHASES = 18;
constexpr int GLA_UNITS = 64, ATT_UNITS = 2048, MIX_UNITS = GLA_UNITS + ATT_UNITS;

__global__ void __launch_bounds__(NWAVES * 64, 2) fwd_kernel(Args a_unused) {
    extern __shared__ __attribute__((aligned(16))) unsigned char lds_raw[];
    LAS unsigned char* lds = (LAS unsigned char*)lds_raw;
#define TIDS() int tid = threadIdx.x; asm volatile("" : "+v"(tid)); const int lane = tid & 63, wave = __builtin_amdgcn_readfirstlane(tid >> 6); (void)lane; (void)wave
#define G_ ((int)gridDim.x)
#define BX_ ((int)blockIdx.x)
#define VCU_ ((G_ % 8 == 0) ? (BX_ % 8) * (G_ / 8) + BX_ / 8 : BX_)
#define GW_ (VCU_ * NWAVES + wave)
#define NGW_ (G_ * NWAVES)
#define MISC_ ((volatile LAS unsigned*)(lds + LDSCTL_OFF))
    for (int u = threadIdx.x; u < (LDS_BYTES - LDSCTL_OFF) / 4; u += NWAVES * 64) ((LAS unsigned*)(lds + LDSCTL_OFF))[u] = 0u;
    __syncthreads();
#if !MK_PER_PHASE
    { CArgs* A = ARGS(); (void)xcd_barrier_post((unsigned*)((gu32*)(A->ws + WS_CTL) + CW_BAR), MISC_ + 8); }
#define GRID_BAR() do { CArgs* A_ = ARGS(); XcdBarrier b_; b_.bar = (unsigned*)((gu32*)(A_->ws + WS_CTL) + CW_BAR); b_.x = xb_xcc_id(); b_.st = MISC_ + 8; xcd_barrier(b_); } while (0)
#define IN(k) true
#else
#define GRID_BAR() do { } while (0)
    const int lo = ARGS()->ph_lo, hi = ARGS()->ph_hi;
#define IN(k) (lo <= (k) && (k) < hi)
#endif
#ifdef ONLY_OFF
#define INL(o) ((o) == ONLY_OFF && IN(pb + (o)))
#else
#define INL(o) IN(pb + (o))
#endif

    if (IN(0)) { TIDS(); p0_prologue(ARGS(), lds, tid, lane, wave, VCU_, G_); GRID_BAR(); }

    for (int l = 0; l < 2; ++l) {
        const int pb = 1 + 8 * l;
        if (INL(0)) { TIDS(); CArgs* A = ARGS(); unsigned char* ws = A->ws;
            norm_phase((l == 0) ? A->in[0] : A->out, A->in[4] + l * D, (const float*)(ws + WS_MOD) + (size_t)l * 16 * NMOD, 0, 1, (bf16*)(ws + WS_HN), GW_, NGW_, lane); GRID_BAR(); }
        if (INL(1)) { TIDS(); CArgs* A = ARGS(); unsigned char* ws = A->ws;
            pg8::Gemm g{(const bf16*)(ws + WS_HN), (const bf16*)(ws + WS_WIN) + (size_t)l * NP * D, M, NP, D}; pg8::StaticOrder S; S.init(M, NP, G_, BX_);
            pg8::EpiProj E{(bf16*)(ws + WS_PROJ), A->in[9] + l * 512};
            pg8::gemm_phase<pg8::EpiProj, pg8::StaticOrder, true, true>(lds + RING_OFF, g, S, E);
            GRID_BAR();
        }
        if (INL(2)) { TIDS(); CArgs* A = ARGS(); unsigned char* ws = A->ws;
            const bf16* PROJ = (const bf16*)(ws + WS_PROJ); bf16* CAT = (bf16*)(ws + WS_HN); gu32* ctl = (gu32*)(ws + WS_CTL);
            const float lam = ((const float*)(ws + WS_SCAL))[l], subscale = (1.f - (l == 0 ? 0.2f : 0.35550906759096926f)) * (1.f + DBG_A[3 * l + 0]); const float ogs = 1.f + DBG_A[3 * l + 1];
            volatile LAS unsigned* qslot = MISC_ + 16;
            for (;;) {
                if (tid == 0) *qslot = __hip_atomic_fetch_add(ctl + CW_QUEUE + 64 * l, 1u, RLX_AGENT);
                __syncthreads();
                const unsigned u = *qslot;
                __syncthreads();
                if (u >= (unsigned)MIX_UNITS) break;
                if (u < (unsigned)GLA_UNITS) {
#ifndef NO_GLA
#ifdef NAIVE_GLA
                    gla_naive_unit(PROJ, CAT, (int)u >> 2, (int)u & 3, ogs, A->in[10] + l * 256, (LAS float*)(lds + RING_OFF), tid);
#else
                    (void)ogs; gla_unit(PROJ, CAT, (int)u >> 2, (int)u & 3, A->in[10] + l * 256, lds + RING_OFF, tid);
#endif
#endif
                } else {
#ifndef NO_ATT
                    const int idx = (int)u - GLA_UNITS, qb = 15 - idx / 128, bh = idx % 128;
#ifdef NAIVE_ATT
                    attn_naive_unit(PROJ, CAT, bh >> 3, bh & 7, qb, lam, subscale, A->in[7] + l * 128, (LAS float*)(lds + RING_OFF), tid);
#else
                    attn_unit(PROJ, CAT, bh >> 3, bh & 7, qb, lam, subscale, A->in[7] + l * 128, lds + RING_OFF, tid);
#endif
#endif
                }
            }
            GRID_BAR();
        }
        if (INL(3)) { TIDS(); CArgs* A = ARGS(); unsigned char* ws = A->ws;
            pg8::Gemm g{(const bf16*)(ws + WS_HN), (const bf16*)(ws + WS_WO) + (size_t)l * D * D, M, D, D}; pg8::StaticOrder S; S.init(M, D, G_, BX_);
            pg8::EpiRes E{(l == 0) ? A->in[0] : A->out, A->out, (const float*)(ws + WS_MOD) + (size_t)l * 16 * NMOD + 2 * D, 1.f};
            pg8::gemm_phase<pg8::EpiRes, pg8::StaticOrder, true, true>(lds + RING_OFF, g, S, E);
            GRID_BAR();
        }
        if (INL(4)) { TIDS(); CArgs* A = ARGS(); unsigned char* ws = A->ws;
            norm_phase(A->out, A->in[12] + l * D, (const float*)(ws + WS_MOD) + (size_t)l * 16 * NMOD, 3, 4, (bf16*)(ws + WS_HN), GW_, NGW_, lane); GRID_BAR(); }
        if (INL(5)) { TIDS(); CArgs* A = ARGS(); unsigned char* ws = A->ws;
            pg8::Gemm g{(const bf16*)(ws + WS_HN), (const bf16*)(ws + WS_WUP) + (size_t)l * NUP * D, M, NUP, D}; pg8::StaticOrder S; S.init(M, NUP, G_, BX_);
            pg8::EpiUp E{(bf16*)(ws + WS_PROJ), A->in[14] + (size_t)l * 3 * FF, A->in[15] + l * FF, (float*)(ws + WS_HALO), (float*)(ws + WS_HALO + HALO_ONE), (float*)(ws + WS_HALO + 2 * HALO_ONE), (LAS float*)(lds + BND_OFF)};
            pg8::gemm_phase<pg8::EpiUp, pg8::StaticOrder, true, true>(lds + RING_OFF, g, S, E);
            GRID_BAR();
        }
        if (INL(6)) { TIDS(); CArgs* A = ARGS(); unsigned char* ws = A->ws;
            fixup_phase((const float*)(ws + WS_HALO), (const float*)(ws + WS_HALO + HALO_ONE), (const float*)(ws + WS_HALO + 2 * HALO_ONE), A->in[14] + (size_t)l * 3 * FF, A->in[15] + l * FF, (bf16*)(ws + WS_PROJ), BX_ * (NWAVES * 64) + tid, G_ * NWAVES * 64); GRID_BAR(); }
        if (INL(7)) { TIDS(); CArgs* A = ARGS(); unsigned char* ws = A->ws;
            pg8::Gemm g{(const bf16*)(ws + WS_PROJ), (const bf16*)(ws + WS_WDN) + (size_t)l * D * FF, M, D, FF}; pg8::StaticOrder S; S.init(M, D, G_, BX_);
            pg8::EpiRes E{A->out, A->out, (const float*)(ws + WS_MOD) + (size_t)l * 16 * NMOD + 5 * D, 1.f + DBG_A[3 * l + 2]};
            pg8::gemm_phase<pg8::EpiRes, pg8::StaticOrder, true, true>(lds + RING_OFF, g, S, E);
            GRID_BAR();
        }
    }
    if (IN(17)) { TIDS(); CArgs* A = ARGS(); final_norm_phase(A->out, A->in[17], GW_, NGW_, lane); }
#undef IN
#undef INL
#undef GRID_BAR
}

extern "C" void kernel_launch(void* const* d_in, const int* in_sizes, int n_in, void* d_out, int out_size, void* d_ws, size_t ws_size, hipStream_t stream) {
    static int grid = 0;
    if (grid == 0) {
        if (n_in != 18 || in_sizes[0] != M * D || out_size != M * D || ws_size < WS_END) { fprintf(stderr, "kernel_launch: unexpected shapes / workspace (%d inputs, ws %zu); nothing launched\n", n_in, ws_size); grid = -1; return; }
        int dev = 0, cus = 0, per_cu = 0;
        if (hipGetDevice(&dev) != hipSuccess || hipDeviceGetAttribute(&cus, hipDeviceAttributeMultiprocessorCount, dev) != hipSuccess) { grid = -1; return; }
        if (hipFuncSetAttribute((const void*)fwd_kernel, hipFuncAttributeMaxDynamicSharedMemorySize, LDS_BYTES) != hipSuccess) { fprintf(stderr, "kernel_launch: hipFuncSetAttribute failed\n"); grid = -1; return; }
        if (hipOccupancyMaxActiveBlocksPerMultiprocessor(&per_cu, (const void*)fwd_kernel, NWAVES * 64, LDS_BYTES) != hipSuccess || per_cu < 1) { fprintf(stderr, "kernel_launch: occupancy query reports %d\n", per_cu); }
        (void)hipGetLastError();
        grid = cus;
    }
    if (grid < 0) return;
    if (hipMemsetAsync((char*)d_ws + WS_CTL, 0, CTL_ZERO_BYTES, stream) != hipSuccess) return;
    Args a{};
    for (int i = 0; i < 18; ++i) a.in[i] = (const float*)d_in[i];
    a.out = (float*)d_out; a.ws = (unsigned char*)d_ws;
#if MK_PER_PHASE
    for (int p = 0; p < N_PHASES; ++p) { a.ph_lo = p; a.ph_hi = p + 1; hipLaunchKernelGGL(fwd_kernel, dim3(grid), dim3(NWAVES * 64), LDS_BYTES, stream, a);
#ifdef DBG_CHECK
#define DBGK(w) hipLaunchKernelGGL(dbg_kernel, dim3(1), dim3(64), 0, stream, a, (w), DBG_LAYER)
        const int pb = 1 + 8 * DBG_LAYER;
        if (p == 0) { DBGK(0); DBGK(10); }
        if (p == pb + 0) DBGK(1);
        if (p == pb + 1) { DBGK(2); DBGK(3); }
        if (p == pb + 2) { DBGK(4); DBGK(5); }
        if (p == pb + 3) { DBGK(6); DBGK(8); }
        if (p == pb + 6) DBGK(7);
        if (p == pb + 7) DBGK(9);
        if (p == N_PHASES - 1) hipLaunchKernelGGL(dbg_emit, dim3(1), dim3(64), 0, stream, a, DBG_LO);
#endif
    }
#else
    a.ph_lo = 0; a.ph_hi = N_PHASES;
    hipLaunchKernelGGL(fwd_kernel, dim3(grid), dim3(NWAVES * 64), LDS_BYTES, stream, a);
#endif
}
```

```cpp
#include <hip/hip_runtime.h>
#include <cstdio>
#include <cstdint>
namespace pg8 {
#define PG8_LAS __attribute__((address_space(3)))
typedef unsigned short bf16_t;
typedef short bf16x8 __attribute__((ext_vector_type(8)));
typedef float f32x4 __attribute__((ext_vector_type(4)));
typedef unsigned u32x4 __attribute__((ext_vector_type(4)));
constexpr int BM = 256, BK = 64, HALF = 128, HTB = HALF * BK * 2  , STAGE_BYTES = 8 * HTB, NXCD = 8, WGM = 8;

__host__ __device__ __forceinline__ int lds_byte(int r, int c) { const int st = (r >> 4) * 2 + (c >> 5), rr = r & 15, cc = c & 31, ob = rr * 64 + cc * 2; return st * 1024 + (ob ^ (((ob >> 9) & 1) << 5)); }
__host__ __device__ __forceinline__ void stage_rc(int b, int& R, int& C) { const int st = b / 1024, sb = b % 1024, swz = sb ^ (((sb >> 9) & 1) << 5); R = (st >> 1) * 16 + swz / 64; C = (st & 1) * 32 + (swz % 64) / 2; }
__host__ __device__ __forceinline__ int perm32(int rho) { const int n = rho >> 4, i = rho & 15; return 8 * (i >> 2) + 4 * n + (i & 3); }

struct Unit { int pm, pn; };
struct Gemm { const bf16_t* A; const bf16_t* Bt; int M, N, K; };

struct StaticOrder {
    int nM, nN, nwg, G, c;
    __host__ __device__ void init(int M, int N, int G_, int c_) { nM = M / BM; nN = N / BM; nwg = nM * nN; G = G_; c = c_; }
    __host__ __device__ bool next(int i, Unit& u) const {
        const long L = (long)i * G + c; if (L >= nwg) return false;
        int wgid = (int)L; { const int q = nwg / NXCD, r = nwg % NXCD, xcd = wgid % NXCD, off = wgid / NXCD; wgid = (xcd < r ? xcd * (q + 1) : r * (q + 1) + (xcd - r) * q) + off; }
        const int nig = WGM * nN, gid = wgid / nig, fm = gid * WGM, gsz = (nM - fm) < WGM ? (nM - fm) : WGM;
        u.pm = fm + ((wgid % nig) % gsz); u.pn = (wgid % nig) / gsz; return true;
    }
    __device__ __forceinline__ void a_ready(const Unit&) const {}
    __device__ __forceinline__ void done(const Unit&) const {}
};

__device__ __forceinline__ unsigned cvt_pk_bf16(float lo, float hi) { unsigned r; asm volatile("v_cvt_pk_bf16_f32 %0, %1, %2" : "=v"(r) : "v"(lo), "v"(hi)); return r; }
typedef float f32x2 __attribute__((ext_vector_type(2)));
__device__ __forceinline__ f32x2 gelu_pk(f32x2 v) {
    const f32x2 av = __builtin_elementwise_abs(v), d = av * 0.2316418882f + 1.0f;
    f32x2 t; t.x = __builtin_amdgcn_rcpf(d.x); t.y = __builtin_amdgcn_rcpf(d.y);
    f32x2 q = t * 0.5307027145f + (-0.7265760135f); q = q * t + 0.7107068705f; q = q * t + (-0.142248368f); q = q * t + 0.127414796f; q = q * t;
    const f32x2 s = (v * v) * (-0.72134752044f);
    f32x2 e; e.x = __builtin_amdgcn_exp2f(s.x); e.y = __builtin_amdgcn_exp2f(s.y);
    const f32x2 m = v * (q * e), r = v - m;
    f32x2 o; o.x = v.x < 0.f ? m.x : r.x; o.y = v.y < 0.f ? m.y : r.y; return o;
}

constexpr float QSCALE = 0.125f * 1.4426950408889634f;
constexpr float GQSCALE = 0.08838834764831845f;
constexpr int NPW = 6656;

struct EpiProj {
    static constexpr bool PERM = true, AFTER_DRAIN = false;
    bf16_t* O; const float* bgk;
    __device__ __forceinline__ void operator()(const f32x4 (&acc)[2][2][4][2], const Unit& u, int wr, int wc, int fr, int fq) const {
        const int row0 = u.pm * BM + wr * 64 + fr, col0 = u.pn * BM + wc * 32 + 8 * fq, pn = u.pn;
        int mode = 0; float sc = 1.f;
        if (pn < 4) sc = QSCALE; else if (pn >= 12 && pn < 14) sc = GQSCALE; else if (pn >= 20 && pn < 24) mode = 1; else if (pn >= 24) mode = 2;
        f32x4 bv[2][2];
#pragma unroll
        for (int bj = 0; bj < 2; ++bj)
#pragma unroll
            for (int n = 0; n < 2; ++n) bv[bj][n] = (mode == 2) ? *(const f32x4*)(bgk + (col0 - 6144) + bj * HALF + 4 * n) : (f32x4){0.f, 0.f, 0.f, 0.f};
#pragma unroll
        for (int ai = 0; ai < 2; ++ai)
#pragma unroll
            for (int m = 0; m < 4; ++m) { bf16_t* rowp = O + (size_t)(row0 + ai * HALF + m * 16) * NPW + col0;
#pragma unroll
                for (int bj = 0; bj < 2; ++bj) { f32x4 v0 = acc[ai][bj][m][0] + bv[bj][0], v1 = acc[ai][bj][m][1] + bv[bj][1];
                    if (mode == 0) { v0 = v0 * sc; v1 = v1 * sc; }
                    else if (mode == 1) {
#pragma unroll
                        for (int e = 0; e < 4; ++e) { v0[e] = v0[e] * __builtin_amdgcn_rcpf(1.f + __builtin_amdgcn_exp2f(-1.4426950408889634f * v0[e])); v1[e] = v1[e] * __builtin_amdgcn_rcpf(1.f + __builtin_amdgcn_exp2f(-1.4426950408889634f * v1[e])); }
                    } else {
#pragma unroll
                        for (int e = 0; e < 4; ++e) {
                            { const float x = v0[e], ax = __builtin_fabsf(x); v0[e] = (__builtin_fminf(x, 0.f) - 0.6931471805599453f * __builtin_amdgcn_logf(1.f + __builtin_amdgcn_exp2f(-1.4426950408889634f * ax))) * 0.0625f; }
                            { const float x = v1[e], ax = __builtin_fabsf(x); v1[e] = (__builtin_fminf(x, 0.f) - 0.6931471805599453f * __builtin_amdgcn_logf(1.f + __builtin_amdgcn_exp2f(-1.4426950408889634f * ax))) * 0.0625f; } }
                    }
                    u32x4 w; w.x = cvt_pk_bf16(v0[0], v0[1]); w.y = cvt_pk_bf16(v0[2], v0[3]); w.z = cvt_pk_bf16(v1[0], v1[1]); w.w = cvt_pk_bf16(v1[2], v1[3]);
                    *(u32x4*)(rowp + bj * HALF) = w; } }
    }
};

struct EpiRes {
    static constexpr bool PERM = false, AFTER_DRAIN = false;
    const float* xin; float* out; const float* gate; float gs;
    __device__ __forceinline__ void operator()(const f32x4 (&acc)[2][2][4][2], const Unit& u, int wr, int wc, int fr, int fq) const {
        const int col0 = u.pn * BM + wc * 32 + 4 * fq; const float* g = gate + (size_t)(u.pm >> 3) * 12288;
        f32x4 gv[2][2];
#pragma unroll
        for (int bj = 0; bj < 2; ++bj)
#pragma unroll
            for (int n = 0; n < 2; ++n) gv[bj][n] = *(const f32x4*)(g + col0 + bj * HALF + n * 16) * gs;
#pragma unroll
        for (int ai = 0; ai < 2; ++ai)
#pragma unroll
            for (int m = 0; m < 4; ++m) { const size_t off = (size_t)(u.pm * BM + ai * HALF + wr * 64 + m * 16 + fr) * 2048 + col0;
#pragma unroll
                for (int bj = 0; bj < 2; ++bj)
#pragma unroll
                    for (int n = 0; n < 2; ++n) { const f32x4 xi = *(const f32x4*)(xin + off + bj * HALF + n * 16); *(f32x4*)(out + off + bj * HALF + n * 16) = xi + gv[bj][n] * acc[ai][bj][m][n]; }
                if (m & 1) asm volatile("" ::: "memory"); }
    }
};

template <bool XF32> struct EpiResB {
    static constexpr bool PERM = true, AFTER_DRAIN = false;
    const void* xin; bf16_t* out; const float* gate;
    __device__ __forceinline__ void operator()(const f32x4 (&acc)[2][2][4][2], const Unit& u, int wr, int wc, int fr, int fq) const {
        const int col0 = u.pn * BM + wc * 32 + 8 * fq; const float* g = gate + (size_t)(u.pm >> 3) * 12288;
        f32x4 gv[2][2];
#pragma unroll
        for (int bj = 0; bj < 2; ++bj)
#pragma unroll
            for (int n = 0; n < 2; ++n) gv[bj][n] = *(const f32x4*)(g + col0 + bj * HALF + 4 * n);
#pragma unroll
        for (int ai = 0; ai < 2; ++ai)
#pragma unroll
            for (int m = 0; m < 4; ++m) { const size_t off = (size_t)(u.pm * BM + ai * HALF + wr * 64 + m * 16 + fr) * 2048 + col0;
#pragma unroll
                for (int bj = 0; bj < 2; ++bj) { f32x4 x0, x1;
                    if (XF32) { x0 = *(const f32x4*)((const float*)xin + off + bj * HALF); x1 = *(const f32x4*)((const float*)xin + off + bj * HALF + 4); }
                    else { const u32x4 w = *(const u32x4*)((const bf16_t*)xin + off + bj * HALF);
                        x0 = (f32x4){__builtin_bit_cast(float, w.x << 16), __builtin_bit_cast(float, w.x & 0xffff0000u), __builtin_bit_cast(float, w.y << 16), __builtin_bit_cast(float, w.y & 0xffff0000u)};
                        x1 = (f32x4){__builtin_bit_cast(float, w.z << 16), __builtin_bit_cast(float, w.z & 0xffff0000u), __builtin_bit_cast(float, w.w << 16), __builtin_bit_cast(float, w.w & 0xffff0000u)}; }
                    const f32x4 y0 = x0 + gv[bj][0] * acc[ai][bj][m][0], y1 = x1 + gv[bj][1] * acc[ai][bj][m][1];
                    u32x4 o; o.x = cvt_pk_bf16(y0[0], y0[1]); o.y = cvt_pk_bf16(y0[2], y0[3]); o.z = cvt_pk_bf16(y1[0], y1[1]); o.w = cvt_pk_bf16(y1[2], y1[3]);
                    *(u32x4*)(out + off + bj * HALF) = o; }
                if (m & 1) asm volatile("" ::: "memory"); }
    }
};

__device__ __forceinline__ float dpp_shr1(float oldv, float src) { return __builtin_bit_cast(float, __builtin_amdgcn_update_dpp(__builtin_bit_cast(int, oldv), __builtin_bit_cast(int, src), 0x111, 0xF, 0xF, false)); }
__device__ __forceinline__ float dpp_shr2(float oldv, float src) { return __builtin_bit_cast(float, __builtin_amdgcn_update_dpp(__builtin_bit_cast(int, oldv), __builtin_bit_cast(int, src), 0x112, 0xF, 0xF, false)); }
__device__ __forceinline__ float dpp_ror1(float src) { return __builtin_bit_cast(float, __builtin_amdgcn_update_dpp(0, __builtin_bit_cast(int, src), 0x121, 0xF, 0xF, false)); }
__device__ __forceinline__ float dpp_ror2(float src) { return __builtin_bit_cast(float, __builtin_amdgcn_update_dpp(0, __builtin_bit_cast(int, src), 0x122, 0xF, 0xF, false)); }
struct EpiUp {
    static constexpr bool PERM = true, AFTER_DRAIN = false;
    bf16_t* act; const float* wconv; const float* bconv; float* glast; float* gfirst; float* ufirst; PG8_LAS float* bnd;
    __device__ __forceinline__ void operator()(const f32x4 (&acc)[2][2][4][2], const Unit& u, int wr, int wc, int fr, int fq) const {
        const int cl = wc * 32 + 8 * fq, c0 = u.pn * 128 + cl;
        f32x4 w0[2], w1[2], w2[2], cb[2];
#pragma unroll
        for (int n = 0; n < 2; ++n) { w0[n] = *(const f32x4*)(wconv + c0 + 4 * n); w1[n] = *(const f32x4*)(wconv + 5632 + c0 + 4 * n); w2[n] = *(const f32x4*)(wconv + 2 * 5632 + c0 + 4 * n); cb[n] = *(const f32x4*)(bconv + c0 + 4 * n); }
        if (fr >= 14) {
#pragma unroll
            for (int ai = 0; ai < 2; ++ai)
#pragma unroll
                for (int n = 0; n < 2; ++n) *(PG8_LAS f32x4*)(bnd + ((2 * ai + wr) * 2 + (fr - 14)) * 128 + cl + 4 * n) = acc[ai][1][3][n];
            if (wr == 1) {
#pragma unroll
                for (int n = 0; n < 2; ++n) *(f32x4*)(glast + ((size_t)u.pm * 2 + (fr - 14)) * 5632 + c0 + 4 * n) = acc[1][1][3][n]; }
        }
        if (wr == 0 && fr < 2) {
#pragma unroll
            for (int n = 0; n < 2; ++n) { *(f32x4*)(gfirst + ((size_t)u.pm * 2 + fr) * 5632 + c0 + 4 * n) = acc[0][1][0][n]; *(f32x4*)(ufirst + ((size_t)u.pm * 2 + fr) * 5632 + c0 + 4 * n) = acc[0][0][0][n]; }
        }
        asm volatile("s_waitcnt lgkmcnt(0)" ::: "memory"); __builtin_amdgcn_s_barrier(); asm volatile("" ::: "memory");
#pragma unroll
        for (int ai = 0; ai < 2; ++ai) {
            const int bp = 2 * ai + wr - 1;
            f32x4 h1[2], h2[2];
#pragma unroll
            for (int n = 0; n < 2; ++n) { if (bp >= 0) { h1[n] = *(const PG8_LAS f32x4*)(bnd + (bp * 2 + 1) * 128 + cl + 4 * n); h2[n] = *(const PG8_LAS f32x4*)(bnd + (bp * 2 + 0) * 128 + cl + 4 * n); } else { h1[n] = (f32x4){0.f, 0.f, 0.f, 0.f}; h2[n] = (f32x4){0.f, 0.f, 0.f, 0.f}; } }
#pragma unroll
            for (int m = 0; m < 4; ++m) {
                unsigned pk[4];
#pragma unroll
                for (int n = 0; n < 2; ++n) {
                    float a[4];
#pragma unroll
                    for (int e = 0; e < 4; ++e) {
                        const float cur = acc[ai][1][m][n][e]; float o1, o2;
                        if (m == 0) { o1 = h1[n][e]; o2 = (fr == 0) ? h2[n][e] : h1[n][e]; }
                        else { o1 = dpp_ror1(acc[ai][1][m - 1][n][e]); o2 = dpp_ror2(acc[ai][1][m - 1][n][e]); }
                        const float g1 = dpp_shr1(o1, cur), g2 = dpp_shr2(o2, cur);
                        a[e] = w0[n][e] * g2 + w1[n][e] * g1 + w2[n][e] * cur + cb[n][e];
                    }
                    const f32x2 ga = gelu_pk((f32x2){a[0], a[1]}), gb = gelu_pk((f32x2){a[2], a[3]});
                    pk[2 * n] = cvt_pk_bf16(ga.x * acc[ai][0][m][n][0], ga.y * acc[ai][0][m][n][1]); pk[2 * n + 1] = cvt_pk_bf16(gb.x * acc[ai][0][m][n][2], gb.y * acc[ai][0][m][n][3]);
                }
                u32x4 w; w.x = pk[0]; w.y = pk[1]; w.z = pk[2]; w.w = pk[3];
                *(u32x4*)(act + (size_t)(u.pm * BM + ai * HALF + wr * 64 + m * 16 + fr) * 5632 + c0) = w;
                asm volatile("" ::: "memory");
            }
        }
    }
};

struct EpiNull {
    static constexpr bool PERM = true, AFTER_DRAIN = false;
    __device__ __forceinline__ void operator()(const f32x4 (&acc)[2][2][4][2], const Unit&, int, int, int, int) const {
#pragma unroll
        for (int ai = 0; ai < 2; ++ai)
#pragma unroll
            for (int bj = 0; bj < 2; ++bj)
#pragma unroll
                for (int m = 0; m < 4; ++m)
#pragma unroll
                    for (int n = 0; n < 2; ++n) asm volatile("" :: "v"(acc[ai][bj][m][n]));
    }
};
template <class Epi, class Sched, bool ALIGN_EPI = false, bool SP2 = false>
__device__ __forceinline__ void gemm_phase(PG8_LAS unsigned char* lds, const Gemm g, const Sched& S, const Epi& E) {
    int tid_o = threadIdx.x; asm volatile("" : "+v"(tid_o));
    const int tid = tid_o, wid = __builtin_amdgcn_readfirstlane(tid >> 6), lane = tid & 63, wr = wid >> 2, wc = wid & 3, fr = lane & 15, fq = lane >> 4;
    const int K = g.K, nt = K / BK;
    unsigned voffA[2], voffB[2];
#pragma unroll
    for (int i = 0; i < 2; ++i) { int R, C; stage_rc(tid * 16 + i * 8192, R, C); const int Rb = Epi::PERM ? ((R & ~31) + perm32(R & 31)) : R;
        voffA[i] = (unsigned)(R * K + C) * 2u; voffB[i] = (unsigned)(Rb * K + C) * 2u; }
    const size_t kstep = (size_t)(BK * 2);
    const size_t hstep = (size_t)HALF * K * 2;
    const size_t tstep = 2 * hstep;
    const unsigned ldsw = (unsigned)wid * 1024u;
    const int aoff = lds_byte(wr * 64 + fr, fq * 8), boff = lds_byte(wc * 32 + fr, fq * 8);
#define PG8_SA(b, h) (((b) * 2 + (h)) * HTB)
#define PG8_SB(b, h) ((4 + (b) * 2 + (h)) * HTB)
#define PG8_STAGE(bufoff, gbase, voff) do { _Pragma("unroll") for (int _i = 0; _i < 2; ++_i) \
        __builtin_amdgcn_global_load_lds((const unsigned*)((const char*)(gbase) + (voff)[_i]), (PG8_LAS unsigned*)(lds + (bufoff) + ldsw + _i * 8192), 16, 0, 0); } while (0)
#define PG8_LDA(dst, b, h) do { _Pragma("unroll") for (int m = 0; m < 4; ++m) _Pragma("unroll") for (int k = 0; k < 2; ++k) dst[m][k] = *(const PG8_LAS bf16x8*)(lds + PG8_SA(b, h) + aoff + m * 2048 + k * 1024); } while (0)
#define PG8_LDB(dst, b, h) do { _Pragma("unroll") for (int n = 0; n < 2; ++n) _Pragma("unroll") for (int k = 0; k < 2; ++k) dst[n][k] = *(const PG8_LAS bf16x8*)(lds + PG8_SB(b, h) + boff + n * 2048 + k * 1024); } while (0)
#define PG8_MMA(ai, bj, At, Bt) do { __builtin_amdgcn_s_setprio(1); _Pragma("unroll") for (int m = 0; m < 4; ++m) _Pragma("unroll") for (int n = 0; n < 2; ++n) _Pragma("unroll") for (int k = 0; k < 2; ++k) \
        acc[ai][bj][m][n] = __builtin_amdgcn_mfma_f32_16x16x32_bf16(Bt[n][k], At[m][k], acc[ai][bj][m][n], 0, 0, 0); __builtin_amdgcn_s_setprio(0); } while (0)
#define PG8_WAIT_V(n) asm volatile("s_waitcnt vmcnt(" #n ")" ::: "memory")
#define PG8_WAIT_L(n) asm volatile("s_waitcnt lgkmcnt(" #n ")" ::: "memory")
#define PG8_BAR __builtin_amdgcn_s_barrier()
#define PG8_SCHED __builtin_amdgcn_sched_barrier(0)
    Unit cur, nxt; int ui = 0;
    if (!S.next(0, cur)) return;
    f32x4 acc[2][2][4][2];
#pragma unroll
    for (int a = 0; a < 2; ++a)
#pragma unroll
        for (int b = 0; b < 2; ++b)
#pragma unroll
            for (int m = 0; m < 4; ++m)
#pragma unroll
                for (int n = 0; n < 2; ++n) acc[a][b][m][n] = (f32x4){0.f, 0.f, 0.f, 0.f};
    bf16x8 At[4][2], B0[2][2], B1[2][2];
    const char* cA = (const char*)g.A + (size_t)cur.pm * tstep; const char* cB = (const char*)g.Bt + (size_t)cur.pn * tstep;
    S.a_ready(cur);
    if constexpr (SP2) {
        PG8_STAGE(PG8_SB(0, 0), cB, voffB); PG8_STAGE(PG8_SB(0, 1), cB + hstep, voffB); PG8_STAGE(PG8_SA(0, 0), cA, voffA); PG8_STAGE(PG8_SA(0, 1), cA + hstep, voffA);
        if (wr == 1) PG8_BAR;
        PG8_WAIT_V(2); PG8_BAR;
        PG8_STAGE(PG8_SB(1, 0), cB + kstep, voffB); PG8_STAGE(PG8_SA(1, 0), cA + kstep, voffA); PG8_STAGE(PG8_SB(1, 1), cB + hstep + kstep, voffB);
        PG8_WAIT_V(6); PG8_BAR;
    } else {
        PG8_STAGE(PG8_SB(0, 0), cB, voffB); PG8_STAGE(PG8_SA(0, 0), cA, voffA); PG8_STAGE(PG8_SB(0, 1), cB + hstep, voffB); PG8_STAGE(PG8_SA(0, 1), cA + hstep, voffA);
        if (wr == 1) PG8_BAR;
        PG8_WAIT_V(4); PG8_BAR;
        PG8_STAGE(PG8_SB(1, 0), cB + kstep, voffB); PG8_STAGE(PG8_SA(1, 0), cA + kstep, voffA); PG8_STAGE(PG8_SB(1, 1), cB + hstep + kstep, voffB);
        PG8_WAIT_V(6); PG8_BAR;
    }
    for (;;) {
        const bool has_next = S.next(ui + 1, nxt);
        const char* nA = has_next ? (const char*)g.A + (size_t)nxt.pm * tstep : cA; const char* nB = has_next ? (const char*)g.Bt + (size_t)nxt.pn * tstep : cB;
        for (int t = 0; t < nt; t += 2) {
            const bool last = (t == nt - 2);
            const char* a1 = cA + (size_t)(t + 1) * kstep;
            const char* a2 = last ? nA : cA + (size_t)(t + 2) * kstep; const char* b2 = last ? nB : cB + (size_t)(t + 2) * kstep;
            const char* a3 = a2 + kstep; const char* b3 = b2 + kstep;
            if (last && has_next) S.a_ready(nxt);
            if constexpr (SP2) {
            PG8_LDB(B0, 0, 0); PG8_LDB(B1, 0, 1); PG8_SCHED; PG8_LDA(At, 0, 0); PG8_STAGE(PG8_SA(1, 1), a1 + hstep, voffA);
            PG8_WAIT_V(8); PG8_WAIT_L(0); PG8_BAR; PG8_MMA(0, 0, At, B0); PG8_MMA(0, 1, At, B1); PG8_BAR; PG8_SCHED;
            PG8_LDA(At, 0, 1); PG8_STAGE(PG8_SB(0, 0), b2, voffB); PG8_STAGE(PG8_SB(0, 1), b2 + hstep, voffB); PG8_STAGE(PG8_SA(0, 0), a2, voffA);
            PG8_WAIT_V(8); PG8_WAIT_L(0); PG8_BAR; PG8_MMA(1, 0, At, B0); PG8_MMA(1, 1, At, B1); PG8_BAR; PG8_SCHED;
            PG8_LDB(B0, 1, 0); PG8_LDB(B1, 1, 1); PG8_SCHED; PG8_LDA(At, 1, 0); PG8_STAGE(PG8_SA(0, 1), a2 + hstep, voffA);
            PG8_WAIT_V(8); PG8_WAIT_L(0); PG8_BAR; PG8_MMA(0, 0, At, B0); PG8_MMA(0, 1, At, B1); PG8_BAR; PG8_SCHED;
            PG8_LDA(At, 1, 1); PG8_STAGE(PG8_SB(1, 0), b3, voffB); PG8_STAGE(PG8_SB(1, 1), b3 + hstep, voffB); PG8_STAGE(PG8_SA(1, 0), a3, voffA);
            PG8_WAIT_V(8); PG8_WAIT_L(0); PG8_BAR; PG8_MMA(1, 0, At, B0); PG8_MMA(1, 1, At, B1); PG8_BAR; PG8_SCHED;
            } else {
            PG8_LDB(B0, 0, 0); PG8_SCHED; PG8_LDA(At, 0, 0); PG8_STAGE(PG8_SA(1, 1), a1 + hstep, voffA);
            PG8_WAIT_L(8); PG8_BAR; PG8_WAIT_L(0); PG8_MMA(0, 0, At, B0); PG8_BAR; PG8_SCHED;
            PG8_LDB(B1, 0, 1); PG8_STAGE(PG8_SB(0, 0), b2, voffB);
            PG8_BAR; PG8_WAIT_L(0); PG8_MMA(0, 1, At, B1); PG8_BAR;
            PG8_LDA(At, 0, 1); PG8_STAGE(PG8_SA(0, 0), a2, voffA);
            PG8_BAR; PG8_WAIT_L(0); PG8_MMA(1, 0, At, B0); PG8_BAR; PG8_SCHED;
            PG8_STAGE(PG8_SB(0, 1), b2 + hstep, voffB);
            PG8_WAIT_V(6); PG8_BAR; PG8_MMA(1, 1, At, B1); PG8_BAR;
            PG8_LDB(B0, 1, 0); PG8_SCHED; PG8_LDA(At, 1, 0); PG8_STAGE(PG8_SA(0, 1), a2 + hstep, voffA);
            PG8_WAIT_L(8); PG8_BAR; PG8_WAIT_L(0); PG8_MMA(0, 0, At, B0); PG8_BAR; PG8_SCHED;
            PG8_LDB(B1, 1, 1); PG8_STAGE(PG8_SB(1, 0), b3, voffB);
            PG8_BAR; PG8_WAIT_L(0); PG8_MMA(0, 1, At, B1); PG8_BAR;
            PG8_LDA(At, 1, 1); PG8_STAGE(PG8_SA(1, 0), a3, voffA);
            PG8_BAR; PG8_WAIT_L(0); PG8_MMA(1, 0, At, B0); PG8_BAR; PG8_SCHED;
            PG8_STAGE(PG8_SB(1, 1), b3 + hstep, voffB);
            PG8_WAIT_V(6); PG8_BAR; PG8_MMA(1, 1, At, B1); PG8_BAR;
            }
        }
        if constexpr (ALIGN_EPI) { if (wr == 0) PG8_BAR; }
        if constexpr (!Epi::AFTER_DRAIN) { E(acc, cur, wr, wc, fr, fq); S.done(cur); }
        if (!has_next) break;
#pragma unroll
        for (int a = 0; a < 2; ++a)
#pragma unroll
            for (int b = 0; b < 2; ++b)
#pragma unroll
                for (int m = 0; m < 4; ++m)
#pragma unroll
                    for (int n = 0; n < 2; ++n) acc[a][b][m][n] = (f32x4){0.f, 0.f, 0.f, 0.f};
        cur = nxt; cA = nA; cB = nB; ++ui;
        if constexpr (ALIGN_EPI) { if (wr == 1) PG8_BAR; }
    }
    PG8_WAIT_V(0);
    if constexpr (!ALIGN_EPI) { if (wr == 0) PG8_BAR; }
    PG8_BAR;
    if constexpr (Epi::AFTER_DRAIN) { E.fused(acc, cur, wr, wc, fr, fq, lds, wid, lane); S.done(cur); }
#undef PG8_SA
#undef PG8_SB
#undef PG8_STAGE
#undef PG8_LDA
#undef PG8_LDB
#undef PG8_MMA
#undef PG8_WAIT_V
#undef PG8_WAIT_L
#undef PG8_BAR
#undef PG8_SCHED
}
}

constexpr int NB = 16, T = 2048, D = 2048, M = NB * T, NP = 6656, NIN = 6160, FF = 5632, NUP = 2 * FF, NMOD = 12288;
constexpr float EPS = 1e-6f, LOG2E = 1.4426950408889634f;
constexpr int NWAVES = 8;
constexpr size_t MiB = 1u << 20;
constexpr size_t WS_CTL = 0, CTL_ZERO_BYTES = 1 * MiB;
constexpr size_t WS_MOD = 1 * MiB;
constexpr size_t WS_SCAL = 3 * MiB;
constexpr size_t WS_WIN = 4 * MiB;
constexpr size_t WS_WO = 56 * MiB;
constexpr size_t WS_WUP = 72 * MiB;
constexpr size_t WS_WDN = 160 * MiB;
constexpr size_t WS_HALO = 204 * MiB;
constexpr size_t HALO_ONE = (size_t)128 * 2 * 5632 * 4;
constexpr size_t WS_HN = 224 * MiB;
constexpr size_t WS_PROJ = 352 * MiB;
constexpr size_t WS_XB = 768 * MiB;
constexpr size_t WS_END = 896 * MiB;
static_assert(WS_WIN + (size_t)2 * NP * D * 2 <= WS_WO && WS_WO + (size_t)2 * D * D * 2 <= WS_WUP && WS_WUP + (size_t)2 * NUP * D * 2 <= WS_WDN && WS_WDN + (size_t)2 * D * FF * 2 <= WS_HALO &&
              WS_HALO + 3 * HALO_ONE <= WS_HN && WS_HN + (size_t)M * D * 2 <= WS_PROJ && WS_PROJ + (size_t)M * NP * 2 <= WS_XB && WS_XB + (size_t)M * D * 2 <= WS_END, "d_ws map");
constexpr int CW_TMO = 0, CW_CODE = 1, CW_BAR = 4096, CW_QUEUE = 16384;
constexpr int RING_OFF = 0, RING_BYTES = 131072, BND_OFF = RING_BYTES, LDSCTL_OFF = BND_OFF + 4096, LDS_BYTES = 147456;

#define GAS __attribute__((address_space(1)))
#define LAS __attribute__((address_space(3)))
typedef unsigned short bf16;
typedef unsigned v4u __attribute__((ext_vector_type(4)));
typedef unsigned v2u __attribute__((ext_vector_type(2)));
typedef float f32x4 __attribute__((ext_vector_type(4)));
typedef GAS unsigned gu32;
#define RLX_AGENT __ATOMIC_RELAXED, __HIP_MEMORY_SCOPE_AGENT
#define LDS_WAIT() asm volatile("s_waitcnt lgkmcnt(0)" ::: "memory")
__device__ __forceinline__ unsigned f2bf(float f) { unsigned u = __builtin_bit_cast(unsigned, f); return (u + 0x7fffu + ((u >> 16) & 1u)) >> 16; }
__device__ __forceinline__ unsigned pk2(float lo, float hi) { return f2bf(lo) | (f2bf(hi) << 16); }
__device__ __forceinline__ float bf2f(unsigned short h) { return __builtin_bit_cast(float, (unsigned)h << 16); }
__device__ __forceinline__ float bflo(unsigned w) { return __builtin_bit_cast(float, w << 16); }
__device__ __forceinline__ float bfhi(unsigned w) { return __builtin_bit_cast(float, w & 0xffff0000u); }
#define DPPF(v, ctrl) __builtin_bit_cast(float, __builtin_amdgcn_update_dpp(0, __builtin_bit_cast(int, (v)), (ctrl), 0xF, 0xF, true))
__device__ __forceinline__ float wave_sum(float v) {
    v += DPPF(v, 0xB1);
    v += DPPF(v, 0x4E);
    v += DPPF(v, 0x141);
    v += DPPF(v, 0x140);
    v += __builtin_bit_cast(float, __builtin_amdgcn_ds_swizzle(__builtin_bit_cast(int, v), 0x401F));
    float a = v, b = v;
    asm volatile("s_nop 1\n\tv_permlane32_swap_b32_e32 %0, %1\n\ts_nop 1" : "+v"(a), "+v"(b));
    return a + b;
}
struct Args { const float* in[18]; float* out; unsigned char* ws; int ph_lo, ph_hi, pad0, pad1; };
typedef const __attribute__((address_space(4))) Args CArgs;
#define ARGS() ({ CArgs* p_ = (CArgs*)__builtin_amdgcn_kernarg_segment_ptr(); asm volatile("" : "+s"(p_)); p_; })
#define XB_TMO      128
#define XB_XCNT(j)  (256  + 64 * (j))
#define XB_XSUB(j)  (1280 + 64 * (j))
#define XB_XGEN(j)  (2304 + 64 * (j))
#define XB_TOP      3328
#define XB_TOPGEN   3392
#define XCD_BAR_WORDS 3456
#define XB_SPIN_CAP (1u << 18)

__device__ __forceinline__ unsigned xb_ld(unsigned* p)              { return __hip_atomic_load(p, __ATOMIC_RELAXED, __HIP_MEMORY_SCOPE_AGENT); }
__device__ __forceinline__ unsigned xb_add(unsigned* p, unsigned v) { return __hip_atomic_fetch_add(p, v, __ATOMIC_RELAXED, __HIP_MEMORY_SCOPE_AGENT); }
__device__ __forceinline__ unsigned xb_xcc_id() { return (unsigned)__builtin_amdgcn_s_getreg((3 << 11) | 20) & 0xFu; }
#define XB_SPIN(cond, bar) do { unsigned _sp = 0; while (cond) { __builtin_amdgcn_s_sleep(1); \
    if ((++_sp & 255u) == 0u) { if (xb_ld(&(bar)[XB_TMO])) break; if (_sp > XB_SPIN_CAP) { atomicAdd(&(bar)[XB_TMO], 1u); break; } } } } while (0)

struct XcdBarrier {
    unsigned* bar; unsigned x;
    volatile LAS unsigned* st;
};

__device__ __forceinline__ XcdBarrier xcd_barrier_post(unsigned* bar, volatile LAS unsigned* st) {
    XcdBarrier b; b.bar = bar; b.x = xb_xcc_id(); b.st = st;
    if (threadIdx.x == 0) (void)xb_add(&bar[XB_XCNT(b.x)], 1u);
    return b;
}
__device__ __forceinline__ void xcd_barrier_complete(unsigned* bar, unsigned x, unsigned& nloc, unsigned& nx) {
    const unsigned G = gridDim.x * gridDim.y * gridDim.z;
    unsigned sum, cnt, mine, sp = 0u;
    for (;;) {
        sum = 0u; cnt = 0u; mine = 0u;
#pragma unroll
        for (unsigned j = 0; j < 16; ++j) { const unsigned c = xb_ld(&bar[XB_XCNT(j)]); sum += c; cnt += (c > 0u) ? 1u : 0u; mine = (j == x) ? c : mine; }
        if (sum == G) break;
        __builtin_amdgcn_s_sleep(1);
        if ((++sp & 255u) == 0u) { if (xb_ld(&bar[XB_TMO])) break; if (sp > XB_SPIN_CAP) { atomicAdd(&bar[XB_TMO], 1u); break; } }
    }
    nloc = mine > 0u ? mine : 1u; nx = cnt > 0u ? cnt : 1u;
}

__device__ __forceinline__ void xcd_barrier(const XcdBarrier& b) {
    asm volatile("s_waitcnt vmcnt(0)" ::: "memory");
    __syncthreads();
    if (threadIdx.x == 0) {
        unsigned* bar = b.bar;
        __builtin_amdgcn_s_waitcnt(0);
        unsigned nloc = b.st[0], nx = b.st[1];
        if (nloc == 0u) { xcd_barrier_complete(bar, b.x, nloc, nx); b.st[0] = nloc; b.st[1] = nx; }
        const unsigned old = xb_add(&bar[XB_XSUB(b.x)], 1u);
        const unsigned gen = old / nloc;
        if (old + 1u == (gen + 1u) * nloc) {
            __builtin_amdgcn_fence(__ATOMIC_RELEASE, "agent");
            asm volatile("s_waitcnt vmcnt(0)" ::: "memory");
            const unsigned og = xb_add(&bar[XB_TOP], 1u);
            const unsigned tg = og / nx;
            if (og + 1u == (tg + 1u) * nx) xb_add(&bar[XB_TOPGEN], 1u);
            else XB_SPIN(xb_ld(&bar[XB_TOPGEN]) == tg, bar);
            __builtin_amdgcn_fence(__ATOMIC_ACQUIRE, "agent");
            xb_add(&bar[XB_XGEN(b.x)], 1u);
            asm volatile("s_waitcnt vmcnt(0)" ::: "memory");
        } else {
            XB_SPIN(xb_ld(&bar[XB_XGEN(b.x)]) == gen, bar);
            __builtin_amdgcn_fence(__ATOMIC_ACQUIRE, "agent");
            asm volatile("s_waitcnt vmcnt(0)" ::: "memory");
        }
    }
    __syncthreads();
}


__device__ __forceinline__ void p0_write_item(bf16* WT, int K, int dst_row, int k0, LAS float* scr, int lane) {
    LDS_WAIT(); asm volatile("" ::: "memory");
    const int c = lane & 7;
#pragma unroll
    for (int j = 0; j < 4; ++j) { const int n = (lane >> 3) + 8 * j; const LAS float* s = scr + (8 * c) * 33 + n;
        v4u o; o.x = pk2(s[0 * 33], s[1 * 33]); o.y = pk2(s[2 * 33], s[3 * 33]); o.z = pk2(s[4 * 33], s[5 * 33]); o.w = pk2(s[6 * 33], s[7 * 33]);
        *(GAS v4u*)(WT + (size_t)(dst_row + n) * K + k0 + 8 * c) = o; }
    LDS_WAIT(); asm volatile("" ::: "memory");
}
__device__ __forceinline__ void p0_transpose_item(const float* W, int ldw, int K, bf16* WT, int dst_row, int k0, int n0, LAS float* scr, int lane) {
#pragma unroll 8
    for (int i = 0; i < 32; ++i) { const int kk = 2 * i + (lane >> 5); scr[kk * 33 + (lane & 31)] = W[(size_t)(k0 + kk) * ldw + n0 + (lane & 31)]; }
    p0_write_item(WT, K, dst_row, k0, scr, lane);
}
__device__ __forceinline__ void p0_weff_item(const float* Win, const float* Wgk, bf16* WT, int k0, int n0, LAS float* scr, int lane) {
    const int n = lane & 31;
    float g[16];
#pragma unroll
    for (int r = 0; r < 16; ++r) g[r] = Wgk[r * 512 + n0 + n];
#pragma unroll 4
    for (int i = 0; i < 32; ++i) { const int kk = 2 * i + (lane >> 5); const float* wr = Win + (size_t)(k0 + kk) * NIN + 6144; float s = 0.f;
#pragma unroll
        for (int r = 0; r < 16; ++r) s += wr[r] * g[r];
        scr[kk * 33 + n] = s; }
    p0_write_item(WT, D, 6144 + n0, k0, scr, lane);
}

__device__ __forceinline__ void p0_prologue(const CArgs* ap, LAS unsigned char* lds, int tid, int lane, int wave, int vcu, int G) {
    unsigned char* ws = ap->ws;
    float* MOD = (float*)(ws + WS_MOD); float* SCAL = (float*)(ws + WS_SCAL);
    if (blockIdx.x < 96) {
        const int l = blockIdx.x / 48, cg = blockIdx.x % 48;
        LAS float* cs = (LAS float*)(lds + wave * 16384);
        const float* c = ap->in[1];
        for (int i = 0; i < 64; ++i) { const int e = lane + 64 * i, bb = e & 15, kk = e >> 4; const float cv = c[bb * D + 256 * wave + kk]; cs[kk * 16 + bb] = cv / (1.f + __expf(-cv)); }
        LDS_WAIT(); asm volatile("" ::: "memory");
        const float* W = ap->in[2] + (size_t)l * D * NMOD + (size_t)(256 * wave) * NMOD + 256 * cg + 4 * lane;
        f32x4 acc[16];
#pragma unroll
        for (int i = 0; i < 16; ++i) acc[i] = (f32x4){0.f, 0.f, 0.f, 0.f};
#pragma unroll 4
        for (int kk = 0; kk < 256; ++kk) { const f32x4 w = __builtin_nontemporal_load((const f32x4*)(W + (size_t)kk * NMOD));
#pragma unroll
            for (int q4 = 0; q4 < 4; ++q4) { const f32x4 c4 = *(const LAS f32x4*)(cs + kk * 16 + 4 * q4);
                acc[4 * q4 + 0] += c4.x * w; acc[4 * q4 + 1] += c4.y * w; acc[4 * q4 + 2] += c4.z * w; acc[4 * q4 + 3] += c4.w * w; } }
        __syncthreads();
        LAS float* red = (LAS float*)lds;
#pragma unroll
        for (int bb = 0; bb < 16; ++bb) *(LAS f32x4*)(red + (wave * 16 + bb) * 256 + 4 * lane) = acc[bb];
        __syncthreads();
        for (int i = 0; i < 8; ++i) { const int o = tid + 512 * i, bb = o >> 8, col = o & 255; float s = ap->in[3][l * NMOD + 256 * cg + col];
#pragma unroll
            for (int w = 0; w < 8; ++w) s += red[(w * 16 + bb) * 256 + col];
            MOD[(size_t)(l * 16 + bb) * NMOD + 256 * cg + col] = s; }
        __syncthreads();
    }
    if (blockIdx.x == 96 && wave == 0) {
        for (int l = 0; l < 2; ++l) { const float* dl = ap->in[6] + l * 256; float s1 = dl[lane] * dl[64 + lane], s2 = dl[128 + lane] * dl[192 + lane];
            s1 = wave_sum(s1); s2 = wave_sum(s2);
            if (lane == 0) SCAL[l] = __expf(s1) - __expf(s2) + (l == 0 ? 0.2f : 0.35550906759096926f); }
    }
    LAS float* scr = (LAS float*)(lds + wave * 16384);
    const int gw = vcu * NWAVES + wave, NGW = G * NWAVES;
    constexpr int I_IN = 32 * 192, I_EFF = 32 * 16, I_O = 32 * 64, I_UP = 32 * 352, I_DN = 88 * 64, I_L = I_IN + I_EFF + I_O + I_UP + I_DN;
    for (int it = gw; it < 2 * I_L; it += NGW) {
        const int l = it / I_L; int r = it % I_L;
        bf16* WINt = (bf16*)(ws + WS_WIN) + (size_t)l * NP * D; bf16* WOt = (bf16*)(ws + WS_WO) + (size_t)l * D * D;
        bf16* WUPt = (bf16*)(ws + WS_WUP) + (size_t)l * NUP * D; bf16* WDNt = (bf16*)(ws + WS_WDN) + (size_t)l * D * FF;
        const float* w_in = ap->in[5] + (size_t)l * D * NIN;
        if (r < I_IN) { const int kb = r / 192, nb = r % 192; p0_transpose_item(w_in, NIN, D, WINt, 32 * nb, 64 * kb, 32 * nb, scr, lane); continue; } r -= I_IN;
        if (r < I_EFF) { const int kb = r / 16, nb = r % 16; p0_weff_item(w_in, ap->in[8] + (size_t)l * 16 * 512, WINt, 64 * kb, 32 * nb, scr, lane); continue; } r -= I_EFF;
        if (r < I_O) { const int kb = r / 64, nb = r % 64; p0_transpose_item(ap->in[11] + (size_t)l * D * D, D, D, WOt, 32 * nb, 64 * kb, 32 * nb, scr, lane); continue; } r -= I_O;
        if (r < I_UP) { const int kb = r / 352, nb = r % 352, n0 = 32 * nb; const int n1 = n0 < FF ? n0 : n0 - FF; const int dst = 256 * (n1 / 128) + (n1 % 128) + (n0 < FF ? 0 : 128);
            p0_transpose_item(ap->in[13] + (size_t)l * D * NUP, NUP, D, WUPt, dst, 64 * kb, n0, scr, lane); continue; } r -= I_UP;
        { const int kb = r / 64, nb = r % 64; p0_transpose_item(ap->in[16] + (size_t)l * FF * D, D, FF, WDNt, 32 * nb, 64 * kb, 32 * nb, scr, lane); }
    }
}

__device__ __forceinline__ void norm_phase(const float* xin, const float* g, const float* modl, int sh_chunk, int sc_chunk, bf16* outp, int gw, int NGW, int lane) {
    for (int rb = gw; rb < M / 16; rb += NGW) {
        const int b = rb >> 7; const float* mb = modl + (size_t)b * NMOD;
        f32x4 A[8], S[8];
#pragma unroll
        for (int j = 0; j < 8; ++j) { const int col = 4 * lane + 256 * j; const f32x4 gv = *(const f32x4*)(g + col), sc = *(const f32x4*)(mb + sc_chunk * D + col); A[j] = gv * (1.f + sc); S[j] = *(const f32x4*)(mb + sh_chunk * D + col); }
        for (int r = 0; r < 16; ++r) {
            const size_t row = (size_t)rb * 16 + r; const GAS f32x4* xr = (const GAS f32x4*)(xin + row * D) + lane;
            f32x4 v[8]; float s = 0.f;
#pragma unroll
            for (int j = 0; j < 8; ++j) { v[j] = xr[64 * j]; s += (v[j].x * v[j].x + v[j].y * v[j].y) + (v[j].z * v[j].z + v[j].w * v[j].w); }
            const float rstd = 1.f / sqrtf(wave_sum(s) * (1.f / D) + EPS);
            GAS v2u* o8 = (GAS v2u*)(outp + row * D) + lane;
#pragma unroll
            for (int j = 0; j < 8; ++j) { const f32x4 y = v[j] * rstd * A[j] + S[j]; v2u w; w.x = pk2(y.x, y.y); w.y = pk2(y.z, y.w); o8[64 * j] = w; }
        }
    }
}
__device__ __forceinline__ void final_norm_phase(float* x, const float* g, int gw, int NGW, int lane) {
    f32x4 A[8];
#pragma unroll
    for (int j = 0; j < 8; ++j) A[j] = *(const f32x4*)(g + 4 * lane + 256 * j);
    for (int row = gw; row < M; row += NGW) {
        GAS f32x4* xr = (GAS f32x4*)(x + (size_t)row * D) + lane;
        f32x4 v[8]; float s = 0.f;
#pragma unroll
        for (int j = 0; j < 8; ++j) { v[j] = xr[64 * j]; s += (v[j].x * v[j].x + v[j].y * v[j].y) + (v[j].z * v[j].z + v[j].w * v[j].w); }
        const float rstd = 1.f / sqrtf(wave_sum(s) * (1.f / D) + EPS);
#pragma unroll
        for (int j = 0; j < 8; ++j) xr[64 * j] = v[j] * rstd * A[j];
    }
}

__device__ __forceinline__ void norm_phase_b(const bf16* xin, const float* g, const float* modl, int sh_chunk, int sc_chunk, bf16* outp, int gw, int NGW, int lane) {
    for (int rb = gw; rb < M / 16; rb += NGW) {
        const int b = rb >> 7; const float* mb = modl + (size_t)b * NMOD;
        f32x4 A[8], S[8];
#pragma unroll
        for (int j = 0; j < 8; ++j) { const int col = 8 * lane + 512 * (j >> 1) + 4 * (j & 1); const f32x4 gv = *(const f32x4*)(g + col), sc = *(const f32x4*)(mb + sc_chunk * D + col); A[j] = gv * (1.f + sc); S[j] = *(const f32x4*)(mb + sh_chunk * D + col); }
        for (int r = 0; r < 16; ++r) {
            const size_t row = (size_t)rb * 16 + r; const GAS v4u* xr = (const GAS v4u*)(xin + row * D) + lane;
            f32x4 v[8]; float s = 0.f;
#pragma unroll
            for (int j = 0; j < 4; ++j) { const v4u w = xr[64 * j]; v[2 * j] = (f32x4){bflo(w.x), bfhi(w.x), bflo(w.y), bfhi(w.y)}; v[2 * j + 1] = (f32x4){bflo(w.z), bfhi(w.z), bflo(w.w), bfhi(w.w)}; }
#pragma unroll
            for (int j = 0; j < 8; ++j) s += (v[j].x * v[j].x + v[j].y * v[j].y) + (v[j].z * v[j].z + v[j].w * v[j].w);
            const float rstd = 1.f / sqrtf(wave_sum(s) * (1.f / D) + EPS);
            GAS v4u* o16 = (GAS v4u*)(outp + row * D) + lane;
#pragma unroll
            for (int j = 0; j < 4; ++j) { const f32x4 y0 = v[2 * j] * rstd * A[2 * j] + S[2 * j], y1 = v[2 * j + 1] * rstd * A[2 * j + 1] + S[2 * j + 1]; v4u w; w.x = pk2(y0.x, y0.y); w.y = pk2(y0.z, y0.w); w.z = pk2(y1.x, y1.y); w.w = pk2(y1.z, y1.w); o16[64 * j] = w; }
        }
    }
}
__device__ __forceinline__ void final_norm_phase_b(const bf16* x, float* out, const float* g, int gw, int NGW, int lane) {
    f32x4 A[8];
#pragma unroll
    for (int j = 0; j < 8; ++j) A[j] = *(const f32x4*)(g + 8 * lane + 512 * (j >> 1) + 4 * (j & 1));
    for (int row = gw; row < M; row += NGW) {
        const GAS v4u* xr = (const GAS v4u*)(x + (size_t)row * D) + lane;
        f32x4 v[8]; float s = 0.f;
#pragma unroll
        for (int j = 0; j < 4; ++j) { const v4u w = xr[64 * j]; v[2 * j] = (f32x4){bflo(w.x), bfhi(w.x), bflo(w.y), bfhi(w.y)}; v[2 * j + 1] = (f32x4){bflo(w.z), bfhi(w.z), bflo(w.w), bfhi(w.w)}; }
#pragma unroll
        for (int j = 0; j < 8; ++j) s += (v[j].x * v[j].x + v[j].y * v[j].y) + (v[j].z * v[j].z + v[j].w * v[j].w);
        const float rstd = 1.f / sqrtf(wave_sum(s) * (1.f / D) + EPS);
        GAS f32x4* o = (GAS f32x4*)(out + (size_t)row * D) + 2 * lane;
#pragma unroll
        for (int j = 0; j < 4; ++j) { o[128 * j] = v[2 * j] * rstd * A[2 * j]; o[128 * j + 1] = v[2 * j + 1] * rstd * A[2 * j + 1]; }
    }
}
__device__ __forceinline__ void fixup_phase(const float* glast, const float* gfirst, const float* ufirst, const float* wconv, const float* bconv, bf16* act, int gtid, int nthreads) {
    constexpr int PER_ROW = FF / 4, TOTAL = 112 * 2 * PER_ROW;
    for (int idx = gtid; idx < TOTAL; idx += nthreads) {
        const int c = (idx % PER_ROW) * 4, rr = (idx / PER_ROW) & 1, pmi = idx / (2 * PER_ROW), pm = (pmi / 7) * 8 + (pmi % 7) + 1;
        const f32x4 gl0 = *(const f32x4*)(glast + ((size_t)(pm - 1) * 2 + 0) * FF + c), gl1 = *(const f32x4*)(glast + ((size_t)(pm - 1) * 2 + 1) * FF + c);
        const f32x4 gf0 = *(const f32x4*)(gfirst + ((size_t)pm * 2 + 0) * FF + c), gf1 = *(const f32x4*)(gfirst + ((size_t)pm * 2 + 1) * FF + c);
        const f32x4 uu = *(const f32x4*)(ufirst + ((size_t)pm * 2 + rr) * FF + c);
        const f32x4 w0 = *(const f32x4*)(wconv + c), w1 = *(const f32x4*)(wconv + FF + c), w2 = *(const f32x4*)(wconv + 2 * FF + c), cb = *(const f32x4*)(bconv + c);
        const f32x4 y = rr == 0 ? (w0 * gl0 + w1 * gl1 + w2 * gf0 + cb) : (w0 * gl1 + w1 * gf0 + w2 * gf1 + cb);
        const pg8::f32x2 ga = pg8::gelu_pk((pg8::f32x2){y.x, y.y}), gb = pg8::gelu_pk((pg8::f32x2){y.z, y.w});
        v2u w; w.x = pk2(ga.x * uu.x, ga.y * uu.y); w.y = pk2(gb.x * uu.z, gb.y * uu.w);
        *(GAS v2u*)(act + (size_t)(256 * pm + rr) * FF + c) = w;
    }
}

__device__ __forceinline__ void attn_naive_unit(const bf16* P, bf16* CAT, int b, int h, int qb, float lam, float subscale, const float* gsub, LAS float* xch, int tid) {
    const int wave = tid >> 6, lane = tid & 63, mp = wave >> 2, dvh = (wave >> 1) & 1, rloc = (wave & 1) * 64 + lane, row = 128 * qb + rloc;
    const float slope2 = exp2f(-(float)(h + 1)) * LOG2E;
    const bf16* prow = P + (size_t)(b * T + row) * NP + h * 128 + mp * 64;
    float q[64];
#pragma unroll
    for (int d8 = 0; d8 < 8; ++d8) { const v4u w = *(const v4u*)(prow + 8 * d8); q[8 * d8 + 0] = bflo(w.x); q[8 * d8 + 1] = bfhi(w.x); q[8 * d8 + 2] = bflo(w.y); q[8 * d8 + 3] = bfhi(w.y); q[8 * d8 + 4] = bflo(w.z); q[8 * d8 + 5] = bfhi(w.z); q[8 * d8 + 6] = bflo(w.w); q[8 * d8 + 7] = bfhi(w.w); }
    float o[64];
#pragma unroll
    for (int i = 0; i < 64; ++i) o[i] = 0.f;
    float m = -1e30f, l = 0.f;
    const int kmax = __builtin_amdgcn_readfirstlane(128 * qb + (wave & 1) * 64 + 63);
    const bf16* kbase = P + (size_t)(b * T) * NP + 1024 + h * 128 + mp * 64;
    const bf16* vbase = P + (size_t)(b * T) * NP + 2048 + h * 128 + dvh * 64;
    for (int kv = 0; kv <= kmax; ++kv) {
        const bf16* kr = kbase + (size_t)kv * NP; float s = 0.f;
#pragma unroll
        for (int d8 = 0; d8 < 8; ++d8) { const v4u w = *(const v4u*)(kr + 8 * d8);
            s += q[8 * d8 + 0] * bflo(w.x) + q[8 * d8 + 1] * bfhi(w.x) + q[8 * d8 + 2] * bflo(w.y) + q[8 * d8 + 3] * bfhi(w.y) + q[8 * d8 + 4] * bflo(w.z) + q[8 * d8 + 5] * bfhi(w.z) + q[8 * d8 + 6] * bflo(w.w) + q[8 * d8 + 7] * bfhi(w.w); }
        s += slope2 * (float)(kv - row);
        if (kv <= row) {
            if (s > m) { const float al = exp2f(m - s); l *= al;
#pragma unroll
                for (int i = 0; i < 64; ++i) o[i] *= al;
                m = s; }
            const float p = exp2f(s - m); l += p;
            const bf16* vr = vbase + (size_t)kv * NP;
#pragma unroll
            for (int d8 = 0; d8 < 8; ++d8) { const v4u w = *(const v4u*)(vr + 8 * d8);
                o[8 * d8 + 0] += p * bflo(w.x); o[8 * d8 + 1] += p * bfhi(w.x); o[8 * d8 + 2] += p * bflo(w.y); o[8 * d8 + 3] += p * bfhi(w.y); o[8 * d8 + 4] += p * bflo(w.z); o[8 * d8 + 5] += p * bfhi(w.z); o[8 * d8 + 6] += p * bflo(w.w); o[8 * d8 + 7] += p * bfhi(w.w); }
        }
    }
    const float inv = 1.f / l;
    LAS float* ssx = xch + 128 * 128;
    if (mp == 1) {
#pragma unroll
        for (int i = 0; i < 64; ++i) xch[(dvh * 64 + i) * 128 + rloc] = o[i] * inv; }
    __syncthreads();
    if (mp == 0) {
        float ss = 0.f;
#pragma unroll
        for (int i = 0; i < 64; ++i) { o[i] = o[i] * inv - lam * xch[(dvh * 64 + i) * 128 + rloc]; ss += o[i] * o[i]; }
        ssx[dvh * 128 + rloc] = ss;
    }
    __syncthreads();
    if (mp == 0) {
        const float rstd = subscale / sqrtf((ssx[rloc] + ssx[128 + rloc]) * (1.f / 128.f) + EPS);
        bf16* orow = CAT + (size_t)(b * T + row) * D + h * 128 + dvh * 64; const float* gs = gsub + dvh * 64;
#pragma unroll
        for (int d8 = 0; d8 < 8; ++d8) { v4u w; w.x = pk2(o[8 * d8 + 0] * rstd * gs[8 * d8 + 0], o[8 * d8 + 1] * rstd * gs[8 * d8 + 1]); w.y = pk2(o[8 * d8 + 2] * rstd * gs[8 * d8 + 2], o[8 * d8 + 3] * rstd * gs[8 * d8 + 3]);
            w.z = pk2(o[8 * d8 + 4] * rstd * gs[8 * d8 + 4], o[8 * d8 + 5] * rstd * gs[8 * d8 + 5]); w.w = pk2(o[8 * d8 + 6] * rstd * gs[8 * d8 + 6], o[8 * d8 + 7] * rstd * gs[8 * d8 + 7]);
            *(GAS v4u*)(orow + 8 * d8) = w; }
    }
    __syncthreads();
}
__device__ __forceinline__ void gla_naive_unit(const bf16* P, bf16* CAT, int b, int h, float ogs, const float* gn, LAS float* lf, int tid) {
    const int e = tid & 255, dh = tid >> 8, wave = tid >> 6, lane = tid & 63;
    LAS float* sa = lf; LAS float* sk = lf + 2048; LAS float* sq = lf + 4096; LAS float* op = lf + 6144; LAS float* wss = lf + 6144 + 8192; LAS float* sv = lf + 6144 + 8192 + 64;
    float S[64];
#pragma unroll
    for (int i = 0; i < 64; ++i) S[i] = 0.f;
    const float gne = gn[e] * ogs;
    for (int t0 = 0; t0 < T; t0 += 16) {
        const bf16* pr0 = P + (size_t)(b * T + t0) * NP;
#pragma unroll
        for (int i = 0; i < 4; ++i) { const int idx = tid + 512 * i, tt = idx >> 7, d = idx & 127; const bf16* pr = pr0 + (size_t)tt * NP;
            sa[idx] = exp2f(LOG2E * bf2f(pr[6144 + h * 128 + d])); sk[idx] = bf2f(pr[3584 + h * 128 + d]); sq[idx] = bf2f(pr[3072 + h * 128 + d]); }
#pragma unroll
        for (int i = 0; i < 8; ++i) { const int tt = 2 * i + dh; sv[tt * 256 + e] = bf2f(pr0[(size_t)tt * NP + 4096 + h * 256 + e]); }
        __syncthreads();
#pragma unroll 1
        for (int tt = 0; tt < 16; ++tt) { float acc = 0.f; const float vv = sv[tt * 256 + e];
#pragma unroll
            for (int d4 = 0; d4 < 16; ++d4) { const f32x4 a4 = *(const LAS f32x4*)(sa + tt * 128 + 64 * dh + 4 * d4), k4 = *(const LAS f32x4*)(sk + tt * 128 + 64 * dh + 4 * d4), q4 = *(const LAS f32x4*)(sq + tt * 128 + 64 * dh + 4 * d4);
#pragma unroll
                for (int c = 0; c < 4; ++c) { S[4 * d4 + c] = a4[c] * S[4 * d4 + c] + k4[c] * vv; acc += q4[c] * S[4 * d4 + c]; } }
            op[(dh * 16 + tt) * 256 + e] = acc; }
        __syncthreads();
        if (dh == 0) {
#pragma unroll 1
            for (int tt = 0; tt < 16; ++tt) { const float o = op[tt * 256 + e] + op[(16 + tt) * 256 + e]; const float s2 = wave_sum(o * o); if (lane == 0) wss[wave * 16 + tt] = s2; } }
        __syncthreads();
        if (dh == 0) {
#pragma unroll 1
            for (int tt = 0; tt < 16; ++tt) { const float o = op[tt * 256 + e] + op[(16 + tt) * 256 + e];
                const float tot = (wss[tt] + wss[16 + tt]) + (wss[32 + tt] + wss[48 + tt]); const float rstd = 1.f / sqrtf(tot * (1.f / 256.f) + EPS);
                const float gate = bf2f(pr0[(size_t)tt * NP + 5120 + h * 256 + e]);
                CAT[(size_t)(b * T + t0 + tt) * D + 1024 + h * 256 + e] = (bf16)f2bf(o * rstd * gne * gate); } }
    }
    __syncthreads();
}

typedef short bf16x8v __attribute__((ext_vector_type(8)));
typedef short s16x4v __attribute__((ext_vector_type(4)));
typedef float f32x16 __attribute__((ext_vector_type(16)));
__device__ __forceinline__ int crow16(int r, int hh) { return (r & 3) + 8 * (r >> 2) + 4 * hh; }
__device__ __forceinline__ s16x4v tr_rd(const LAS unsigned char* p) { return __builtin_bit_cast(s16x4v, __builtin_amdgcn_ds_read_tr16_b64_v4i16((LAS s16x4v*)p)); }
__device__ __forceinline__ void half_swap(float& a, float& b) { asm volatile("s_nop 1\n\tv_permlane32_swap_b32_e32 %0, %1\n\ts_nop 1" : "+v"(a), "+v"(b)); }
__device__ __forceinline__ float half_sum(float v) { float a = v, b = v; half_swap(a, b); return a + b; }
__device__ __forceinline__ float half_max(float v) { float a = v, b = v; half_swap(a, b); return __builtin_fmaxf(a, b); }
__device__ __forceinline__ unsigned cvtpk(float lo, float hi) { unsigned r; asm volatile("v_cvt_pk_bf16_f32 %0, %1, %2" : "=v"(r) : "v"(lo), "v"(hi)); return r; }
__device__ __forceinline__ bf16x8v pack8(const f32x16& p, int s) {
    v4u w; w.x = cvtpk(p[8 * s + 0], p[8 * s + 1]); w.y = cvtpk(p[8 * s + 2], p[8 * s + 3]); w.z = cvtpk(p[8 * s + 4], p[8 * s + 5]); w.w = cvtpk(p[8 * s + 6], p[8 * s + 7]);
    return __builtin_bit_cast(bf16x8v, w);
}
constexpr int AT_KP = 272, AT_VP = 320, AT_KBYTES = 64 * AT_KP, AT_STAGE = AT_KBYTES + 64 * AT_VP;
constexpr float AT_THR = 6.f;

__device__ __forceinline__ void attn_unit(const bf16* P, bf16* CAT, int b, int h, int qb, float lam, float subscale, const float* gsub, LAS unsigned char* lds, int tid) {
    const int lane = tid & 63, wave = __builtin_amdgcn_readfirstlane(tid >> 6), mp = wave >> 2, wq = wave & 3, r32 = lane & 31, hh = lane >> 5;
    const int q0 = 128 * qb, NT = 2 * qb + 2, qg = q0 + 32 * wq + r32;
    const float slope2 = exp2f(-(float)(h + 1)) * LOG2E;
    const bf16* qrow = P + (size_t)(b * T + qg) * NP + h * 128 + mp * 64 + 8 * hh;
    bf16x8v qf[4];
#pragma unroll
    for (int ds = 0; ds < 4; ++ds) qf[ds] = *(const bf16x8v*)(qrow + 16 * ds);
    const int srow = tid >> 3, sseg = tid & 7;
    const bf16* gk = P + (size_t)(b * T + srow) * NP + 1024 + h * 128 + sseg * 16;
    LAS unsigned char* kdst = lds + srow * AT_KP + sseg * 32; LAS unsigned char* vdst = lds + AT_KBYTES + srow * AT_VP + sseg * 32;
    v4u st0 = *(const v4u*)gk, st1 = *(const v4u*)(gk + 8), st2 = *(const v4u*)(gk + 1024), st3 = *(const v4u*)(gk + 1032);
    *(LAS v4u*)kdst = st0; *(LAS v4u*)(kdst + 16) = st1; *(LAS v4u*)vdst = st2; *(LAS v4u*)(vdst + 16) = st3;
    f32x16 O[4];
#pragma unroll
    for (int d = 0; d < 4; ++d)
#pragma unroll
        for (int r = 0; r < 16; ++r) O[d][r] = 0.f;
    float cb[16];
#pragma unroll
    for (int r = 0; r < 16; ++r) cb[r] = slope2 * (float)crow16(r, hh);
    float m_ref = -1e30f, l = 0.f;
    const LAS unsigned char* kbase = lds + r32 * AT_KP + mp * 128 + hh * 16;
    const int g4 = lane >> 4, i16 = lane & 15;
    const LAS unsigned char* vbase = lds + AT_KBYTES + (4 * (g4 >> 1) + (i16 >> 2)) * AT_VP + (16 * (g4 & 1) + 4 * (i16 & 3)) * 2;
    __syncthreads();
    bf16x8v pb[4];
    bool act_prev = false; int so_prev = 0, so_cur = 0;
#define AT_PV(SO) do { _Pragma("unroll") for (int hf = 0; hf < 2; ++hf) _Pragma("unroll") for (int s = 0; s < 2; ++s) { \
            const LAS unsigned char* vp = vbase + (SO) + (32 * hf + 16 * s) * AT_VP; \
            _Pragma("unroll") for (int d = 0; d < 4; ++d) { const s16x4v lo = tr_rd(vp + d * 64), hi = tr_rd(vp + 8 * AT_VP + d * 64); \
                const bf16x8v va = (bf16x8v){lo[0], lo[1], lo[2], lo[3], hi[0], hi[1], hi[2], hi[3]}; \
                O[d] = __builtin_amdgcn_mfma_f32_32x32x16_bf16(va, pb[2 * hf + s], O[d], 0, 0, 0); } } } while (0)
    for (int t = 0; t <= NT; ++t) {
        const int so_next = (so_cur == 2 * AT_STAGE) ? 0 : so_cur + AT_STAGE;
        if (t + 1 < NT) { const bf16* gn = gk + (size_t)(t + 1) * 64 * NP; st0 = *(const v4u*)gn; st1 = *(const v4u*)(gn + 8); st2 = *(const v4u*)(gn + 1024); st3 = *(const v4u*)(gn + 1032); }
        if (mp == 1 && act_prev) AT_PV(so_prev);
        const bool act = (t < NT) && (64 * t <= q0 + 32 * wq + 31);
        if (act) {
            const int so = so_cur;
            f32x16 p0, p1;
            const float tb = slope2 * (float)(64 * t - q0);
#pragma unroll
            for (int r = 0; r < 16; ++r) { p0[r] = cb[r] + tb; p1[r] = p0[r] + 32.f * slope2; }
#pragma unroll
            for (int ds = 0; ds < 4; ++ds) {
                const bf16x8v k0 = *(const LAS bf16x8v*)(kbase + so + ds * 32), k1 = *(const LAS bf16x8v*)(kbase + so + 32 * AT_KP + ds * 32);
                p0 = __builtin_amdgcn_mfma_f32_32x32x16_bf16(k0, qf[ds], p0, 0, 0, 0);
                p1 = __builtin_amdgcn_mfma_f32_32x32x16_bf16(k1, qf[ds], p1, 0, 0, 0);
            }
            if (t >= NT - 2) {
#pragma unroll
                for (int r = 0; r < 16; ++r) { const int kvg = 64 * t + crow16(r, hh); if (kvg > qg) p0[r] = -1e30f; if (kvg + 32 > qg) p1[r] = -1e30f; }
            }
            float rm = __builtin_fmaxf(p0[0], p1[0]);
#pragma unroll
            for (int r = 1; r < 16; ++r) rm = __builtin_fmaxf(rm, __builtin_fmaxf(p0[r], p1[r]));
            rm = half_max(rm);
            if (__any(rm > m_ref + AT_THR)) {
                const float mn = __builtin_fmaxf(m_ref, rm), al = __builtin_amdgcn_exp2f(m_ref - mn);
                l *= al; m_ref = mn;
#pragma unroll
                for (int d = 0; d < 4; ++d)
#pragma unroll
                    for (int r = 0; r < 16; ++r) O[d][r] *= al;
            }
            float ls = 0.f;
#pragma unroll
            for (int r = 0; r < 16; ++r) { p0[r] = __builtin_amdgcn_exp2f(p0[r] - m_ref); p1[r] = __builtin_amdgcn_exp2f(p1[r] - m_ref); ls += p0[r] + p1[r]; }
            l += ls;
            pb[0] = pack8(p0, 0); pb[1] = pack8(p0, 1); pb[2] = pack8(p1, 0); pb[3] = pack8(p1, 1);
            if (mp == 0) AT_PV(so);
        }
        act_prev = act; so_prev = so_cur;
        if (t + 1 < NT) { *(LAS v4u*)(kdst + so_next) = st0; *(LAS v4u*)(kdst + so_next + 16) = st1; *(LAS v4u*)(vdst + so_next) = st2; *(LAS v4u*)(vdst + so_next + 16) = st3; }
        so_cur = so_next;
        __syncthreads();
    }
#undef AT_PV
    l = half_sum(l);
    const float inv = 1.f / l;
    LAS float* xch = (LAS float*)lds;
    if (mp == 1) {
#pragma unroll
        for (int d = 0; d < 4; ++d)
#pragma unroll
            for (int r = 0; r < 16; ++r) xch[((wq * 64 + d * 16 + r) * 64) + lane] = O[d][r] * inv; }
    __syncthreads();
    if (mp == 0) {
        float ss = 0.f;
#pragma unroll
        for (int d = 0; d < 4; ++d)
#pragma unroll
            for (int r = 0; r < 16; ++r) { const float o = O[d][r] * inv - lam * xch[((wq * 64 + d * 16 + r) * 64) + lane]; O[d][r] = o; ss += o * o; }
        ss = half_sum(ss);
        const float rstd = subscale / sqrtf(ss * (1.f / 128.f) + EPS);
        bf16* orow = CAT + (size_t)(b * T + qg) * D + h * 128;
#pragma unroll
        for (int d = 0; d < 4; ++d)
#pragma unroll
            for (int i = 0; i < 4; ++i) { const int dv0 = 32 * d + 8 * i + 4 * hh; const f32x4 gg = *(const f32x4*)(gsub + dv0);
                v2u w; w.x = pk2(O[d][4 * i + 0] * rstd * gg.x, O[d][4 * i + 1] * rstd * gg.y); w.y = pk2(O[d][4 * i + 2] * rstd * gg.z, O[d][4 * i + 3] * rstd * gg.w);
                *(GAS v2u*)(orow + dv0) = w; }
    }
    __syncthreads();
}

constexpr int GL_QT = 0, GL_KT = 24576, GL_KH = 49152, GL_V = 67584, GL_A = 104448, GL_SEG = 113664, GL_BL = 115712, GL_SS = 116224, GL_OT = 0;
constexpr int GL_QP = 192, GL_KHP = 144, GL_VP = 576, GL_AP = 144, GL_OP = 144;
static_assert(GL_SS + 2048 <= RING_BYTES && GL_KH + 128 * GL_KHP == GL_V && GL_V + 64 * GL_VP == GL_A && GL_A + 64 * GL_AP == GL_SEG, "GLA LDS map");

__device__ __forceinline__ void gla_unit(const bf16* P, bf16* CAT, int b, int h, const float* gn, LAS unsigned char* lds, int tid) {
    const int lane = tid & 63, wave = __builtin_amdgcn_readfirstlane(tid >> 6), r32 = lane & 31, hh = lane >> 5, g4 = lane >> 4, i16 = lane & 15;
    const int dk = tid & 127, jg = __builtin_amdgcn_readfirstlane(tid >> 7);
    const int vrow = tid >> 3, vseg = tid & 7;
    f32x16 S[4];
#pragma unroll
    for (int d = 0; d < 4; ++d)
#pragma unroll
        for (int r = 0; r < 16; ++r) S[d][r] = 0.f;
    const int trr = i16 >> 2, trc = 16 * (g4 & 1) + 4 * (i16 & 3);
    LAS float* seg = (LAS float*)(lds + GL_SEG); LAS float* ebl = (LAS float*)(lds + GL_BL); LAS float* ssp = (LAS float*)(lds + GL_SS);
    for (int c = 0; c < T / 64; ++c) {
        const bf16* rowbase = P + (size_t)(b * T + 64 * c) * NP;
        float la[16], qv[16], kv[16];
        { const bf16* pr = rowbase + (size_t)(16 * jg) * NP + h * 128 + dk;
#pragma unroll
          for (int jj = 0; jj < 16; ++jj) { la[jj] = bf2f(pr[(size_t)jj * NP + 6144]); qv[jj] = bf2f(pr[(size_t)jj * NP + 3072]); kv[jj] = bf2f(pr[(size_t)jj * NP + 3584]); } }
        { const bf16* pv = rowbase + (size_t)vrow * NP + 4096 + h * 256 + vseg * 32; LAS unsigned char* vd = lds + GL_V + vrow * GL_VP + vseg * 64;
          const v4u a0 = *(const v4u*)pv, a1 = *(const v4u*)(pv + 8), a2 = *(const v4u*)(pv + 16), a3 = *(const v4u*)(pv + 24);
          *(LAS v4u*)vd = a0; *(LAS v4u*)(vd + 16) = a1; *(LAS v4u*)(vd + 32) = a2; *(LAS v4u*)(vd + 48) = a3; }
#pragma unroll
        for (int jj = 1; jj < 16; ++jj) la[jj] += la[jj - 1];
        seg[jg * 128 + dk] = la[15];
        __syncthreads();
        { float pre = 0.f, tot = 0.f;
#pragma unroll
          for (int g = 0; g < 4; ++g) { const float sv = seg[g * 128 + dk]; tot += sv; if (g < jg) pre += sv; }
          const float eb_last = __builtin_amdgcn_exp2f(LOG2E * tot);
          float qt[16], kt[16], kh[16];
#pragma unroll
          for (int jj = 0; jj < 16; ++jj) { const float e = __builtin_amdgcn_exp2f(LOG2E * (pre + la[jj])), ri = __builtin_amdgcn_rcpf(e); qt[jj] = qv[jj] * e; kt[jj] = kv[jj] * ri; kh[jj] = kt[jj] * eb_last; }
          v4u w;
#define GL_PACK8(src, o) w.x = pk2(src[o + 0], src[o + 1]); w.y = pk2(src[o + 2], src[o + 3]); w.z = pk2(src[o + 4], src[o + 5]); w.w = pk2(src[o + 6], src[o + 7])
          GL_PACK8(qt, 0); *(LAS v4u*)(lds + GL_QT + dk * GL_QP + jg * 32) = w; GL_PACK8(qt, 8); *(LAS v4u*)(lds + GL_QT + dk * GL_QP + jg * 32 + 16) = w;
          GL_PACK8(kt, 0); *(LAS v4u*)(lds + GL_KT + dk * GL_QP + jg * 32) = w; GL_PACK8(kt, 8); *(LAS v4u*)(lds + GL_KT + dk * GL_QP + jg * 32 + 16) = w;
          GL_PACK8(kh, 0); *(LAS v4u*)(lds + GL_KH + dk * GL_KHP + jg * 32) = w; GL_PACK8(kh, 8); *(LAS v4u*)(lds + GL_KH + dk * GL_KHP + jg * 32 + 16) = w;
#undef GL_PACK8
          if (jg == 0) ebl[dk] = eb_last; }
        __syncthreads();
        if (wave < 3) {
            const int jb = wave >> 1, ib = (wave + 1) >> 1;
            f32x16 at;
#pragma unroll
            for (int r = 0; r < 16; ++r) at[r] = 0.f;
            const LAS unsigned char* ka = lds + GL_KT + (8 * hh + trr) * GL_QP + (32 * jb + trc) * 2;
            const LAS unsigned char* qa = lds + GL_QT + (8 * hh + trr) * GL_QP + (32 * ib + trc) * 2;
#pragma unroll
            for (int s = 0; s < 8; ++s) {
                const s16x4v k0 = tr_rd(ka + s * 16 * GL_QP), k1 = tr_rd(ka + (s * 16 + 4) * GL_QP), q0 = tr_rd(qa + s * 16 * GL_QP), q1 = tr_rd(qa + (s * 16 + 4) * GL_QP);
                const bf16x8v af = (bf16x8v){k0[0], k0[1], k0[2], k0[3], k1[0], k1[1], k1[2], k1[3]}, bfr = (bf16x8v){q0[0], q0[1], q0[2], q0[3], q1[0], q1[1], q1[2], q1[3]};
                at = __builtin_amdgcn_mfma_f32_32x32x16_bf16(af, bfr, at, 0, 0, 0);
            }
            if (jb == ib) {
#pragma unroll
                for (int r = 0; r < 16; ++r) if (crow16(r, hh) > r32) at[r] = 0.f; }
            LAS unsigned char* ad = lds + GL_A + (32 * ib + r32) * GL_AP + (32 * jb + 4 * hh) * 2;
#pragma unroll
            for (int g = 0; g < 4; ++g) { v2u w; w.x = pk2(at[4 * g + 0], at[4 * g + 1]); w.y = pk2(at[4 * g + 2], at[4 * g + 3]); *(LAS v2u*)(ad + 16 * g) = w; }
        }
        __syncthreads();
        f32x16 o[2];
        {
            bf16x8v vf[4];
            const LAS unsigned char* va = lds + GL_V + (8 * hh + trr) * GL_VP + (32 * wave + trc) * 2;
#pragma unroll
            for (int s = 0; s < 4; ++s) { const s16x4v a0 = tr_rd(va + s * 16 * GL_VP), a1 = tr_rd(va + (s * 16 + 4) * GL_VP); vf[s] = (bf16x8v){a0[0], a0[1], a0[2], a0[3], a1[0], a1[1], a1[2], a1[3]}; }
#pragma unroll
            for (int ib = 0; ib < 2; ++ib) {
#pragma unroll
                for (int r = 0; r < 16; ++r) o[ib][r] = 0.f;
                const LAS unsigned char* aa = lds + GL_A + (32 * ib + r32) * GL_AP + 16 * hh;
#pragma unroll
                for (int s = 0; s < 2 + 2 * ib; ++s) o[ib] = __builtin_amdgcn_mfma_f32_32x32x16_bf16(*(const LAS bf16x8v*)(aa + 32 * s), vf[s], o[ib], 0, 0, 0);
            }
#pragma unroll
            for (int d = 0; d < 4; ++d)
#pragma unroll
                for (int s2 = 0; s2 < 2; ++s2) {
                    const bf16x8v sb = pack8(S[d], s2);
#pragma unroll
                    for (int ib = 0; ib < 2; ++ib) {
                        const LAS unsigned char* qa = lds + GL_QT + (32 * d + 16 * s2 + 4 * hh + trr) * GL_QP + (32 * ib + trc) * 2;
                        const s16x4v q0 = tr_rd(qa), q1 = tr_rd(qa + 8 * GL_QP);
                        o[ib] = __builtin_amdgcn_mfma_f32_32x32x16_bf16((bf16x8v){q0[0], q0[1], q0[2], q0[3], q1[0], q1[1], q1[2], q1[3]}, sb, o[ib], 0, 0, 0);
                    }
                }
#pragma unroll
            for (int d = 0; d < 4; ++d) {
#pragma unroll
                for (int g = 0; g < 4; ++g) { const f32x4 e4 = *(const LAS f32x4*)(ebl + 32 * d + 8 * g + 4 * hh); S[d][4 * g + 0] *= e4.x; S[d][4 * g + 1] *= e4.y; S[d][4 * g + 2] *= e4.z; S[d][4 * g + 3] *= e4.w; }
                const LAS unsigned char* ha = lds + GL_KH + (32 * d + r32) * GL_KHP + 16 * hh;
#pragma unroll
                for (int s = 0; s < 4; ++s) S[d] = __builtin_amdgcn_mfma_f32_32x32x16_bf16(*(const LAS bf16x8v*)(ha + 32 * s), vf[s], S[d], 0, 0, 0);
            }
        }
        __syncthreads();
        { LAS unsigned char* od = lds + GL_OT + (32 * wave + r32) * GL_OP + 8 * hh;
#pragma unroll
          for (int ib = 0; ib < 2; ++ib)
#pragma unroll
              for (int g = 0; g < 4; ++g) { v2u w; w.x = pk2(o[ib][4 * g + 0], o[ib][4 * g + 1]); w.y = pk2(o[ib][4 * g + 2], o[ib][4 * g + 3]); *(LAS v2u*)(od + 64 * ib + 16 * g) = w; } }
        __syncthreads();
        { float ov[32]; float ss = 0.f;
          const LAS unsigned short* op = (const LAS unsigned short*)(lds + GL_OT + (32 * wave) * GL_OP) + lane;
#pragma unroll
          for (int e = 0; e < 32; ++e) { ov[e] = bf2f(op[e * (GL_OP / 2)]); ss += ov[e] * ov[e]; }
          ssp[wave * 64 + lane] = ss;
          __syncthreads();
          float tot = 0.f;
#pragma unroll
          for (int w8 = 0; w8 < 8; ++w8) tot += ssp[w8 * 64 + lane];
          const float rstd = 1.f / sqrtf(tot * (1.f / 256.f) + EPS);
          const bf16* gp = rowbase + (size_t)lane * NP + 5120 + h * 256 + 32 * wave; bf16* cp = CAT + (size_t)(b * T + 64 * c + lane) * D + 1024 + h * 256 + 32 * wave; const float* g32 = gn + 32 * wave;
#pragma unroll
          for (int q4 = 0; q4 < 4; ++q4) { const v4u gw = *(const v4u*)(gp + 8 * q4); v4u w;
              w.x = pk2(ov[8 * q4 + 0] * rstd * g32[8 * q4 + 0] * bflo(gw.x), ov[8 * q4 + 1] * rstd * g32[8 * q4 + 1] * bfhi(gw.x));
              w.y = pk2(ov[8 * q4 + 2] * rstd * g32[8 * q4 + 2] * bflo(gw.y), ov[8 * q4 + 3] * rstd * g32[8 * q4 + 3] * bfhi(gw.y));
              w.z = pk2(ov[8 * q4 + 4] * rstd * g32[8 * q4 + 4] * bflo(gw.z), ov[8 * q4 + 5] * rstd * g32[8 * q4 + 5] * bfhi(gw.z));
              w.w = pk2(ov[8 * q4 + 6] * rstd * g32[8 * q4 + 6] * bflo(gw.w), ov[8 * q4 + 7] * rstd * g32[8 * q4 + 7] * bfhi(gw.w));
              *(GAS v4u*)(cp + 8 * q4) = w; } }
    }
    __syncthreads();
}

#ifdef DBG_CHECK
constexpr int CW_DBG = 32768;
__device__ __forceinline__ float dbg_dot(const bf16* arow, const float* w, int ldw, int K, int lane, bool roundw) {
    float s = 0.f;
    for (int k = lane; k < K; k += 64) { const float wv = w[(size_t)k * ldw]; s += bf2f(arow[k]) * (roundw ? bf2f((unsigned short)f2bf(wv)) : wv); }
    return wave_sum(s);
}
__device__ __forceinline__ void dbg_fail(gu32* ctl, int which, float got, float exp, float rtol, float atol) {
    if (!(__builtin_fabsf(got - exp) <= rtol * __builtin_fabsf(exp) + atol)) __hip_atomic_fetch_add(ctl + CW_DBG + which, 1u, RLX_AGENT);
}
__device__ __forceinline__ float dbg_logsig(float x) { return (x < 0.f ? x : 0.f) - log1pf(expf(-fabsf(x))); }
__global__ void __launch_bounds__(64) dbg_kernel(Args a, int which, int l) {
    const int lane = threadIdx.x; unsigned char* ws = a.ws; gu32* ctl = (gu32*)(ws + WS_CTL);
    const float* MOD = (const float*)(ws + WS_MOD); const bf16* HN = (const bf16*)(ws + WS_HN); const bf16* PROJ = (const bf16*)(ws + WS_PROJ); const bf16* CAT = HN; const bf16* ACT = PROJ;
    float* STASH = (float*)(ws + WS_SCAL) + 64;
    const int rows8[8] = {0, 1, 255, 256, 2047, 2048, 12345, 32767};
    if (which == 0) {
        const float t1 = wave_sum((float)(lane + 1)); dbg_fail(ctl, 0, t1, 2080.f, 0.f, 0.01f);
        { float v = (float)(lane + 1); v += DPPF(v, 0xB1); v += DPPF(v, 0x4E); v += DPPF(v, 0x141); v += DPPF(v, 0x140); const int r = lane >> 4; dbg_fail(ctl, 21, v, (float)(16 * (16 * r) + 136), 0.f, 0.01f); }
        { const float v = __builtin_bit_cast(float, __builtin_amdgcn_ds_swizzle(__builtin_bit_cast(int, (float)lane), 0x401F)); dbg_fail(ctl, 22, v, (float)(lane ^ 16), 0.f, 0.01f); }
        { float a_ = (float)lane, b_ = (float)lane; asm volatile("s_nop 1\n\tv_permlane32_swap_b32_e32 %0, %1\n\ts_nop 1" : "+v"(a_), "+v"(b_));
          dbg_fail(ctl, 23, a_ + b_, (float)((lane & 31) + (lane & 31) + 32), 0.f, 0.01f); dbg_fail(ctl, 25, a_, (float)(lane & 31), 0.f, 0.01f); }
        { const float v = __shfl_xor((float)lane, 16); dbg_fail(ctl, 24, v, (float)(lane ^ 16), 0.f, 0.01f); }
    } else if (which == 10) {
        const int bs[3] = {0, 7, 15}, js[5] = {0, 255, 256, 5000, 12287};
        for (int ll = 0; ll < 2; ++ll) for (int bi = 0; bi < 3; ++bi) for (int ji = 0; ji < 5; ++ji) { const int b = bs[bi], j = js[ji]; float s = 0.f;
            for (int k = lane; k < D; k += 64) { const float cv = a.in[1][b * D + k]; s += cv / (1.f + expf(-cv)) * a.in[2][((size_t)ll * D + k) * NMOD + j]; }
            s = wave_sum(s) + a.in[3][ll * NMOD + j];
            if (lane == 0) dbg_fail(ctl, 10, MOD[(size_t)(ll * 16 + b) * NMOD + j], s, 1e-3f, 1e-3f); }
    } else if (which == 1) {
        const float* xin = (l == 0) ? a.in[0] : a.out; const int cs[4] = {0, 5, 1000, 2047};
        for (int ri = 0; ri < 8; ++ri) { const int r = rows8[ri], b = r / T; float s = 0.f;
            for (int k = lane; k < D; k += 64) { const float v = xin[(size_t)r * D + k]; s += v * v; }
            const float rstd = 1.f / sqrtf(wave_sum(s) / D + EPS);
            for (int ci = 0; ci < 4; ++ci) { const int c = cs[ci]; const float* mb = MOD + (size_t)(l * 16 + b) * NMOD;
                const float e = xin[(size_t)r * D + c] * rstd * a.in[4][l * D + c] * (1.f + mb[D + c]) + mb[c];
                if (lane == 0) dbg_fail(ctl, 1, bf2f(HN[(size_t)r * D + c]), e, 0.01f, 0.01f); } }
    } else if (which == 2) {
        const int cs[10] = {5, 700, 1030, 2100, 3100, 3600, 4200, 5200, 1023, 6143};
        for (int ri = 0; ri < 8; ++ri) for (int ci = 0; ci < 10; ++ci) { const int r = rows8[ri], c = cs[ci];
            float e = dbg_dot(HN + (size_t)r * D, a.in[5] + (size_t)l * D * NIN + c, NIN, D, lane, true);
            if (c < 1024) e *= pg8::QSCALE; else if (c >= 3072 && c < 3584) e *= pg8::GQSCALE; else if (c >= 5120) e = e / (1.f + expf(-e));
            if (lane == 0) dbg_fail(ctl, 2, bf2f(PROJ[(size_t)r * NP + c]), e, 0.02f, 0.02f); }
    } else if (which == 3) {
        const int js[5] = {0, 6, 255, 256, 511};
        for (int ri = 0; ri < 8; ++ri) { const int r = rows8[ri]; float gl[16];
#pragma unroll
            for (int q = 0; q < 16; ++q) gl[q] = dbg_dot(HN + (size_t)r * D, a.in[5] + (size_t)l * D * NIN + 6144 + q, NIN, D, lane, false);
            for (int ji = 0; ji < 5; ++ji) { const int j = js[ji]; float xg = a.in[9][l * 512 + j];
#pragma unroll
                for (int q = 0; q < 16; ++q) xg += gl[q] * a.in[8][(size_t)l * 16 * 512 + q * 512 + j];
                if (lane == 0) dbg_fail(ctl, 3, bf2f(PROJ[(size_t)r * NP + 6144 + j]), dbg_logsig(xg) * 0.0625f, 0.05f, 1e-3f); } }
    } else if (which == 4) {
        const int bs[3] = {0, 5, 15}, ts[3] = {0, 77, 300}, hs[3] = {0, 3, 7};
        const float lam = ((const float*)(ws + WS_SCAL))[l], sub = 1.f - (l == 0 ? 0.2f : 0.35550906759096926f);
        for (int si = 0; si < 3; ++si) { const int b = bs[si], t = ts[si], h = hs[si]; const float slope = exp2f(-(float)(h + 1));
            float od0 = 0.f, od1 = 0.f;
            for (int mp = 0; mp < 2; ++mp) {
                const bf16* qrow = PROJ + (size_t)(b * T + t) * NP + h * 128 + mp * 64;
                const bf16* kb = PROJ + (size_t)(b * T) * NP + 1024 + h * 128 + mp * 64;
#define DBG_SCORE(kv) ({ const bf16* kr_ = kb + (size_t)(kv) * NP; float s_ = 0.f; for (int d = 0; d < 64; ++d) s_ += bf2f(qrow[d]) * bf2f(kr_[d]); s_ / 1.4426950408889634f - slope * (float)(t - (kv)); })
                float mx = -1e30f;
                for (int kv = lane; kv <= t; kv += 64) mx = fmaxf(mx, DBG_SCORE(kv));
                for (int o = 1; o < 64; o <<= 1) mx = fmaxf(mx, __shfl_xor(mx, o));
                float den = 0.f;
                for (int kv = lane; kv <= t; kv += 64) den += expf(DBG_SCORE(kv) - mx);
                den = wave_sum(den);
                for (int ch = 0; ch < 4; ++ch) {
                    float acc[32];
#pragma unroll
                    for (int i = 0; i < 32; ++i) acc[i] = 0.f;
                    for (int kv = lane; kv <= t; kv += 64) { const float p = expf(DBG_SCORE(kv) - mx); const bf16* vr = PROJ + (size_t)(b * T + kv) * NP + 2048 + h * 128 + ch * 32;
#pragma unroll
                        for (int i = 0; i < 32; ++i) acc[i] += p * bf2f(vr[i]); }
#pragma unroll
                    for (int i = 0; i < 32; ++i) { const float v = wave_sum(acc[i]) / den, cv = (mp == 0) ? v : -lam * v; const int idx = ch * 32 + i;
                        if (lane == (idx & 63)) { if (idx < 64) od0 += cv; else od1 += cv; } }
                }
#undef DBG_SCORE
            }
            const float rstd = sub / sqrtf(wave_sum(od0 * od0 + od1 * od1) / 128.f + EPS);
            dbg_fail(ctl, 4, bf2f(CAT[(size_t)(b * T + t) * D + h * 128 + lane]), od0 * rstd * a.in[7][l * 128 + lane], 0.03f, 0.02f);
            dbg_fail(ctl, 4, bf2f(CAT[(size_t)(b * T + t) * D + h * 128 + 64 + lane]), od1 * rstd * a.in[7][l * 128 + 64 + lane], 0.03f, 0.02f);
        }
    } else if (which == 5) {
        const int bs[3] = {0, 9, 15}, ts[3] = {0, 70, 200}, hs[3] = {0, 2, 3};
        for (int si = 0; si < 3; ++si) { const int b = bs[si], t = ts[si], h = hs[si];
            const bf16* qrow = PROJ + (size_t)(b * T + t) * NP + 3072 + h * 128; const float q0 = bf2f(qrow[lane]), q1 = bf2f(qrow[64 + lane]);
            float c0 = 0.f, c1 = 0.f, o[4] = {0.f, 0.f, 0.f, 0.f};
            for (int s = t; s >= 0; --s) { const bf16* pr = PROJ + (size_t)(b * T + s) * NP;
                const float w = wave_sum(q0 * bf2f(pr[3584 + h * 128 + lane]) * expf(c0) + q1 * bf2f(pr[3584 + h * 128 + 64 + lane]) * expf(c1));
#pragma unroll
                for (int i = 0; i < 4; ++i) o[i] += w * bf2f(pr[4096 + h * 256 + 4 * lane + i]);
                c0 += bf2f(pr[6144 + h * 128 + lane]); c1 += bf2f(pr[6144 + h * 128 + 64 + lane]); }
            const float rstd = 1.f / sqrtf(wave_sum(o[0] * o[0] + o[1] * o[1] + o[2] * o[2] + o[3] * o[3]) / 256.f + EPS);
#pragma unroll
            for (int i = 0; i < 4; ++i) { const int e = 4 * lane + i; const float gate = bf2f(PROJ[(size_t)(b * T + t) * NP + 5120 + h * 256 + e]);
                dbg_fail(ctl, 5, bf2f(CAT[(size_t)(b * T + t) * D + 1024 + h * 256 + e]), o[i] * rstd * a.in[10][l * 256 + e] * gate, 0.03f, 0.02f); }
        }
    } else if (which == 6) {
        const float* xin = (l == 0) ? a.in[0] : STASH + 256; const int cs[5] = {0, 1, 17, 300, 2047};
        for (int ri = 0; ri < 8; ++ri) for (int ci = 0; ci < 5; ++ci) { const int r = rows8[ri], c = cs[ci], b = r / T;
            const float d = dbg_dot(CAT + (size_t)r * D, a.in[11] + (size_t)l * D * D + c, D, D, lane, true);
            const float xo = (l == 0) ? xin[(size_t)r * D + c] : xin[ri * 8 + ci];
            if (lane == 0) dbg_fail(ctl, 6, a.out[(size_t)r * D + c], xo + MOD[(size_t)(l * 16 + b) * NMOD + 2 * D + c] * d, 0.01f, 0.01f); }
    } else if (which == 7) {
        const int pms[5] = {0, 1, 7, 8, 9}, lr[17] = {0, 1, 2, 15, 16, 17, 63, 64, 65, 127, 128, 129, 191, 192, 193, 254, 255}, cs[9] = {0, 3, 4, 9, 37, 100, 127, 133, 5631};
        const float* wu = a.in[13] + (size_t)l * D * NUP;
        for (int pi = 0; pi < 5; ++pi) for (int ri = 0; ri < 17; ++ri) for (int ci = 0; ci < 9; ++ci) { const int r = 256 * pms[pi] + lr[ri], c = cs[ci], t = r % T;
            const float u = dbg_dot(HN + (size_t)r * D, wu + c, NUP, D, lane, true), g0 = dbg_dot(HN + (size_t)r * D, wu + FF + c, NUP, D, lane, true);
            const float g1 = t >= 1 ? dbg_dot(HN + (size_t)(r - 1) * D, wu + FF + c, NUP, D, lane, true) : 0.f, g2 = t >= 2 ? dbg_dot(HN + (size_t)(r - 2) * D, wu + FF + c, NUP, D, lane, true) : 0.f;
            const float* wc = a.in[14] + (size_t)l * 3 * FF; const float y = wc[c] * g2 + wc[FF + c] * g1 + wc[2 * FF + c] * g0 + a.in[15][l * FF + c];
            const float e = 0.5f * y * (1.f + erff(y * 0.70710678f)) * u;
            if (lane == 0) dbg_fail(ctl, 7, bf2f(ACT[(size_t)r * FF + c]), e, 0.03f, 0.02f); }
    } else if (which == 8) {
        const int cs[5] = {0, 1, 17, 300, 2047};
        for (int ri = 0; ri < 8; ++ri) for (int ci = 0; ci < 5; ++ci) if (lane == 0) STASH[ri * 8 + ci] = a.out[(size_t)rows8[ri] * D + cs[ci]];
    } else if (which == 9) {
        const int cs[5] = {0, 1, 17, 300, 2047};
        for (int ri = 0; ri < 8; ++ri) for (int ci = 0; ci < 5; ++ci) { const int r = rows8[ri], c = cs[ci], b = r / T;
            const float d = dbg_dot(ACT + (size_t)r * FF, a.in[16] + (size_t)l * FF * D + c, D, FF, lane, true);
            if (lane == 0) { dbg_fail(ctl, 9, a.out[(size_t)r * D + c], STASH[ri * 8 + ci] + MOD[(size_t)(l * 16 + b) * NMOD + 5 * D + c] * d, 0.01f, 0.01f); STASH[256 + ri * 8 + ci] = a.out[(size_t)r * D + c]; } }
    }
}
__global__ void dbg_emit(Args a, int lo_bit) {
    gu32* ctl = (gu32*)(a.ws + WS_CTL); unsigned mask = 0;
    for (int i = 0; i < 6; ++i) if (ctl[CW_DBG + lo_bit + i]) mask |= 1u << i;
    if (threadIdx.x == 0 && blockIdx.x == 0) a.out[0] += 10.f + (float)mask;
}
#endif

#ifndef MK_PER_PHASE
#define MK_PER_PHASE 0
#endif
#ifndef DBG_SIGNS
#define DBG_SIGNS 0,0,0,0,0,0
#endif
__device__ const float DBG_A[6] = {DBG_SIGNS};
#ifndef DUP_MASK
#define DUP_MASK 0
#endif
constexpr int N_PHASES = 18;
constexpr int GLA_UNITS = 64, ATT_UNITS = 2048, MIX_UNITS = GLA_UNITS + ATT_UNITS;

__global__ void __launch_bounds__(NWAVES * 64, 2) fwd_kernel(Args a_unused) {
    extern __shared__ __attribute__((aligned(16))) unsigned char lds_raw[];
    LAS unsigned char* lds = (LAS unsigned char*)lds_raw;
#define TIDS() int tid = threadIdx.x; asm volatile("" : "+v"(tid)); const int lane = tid & 63, wave = __builtin_amdgcn_readfirstlane(tid >> 6); (void)lane; (void)wave
#define G_ ((int)gridDim.x)
#define BX_ ((int)blockIdx.x)
#define VCU_ ((G_ % 8 == 0) ? (BX_ % 8) * (G_ / 8) + BX_ / 8 : BX_)
#define GW_ (VCU_ * NWAVES + wave)
#define NGW_ (G_ * NWAVES)
#define MISC_ ((volatile LAS unsigned*)(lds + LDSCTL_OFF))
    for (int u = threadIdx.x; u < (LDS_BYTES - LDSCTL_OFF) / 4; u += NWAVES * 64) ((LAS unsigned*)(lds + LDSCTL_OFF))[u] = 0u;
    __syncthreads();
#if !MK_PER_PHASE
    { CArgs* A = ARGS(); (void)xcd_barrier_post((unsigned*)((gu32*)(A->ws + WS_CTL) + CW_BAR), MISC_ + 8); }
#define GRID_BAR() do { CArgs* A_ = ARGS(); XcdBarrier b_; b_.bar = (unsigned*)((gu32*)(A_->ws + WS_CTL) + CW_BAR); b_.x = xb_xcc_id(); b_.st = MISC_ + 8; xcd_barrier(b_); } while (0)
#define IN(k) true
#else
#define GRID_BAR() do { } while (0)
    const int lo = ARGS()->ph_lo, hi = ARGS()->ph_hi;
#define IN(k) (lo <= (k) && (k) < hi)
#endif
#ifdef ONLY_OFF
#define INL(o) ((o) == ONLY_OFF && IN(pb + (o)))
#else
#define INL(o) IN(pb + (o))
#endif

    if (IN(0)) { TIDS(); p0_prologue(ARGS(), lds, tid, lane, wave, VCU_, G_); GRID_BAR(); }

    for (int l = 0; l < 2; ++l) {
        const int pb = 1 + 8 * l;
        if (INL(0)) { TIDS(); CArgs* A = ARGS(); unsigned char* ws = A->ws;
            if (l == 0) norm_phase(A->in[0], A->in[4] + l * D, (const float*)(ws + WS_MOD) + (size_t)l * 16 * NMOD, 0, 1, (bf16*)(ws + WS_HN), GW_, NGW_, lane);
            else norm_phase_b((const bf16*)(ws + WS_XB), A->in[4] + l * D, (const float*)(ws + WS_MOD) + (size_t)l * 16 * NMOD, 0, 1, (bf16*)(ws + WS_HN), GW_, NGW_, lane); GRID_BAR(); }
        if (INL(1)) { TIDS(); CArgs* A = ARGS(); unsigned char* ws = A->ws;
            pg8::Gemm g{(const bf16*)(ws + WS_HN), (const bf16*)(ws + WS_WIN) + (size_t)l * NP * D, M, NP, D}; pg8::StaticOrder S; S.init(M, NP, G_, BX_);
            pg8::EpiProj E{(bf16*)(ws + WS_PROJ), A->in[9] + l * 512};
#if DUP_MASK & 64
            { pg8::EpiNull EN; pg8::gemm_phase<pg8::EpiNull, pg8::StaticOrder, true, true>(lds + RING_OFF, g, S, EN); }
#endif
            for (int rep = 0; rep < ((DUP_MASK & 2) ? 2 : 1); ++rep) pg8::gemm_phase<pg8::EpiProj, pg8::StaticOrder, true, true>(lds + RING_OFF, g, S, E);
            GRID_BAR();
        }
        if (INL(2)) { TIDS(); CArgs* A = ARGS(); unsigned char* ws = A->ws;
            const bf16* PROJ = (const bf16*)(ws + WS_PROJ); bf16* CAT = (bf16*)(ws + WS_HN); gu32* ctl = (gu32*)(ws + WS_CTL);
            const float lam = ((const float*)(ws + WS_SCAL))[l], subscale = (1.f - (l == 0 ? 0.2f : 0.35550906759096926f)) * (1.f + DBG_A[3 * l + 0]); const float ogs = 1.f + DBG_A[3 * l + 1];
            volatile LAS unsigned* qslot = MISC_ + 16;
            for (int rep = 0; rep < ((DUP_MASK & 4) ? 2 : 1); ++rep)
            for (;;) {
                if (tid == 0) *qslot = __hip_atomic_fetch_add(ctl + CW_QUEUE + 64 * (l + 2 * rep), 1u, RLX_AGENT);
                __syncthreads();
                const unsigned u = *qslot;
                __syncthreads();
                if (u >= (unsigned)MIX_UNITS) break;
                if (u < (unsigned)GLA_UNITS) {
#ifndef NO_GLA
#ifdef NAIVE_GLA
                    gla_naive_unit(PROJ, CAT, (int)u >> 2, (int)u & 3, ogs, A->in[10] + l * 256, (LAS float*)(lds + RING_OFF), tid);
#else
                    (void)ogs; for (int rg = 0; rg < ((DUP_MASK & 8) ? 2 : 1); ++rg) gla_unit(PROJ, CAT, (int)u >> 2, (int)u & 3, A->in[10] + l * 256, lds + RING_OFF, tid);
#endif
#endif
                } else {
#ifndef NO_ATT
                    const int idx = (int)u - GLA_UNITS, qb = 15 - idx / 128, bh = idx % 128;
#ifdef NAIVE_ATT
                    attn_naive_unit(PROJ, CAT, bh >> 3, bh & 7, qb, lam, subscale, A->in[7] + l * 128, (LAS float*)(lds + RING_OFF), tid);
#else
                    attn_unit(PROJ, CAT, bh >> 3, bh & 7, qb, lam, subscale, A->in[7] + l * 128, lds + RING_OFF, tid);
#endif
#endif
                }
            }
            GRID_BAR();
        }
        if (INL(3)) { TIDS(); CArgs* A = ARGS(); unsigned char* ws = A->ws;
            pg8::Gemm g{(const bf16*)(ws + WS_HN), (const bf16*)(ws + WS_WO) + (size_t)l * D * D, M, D, D}; pg8::StaticOrder S; S.init(M, D, G_, BX_);
            const float* gt = (const float*)(ws + WS_MOD) + (size_t)l * 16 * NMOD + 2 * D;
            if (l == 0) { pg8::EpiResB<true> E{A->in[0], (bf16*)(ws + WS_XB), gt}; pg8::gemm_phase<pg8::EpiResB<true>, pg8::StaticOrder, true, true>(lds + RING_OFF, g, S, E); }
            else { pg8::EpiResB<false> E{(const void*)(ws + WS_XB), (bf16*)(ws + WS_XB), gt}; pg8::gemm_phase<pg8::EpiResB<false>, pg8::StaticOrder, true, true>(lds + RING_OFF, g, S, E); }
            GRID_BAR();
        }
        if (INL(4)) { TIDS(); CArgs* A = ARGS(); unsigned char* ws = A->ws;
            norm_phase_b((const bf16*)(ws + WS_XB), A->in[12] + l * D, (const float*)(ws + WS_MOD) + (size_t)l * 16 * NMOD, 3, 4, (bf16*)(ws + WS_HN), GW_, NGW_, lane); GRID_BAR(); }
        if (INL(5)) { TIDS(); CArgs* A = ARGS(); unsigned char* ws = A->ws;
            pg8::Gemm g{(const bf16*)(ws + WS_HN), (const bf16*)(ws + WS_WUP) + (size_t)l * NUP * D, M, NUP, D}; pg8::StaticOrder S; S.init(M, NUP, G_, BX_);
            pg8::EpiUp E{(bf16*)(ws + WS_PROJ), A->in[14] + (size_t)l * 3 * FF, A->in[15] + l * FF, (float*)(ws + WS_HALO), (float*)(ws + WS_HALO + HALO_ONE), (float*)(ws + WS_HALO + 2 * HALO_ONE), (LAS float*)(lds + BND_OFF)};
            for (int rep = 0; rep < ((DUP_MASK & 16) ? 2 : 1); ++rep) pg8::gemm_phase<pg8::EpiUp, pg8::StaticOrder, true, true>(lds + RING_OFF, g, S, E);
            GRID_BAR();
        }
        if (INL(6)) { TIDS(); CArgs* A = ARGS(); unsigned char* ws = A->ws;
            fixup_phase((const float*)(ws + WS_HALO), (const float*)(ws + WS_HALO + HALO_ONE), (const float*)(ws + WS_HALO + 2 * HALO_ONE), A->in[14] + (size_t)l * 3 * FF, A->in[15] + l * FF, (bf16*)(ws + WS_PROJ), BX_ * (NWAVES * 64) + tid, G_ * NWAVES * 64); GRID_BAR(); }
        if (INL(7)) { TIDS(); CArgs* A = ARGS(); unsigned char* ws = A->ws;
            pg8::Gemm g{(const bf16*)(ws + WS_PROJ), (const bf16*)(ws + WS_WDN) + (size_t)l * D * FF, M, D, FF}; pg8::StaticOrder S; S.init(M, D, G_, BX_);
            pg8::EpiResB<false> E{(const void*)(ws + WS_XB), (bf16*)(ws + WS_XB), (const float*)(ws + WS_MOD) + (size_t)l * 16 * NMOD + 5 * D};
            pg8::gemm_phase<pg8::EpiResB<false>, pg8::StaticOrder, true, true>(lds + RING_OFF, g, S, E);
            GRID_BAR();
        }
    }
    if (IN(17)) { TIDS(); CArgs* A = ARGS(); final_norm_phase_b((const bf16*)(A->ws + WS_XB), A->out, A->in[17], GW_, NGW_, lane); }
#undef IN
#undef INL
#undef GRID_BAR
}

extern "C" void kernel_launch(void* const* d_in, const int* in_sizes, int n_in, void* d_out, int out_size, void* d_ws, size_t ws_size, hipStream_t stream) {
    static int grid = 0;
    if (grid == 0) {
        if (n_in != 18 || in_sizes[0] != M * D || out_size != M * D || ws_size < WS_END) { fprintf(stderr, "kernel_launch: unexpected shapes / workspace (%d inputs, ws %zu); nothing launched\n", n_in, ws_size); grid = -1; return; }
        int dev = 0, cus = 0, per_cu = 0;
        if (hipGetDevice(&dev) != hipSuccess || hipDeviceGetAttribute(&cus, hipDeviceAttributeMultiprocessorCount, dev) != hipSuccess) { grid = -1; return; }
        if (hipFuncSetAttribute((const void*)fwd_kernel, hipFuncAttributeMaxDynamicSharedMemorySize, LDS_BYTES) != hipSuccess) { fprintf(stderr, "kernel_launch: hipFuncSetAttribute failed\n"); grid = -1; return; }
        if (hipOccupancyMaxActiveBlocksPerMultiprocessor(&per_cu, (const void*)fwd_kernel, NWAVES * 64, LDS_BYTES) != hipSuccess || per_cu < 1) { fprintf(stderr, "kernel_launch: occupancy query reports %d\n", per_cu); }
        (void)hipGetLastError();
        grid = cus;
    }
    if (grid < 0) return;
    if (hipMemsetAsync((char*)d_ws + WS_CTL, 0, CTL_ZERO_BYTES, stream) != hipSuccess) return;
    Args a{};
    for (int i = 0; i < 18; ++i) a.in[i] = (const float*)d_in[i];
    a.out = (float*)d_out; a.ws = (unsigned char*)d_ws;
#if MK_PER_PHASE
    for (int p = 0; p < N_PHASES; ++p) { a.ph_lo = p; a.ph_hi = p + 1; hipLaunchKernelGGL(fwd_kernel, dim3(grid), dim3(NWAVES * 64), LDS_BYTES, stream, a);
#ifdef DBG_CHECK
#define DBGK(w) hipLaunchKernelGGL(dbg_kernel, dim3(1), dim3(64), 0, stream, a, (w), DBG_LAYER)
        const int pb = 1 + 8 * DBG_LAYER;
        if (p == 0) { DBGK(0); DBGK(10); }
        if (p == pb + 0) DBGK(1);
        if (p == pb + 1) { DBGK(2); DBGK(3); }
        if (p == pb + 2) { DBGK(4); DBGK(5); }
        if (p == pb + 3) { DBGK(6); DBGK(8); }
        if (p == pb + 6) DBGK(7);
        if (p == pb + 7) DBGK(9);
        if (p == N_PHASES - 1) hipLaunchKernelGGL(dbg_emit, dim3(1), dim3(64), 0, stream, a, DBG_LO);
#endif
    }
#else
    a.ph_lo = 0; a.ph_hi = N_PHASES;
    hipLaunchKernelGGL(fwd_kernel, dim3(grid), dim3(NWAVES * 64), LDS_BYTES, stream, a);
#endif
}
```

```cpp
#include <hip/hip_runtime.h>
#include <cstdio>
#include <cstdint>
namespace pg8 {
#define PG8_LAS __attribute__((address_space(3)))
typedef unsigned short bf16_t;
typedef short bf16x8 __attribute__((ext_vector_type(8)));
typedef float f32x4 __attribute__((ext_vector_type(4)));
typedef unsigned u32x4 __attribute__((ext_vector_type(4)));
constexpr int BM = 256, BK = 64, HALF = 128, HTB = HALF * BK * 2  , STAGE_BYTES = 8 * HTB, NXCD = 8, WGM = 8;

__host__ __device__ __forceinline__ int lds_byte(int r, int c) { const int st = (r >> 4) * 2 + (c >> 5), rr = r & 15, cc = c & 31, ob = rr * 64 + cc * 2; return st * 1024 + (ob ^ (((ob >> 9) & 1) << 5)); }
__host__ __device__ __forceinline__ void stage_rc(int b, int& R, int& C) { const int st = b / 1024, sb = b % 1024, swz = sb ^ (((sb >> 9) & 1) << 5); R = (st >> 1) * 16 + swz / 64; C = (st & 1) * 32 + (swz % 64) / 2; }
__host__ __device__ __forceinline__ int perm32(int rho) { const int n = rho >> 4, i = rho & 15; return 8 * (i >> 2) + 4 * n + (i & 3); }

struct Unit { int pm, pn; };
struct Gemm { const bf16_t* A; const bf16_t* Bt; int M, N, K; };

template <int WGM_T> struct StaticOrderT {
    static constexpr int WGM = WGM_T;
    int nM, nN, nwg, G, c;
    __host__ __device__ void init(int M, int N, int G_, int c_) { nM = M / BM; nN = N / BM; nwg = nM * nN; G = G_; c = c_; }
    __host__ __device__ bool next(int i, Unit& u) const {
        const long L = (long)i * G + c; if (L >= nwg) return false;
        int wgid = (int)L; { const int q = nwg / NXCD, r = nwg % NXCD, xcd = wgid % NXCD, off = wgid / NXCD; wgid = (xcd < r ? xcd * (q + 1) : r * (q + 1) + (xcd - r) * q) + off; }
        const int nig = WGM * nN, gid = wgid / nig, fm = gid * WGM, gsz = (nM - fm) < WGM ? (nM - fm) : WGM;
        u.pm = fm + ((wgid % nig) % gsz); u.pn = (wgid % nig) / gsz; return true;
    }
    __device__ __forceinline__ void a_ready(const Unit&) const {}
    __device__ __forceinline__ void done(const Unit&) const {}
};
typedef StaticOrderT<WGM> StaticOrder;

__device__ __forceinline__ unsigned cvt_pk_bf16(float lo, float hi) { unsigned r; asm volatile("v_cvt_pk_bf16_f32 %0, %1, %2" : "=v"(r) : "v"(lo), "v"(hi)); return r; }
typedef float f32x2 __attribute__((ext_vector_type(2)));
__device__ __forceinline__ f32x2 gelu_pk(f32x2 v) {
    const f32x2 av = __builtin_elementwise_abs(v), d = av * 0.2316418882f + 1.0f;
    f32x2 t; t.x = __builtin_amdgcn_rcpf(d.x); t.y = __builtin_amdgcn_rcpf(d.y);
    f32x2 q = t * 0.5307027145f + (-0.7265760135f); q = q * t + 0.7107068705f; q = q * t + (-0.142248368f); q = q * t + 0.127414796f; q = q * t;
    const f32x2 s = (v * v) * (-0.72134752044f);
    f32x2 e; e.x = __builtin_amdgcn_exp2f(s.x); e.y = __builtin_amdgcn_exp2f(s.y);
    const f32x2 m = v * (q * e), r = v - m;
    f32x2 o; o.x = v.x < 0.f ? m.x : r.x; o.y = v.y < 0.f ? m.y : r.y; return o;
}

#ifndef GELU_SCALAR
#define GELU_PK 1
#endif
__device__ __forceinline__ f32x2 gelu_pk2(f32x2 v) {
    const f32x2 av = __builtin_elementwise_abs(v), d = av * 0.2316418882f + 1.0f;
    f32x2 t; t.x = __builtin_amdgcn_rcpf(d.x); t.y = __builtin_amdgcn_rcpf(d.y);
    f32x2 q = t * 0.5307027145f + (-0.7265760135f); q = q * t + 0.7107068705f; q = q * t + (-0.142248368f); q = q * t + 0.127414796f; q = q * t;
    const f32x2 s = (v * v) * (-0.72134752044f);
    f32x2 e; e.x = __builtin_amdgcn_exp2f(s.x); e.y = __builtin_amdgcn_exp2f(s.y);
    return av * (0.5f - q * e) + v * 0.5f;
}

__device__ __forceinline__ f32x2 gelu_pk3(f32x2 v) {
    f32x2 vc; vc.x = __builtin_amdgcn_fmed3f(v.x, -4.949747468f, 4.949747468f); vc.y = __builtin_amdgcn_fmed3f(v.y, -4.949747468f, 4.949747468f);
    const f32x2 t = (vc * 0.08163265306f) * vc + (-1.0f);
    f32x2 p = t * 1.261159778e-03f + (-2.926710295e-03f);
    p = p * t + 2.575485269e-03f; p = p * t + (-4.842873197e-03f); p = p * t + 1.265742164e-02f; p = p * t + (-2.147688158e-02f); p = p * t + 3.155010566e-02f;
    p = p * t + (-4.570596293e-02f); p = p * t + 6.256821752e-02f; p = p * t + (-8.105810732e-02f); p = p * t + 1.037636697e-01f; p = p * t + (-1.419164389e-01f); p = p * t + 2.855813801e-01f;
    const f32x2 hv = v * 0.5f;
    return hv * (vc * p) + hv;
}

__device__ __forceinline__ void gelu_pk3x2(f32x2 v, f32x2 w, f32x2& gv, f32x2& gw) {
    f32x2 vc, wc; vc.x = __builtin_amdgcn_fmed3f(v.x, -4.949747468f, 4.949747468f); vc.y = __builtin_amdgcn_fmed3f(v.y, -4.949747468f, 4.949747468f);
    wc.x = __builtin_amdgcn_fmed3f(w.x, -4.949747468f, 4.949747468f); wc.y = __builtin_amdgcn_fmed3f(w.y, -4.949747468f, 4.949747468f);
    const f32x2 t = (vc * 0.08163265306f) * vc + (-1.0f), s = (wc * 0.08163265306f) * wc + (-1.0f);
    f32x2 p = t * 1.261159778e-03f + (-2.926710295e-03f), q = s * 1.261159778e-03f + (-2.926710295e-03f);
#define GELU_H(c) p = p * t + (c); q = q * s + (c)
    GELU_H(2.575485269e-03f); GELU_H(-4.842873197e-03f); GELU_H(1.265742164e-02f); GELU_H(-2.147688158e-02f); GELU_H(3.155010566e-02f); GELU_H(-4.570596293e-02f);
    GELU_H(6.256821752e-02f); GELU_H(-8.105810732e-02f); GELU_H(1.037636697e-01f); GELU_H(-1.419164389e-01f); GELU_H(2.855813801e-01f);
#undef GELU_H
    const f32x2 hv = v * 0.5f, hw = w * 0.5f;
    gv = hv * (vc * p) + hv; gw = hw * (wc * q) + hw;
}

__device__ __forceinline__ void gelu_s4(const float (&v)[4], float (&out)[4], float one, float b5) {
    float av[4], d[4], t[4], q[4], s[4], e[4], r[4];
#define G4(stmt) _Pragma("unroll") for (int i = 0; i < 4; ++i) { stmt; }
    G4(asm("v_and_b32_e32 %0, 0x7fffffff, %1" : "=v"(av[i]) : "v"(v[i])))
    G4(asm("v_fmamk_f32 %0, %1, 0x3e6d3388, %2" : "=v"(d[i]) : "v"(av[i]), "v"(one)))
    G4(asm("v_mul_f32_e32 %0, %1, %1" : "=v"(s[i]) : "v"(v[i])))
    G4(t[i] = __builtin_amdgcn_rcpf(d[i]))
    G4(asm("v_mul_f32_e32 %0, 0xbf38aa3b, %1" : "=v"(s[i]) : "v"(s[i])))
    G4(asm("s_nop 0\n\tv_fmaak_f32 %0, %1, %2, 0xbf3a00e3" : "=v"(q[i]) : "v"(t[i]), "v"(b5)))
    G4(e[i] = __builtin_amdgcn_exp2f(s[i]))
    G4(asm("v_fmaak_f32 %0, %1, %2, 0x3f35f0e3" : "=v"(q[i]) : "v"(q[i]), "v"(t[i])))
    G4(asm("v_fmaak_f32 %0, %1, %2, 0xbe11a98e" : "=v"(q[i]) : "v"(q[i]), "v"(t[i])))
    G4(asm("v_fmaak_f32 %0, %1, %2, 0x3e027906" : "=v"(q[i]) : "v"(q[i]), "v"(t[i])))
    G4(asm("v_mul_f32_e32 %0, %1, %2" : "=v"(q[i]) : "v"(q[i]), "v"(t[i])))
    G4(asm("s_nop 0\n\tv_mul_f32_e32 %0, %1, %2" : "=v"(r[i]) : "v"(q[i]), "v"(e[i])))
    G4(asm("v_sub_f32_e32 %0, 0.5, %1" : "=v"(r[i]) : "v"(r[i])))
    G4(asm("v_mul_f32_e32 %0, %1, %2" : "=v"(r[i]) : "v"(av[i]), "v"(r[i])))
    G4(asm("v_fma_f32 %0, %1, 0.5, %2" : "=v"(out[i]) : "v"(v[i]), "v"(r[i])))
#undef G4
}
__device__ __forceinline__ float fma_s(float a, float b, float c) { float r; asm("v_fma_f32 %0, %1, %2, %3" : "=v"(r) : "v"(a), "v"(b), "v"(c)); return r; }
__device__ __forceinline__ float mul_s(float a, float b) { float r; asm("v_mul_f32_e32 %0, %1, %2" : "=v"(r) : "v"(a), "v"(b)); return r; }

constexpr float QSCALE = 0.125f * 1.4426950408889634f;
constexpr float GQSCALE = 0.08838834764831845f;
constexpr int NPW = 6656;

struct EpiProj {
    static constexpr bool PERM = true, AFTER_DRAIN = false;
    bf16_t* O; const float* bgk; float* nrm;
    __device__ __forceinline__ void operator()(const f32x4 (&acc)[2][2][4][2], const Unit& u, int wr, int wc, int fr, int fq) const {
        const int row0 = u.pm * BM + wr * 64 + fr, col0 = u.pn * BM + wc * 32 + 8 * fq, pn = u.pn;
        int mode = 0; float sc = 1.f;
        if (pn < 4) sc = QSCALE; else if (pn >= 12 && pn < 14) sc = GQSCALE; else if (pn >= 20 && pn < 24) mode = 1; else if (pn >= 24) mode = 2;
        f32x4 bv[2][2];
#pragma unroll
        for (int bj = 0; bj < 2; ++bj)
#pragma unroll
            for (int n = 0; n < 2; ++n) bv[bj][n] = (mode == 2) ? *(const f32x4*)(bgk + (col0 - 6144) + bj * HALF + 4 * n) : (f32x4){0.f, 0.f, 0.f, 0.f};
        if (pn < 8) {
#pragma unroll
            for (int ai = 0; ai < 2; ++ai)
#pragma unroll
                for (int bj = 0; bj < 2; ++bj) { float p = 0.f;
#pragma unroll
                    for (int m = 0; m < 4; ++m) { const f32x4 a0 = acc[ai][bj][m][0] * sc, a1 = acc[ai][bj][m][1] * sc;
                        p = __builtin_fmaxf(p, (a0[0] * a0[0] + a0[1] * a0[1]) + (a0[2] * a0[2] + a0[3] * a0[3]) + (a1[0] * a1[0] + a1[1] * a1[1]) + (a1[2] * a1[2] + a1[3] * a1[3])); }
#define PG8_DPPMAX(v, ctrl) v = __builtin_fmaxf(v, __builtin_bit_cast(float, __builtin_amdgcn_update_dpp(0, __builtin_bit_cast(int, v), (ctrl), 0xF, 0xF, true)))
                    PG8_DPPMAX(p, 0xB1); PG8_DPPMAX(p, 0x4E); PG8_DPPMAX(p, 0x141); PG8_DPPMAX(p, 0x140);
#undef PG8_DPPMAX
                    if (fr == 0) nrm[(size_t)(4 * u.pm + 2 * ai + wr) * 256 + 32 * pn + 16 * bj + 4 * wc + fq] = p * 1.02f; }
        }
#pragma unroll
        for (int ai = 0; ai < 2; ++ai)
#pragma unroll
            for (int m = 0; m < 4; ++m) { bf16_t* rowp = O + (size_t)(row0 + ai * HALF + m * 16) * NPW + col0;
#pragma unroll
                for (int bj = 0; bj < 2; ++bj) { f32x4 v0 = acc[ai][bj][m][0] + bv[bj][0], v1 = acc[ai][bj][m][1] + bv[bj][1];
                    if (mode == 0) { v0 = v0 * sc; v1 = v1 * sc; }
                    else if (mode == 1) {
#pragma unroll
                        for (int e = 0; e < 4; ++e) { v0[e] = v0[e] * __builtin_amdgcn_rcpf(1.f + __builtin_amdgcn_exp2f(-1.4426950408889634f * v0[e])); v1[e] = v1[e] * __builtin_amdgcn_rcpf(1.f + __builtin_amdgcn_exp2f(-1.4426950408889634f * v1[e])); }
                    } else {
#pragma unroll
                        for (int e = 0; e < 4; ++e) {
                            { const float x = v0[e], ax = __builtin_fabsf(x); v0[e] = (__builtin_fminf(x, 0.f) - 0.6931471805599453f * __builtin_amdgcn_logf(1.f + __builtin_amdgcn_exp2f(-1.4426950408889634f * ax))) * 0.0625f; }
                            { const float x = v1[e], ax = __builtin_fabsf(x); v1[e] = (__builtin_fminf(x, 0.f) - 0.6931471805599453f * __builtin_amdgcn_logf(1.f + __builtin_amdgcn_exp2f(-1.4426950408889634f * ax))) * 0.0625f; } }
                    }
                    u32x4 w; w.x = cvt_pk_bf16(v0[0], v0[1]); w.y = cvt_pk_bf16(v0[2], v0[3]); w.z = cvt_pk_bf16(v1[0], v1[1]); w.w = cvt_pk_bf16(v1[2], v1[3]);
                    *(u32x4*)(rowp + bj * HALF) = w; } }
    }
};

struct EpiRes {
    static constexpr bool PERM = false, AFTER_DRAIN = false;
    const float* xin; float* out; const float* gate; float gs;
    __device__ __forceinline__ void operator()(const f32x4 (&acc)[2][2][4][2], const Unit& u, int wr, int wc, int fr, int fq) const {
        const int col0 = u.pn * BM + wc * 32 + 4 * fq; const float* g = gate + (size_t)(u.pm >> 3) * 12288;
        f32x4 gv[2][2];
#pragma unroll
        for (int bj = 0; bj < 2; ++bj)
#pragma unroll
            for (int n = 0; n < 2; ++n) gv[bj][n] = *(const f32x4*)(g + col0 + bj * HALF + n * 16) * gs;
#pragma unroll
        for (int ai = 0; ai < 2; ++ai)
#pragma unroll
            for (int m = 0; m < 4; ++m) { const size_t off = (size_t)(u.pm * BM + ai * HALF + wr * 64 + m * 16 + fr) * 2048 + col0;
#pragma unroll
                for (int bj = 0; bj < 2; ++bj)
#pragma unroll
                    for (int n = 0; n < 2; ++n) { const f32x4 xi = *(const f32x4*)(xin + off + bj * HALF + n * 16); *(f32x4*)(out + off + bj * HALF + n * 16) = xi + gv[bj][n] * acc[ai][bj][m][n]; }
                if (m & 1) asm volatile("" ::: "memory"); }
    }
};

template <bool XF32> struct EpiResB {
    static constexpr bool PERM = true, AFTER_DRAIN = false;
    const void* xin; bf16_t* out; const float* gate;
    __device__ __forceinline__ void operator()(const f32x4 (&acc)[2][2][4][2], const Unit& u, int wr, int wc, int fr, int fq) const {
        const int col0 = u.pn * BM + wc * 32 + 8 * fq; const float* g = gate + (size_t)(u.pm >> 3) * 12288;
        f32x4 gv[2][2];
#pragma unroll
        for (int bj = 0; bj < 2; ++bj)
#pragma unroll
            for (int n = 0; n < 2; ++n) gv[bj][n] = *(const f32x4*)(g + col0 + bj * HALF + 4 * n);
#pragma unroll
        for (int ai = 0; ai < 2; ++ai) {
            u32x4 xb[4][2]; f32x4 xf[XF32 ? 4 : 1][2][2];
#pragma unroll
            for (int m = 0; m < 4; ++m) { const size_t off = (size_t)(u.pm * BM + ai * HALF + wr * 64 + m * 16 + fr) * 2048 + col0;
#pragma unroll
                for (int bj = 0; bj < 2; ++bj) {
                    if (XF32) { xf[XF32 ? m : 0][bj][0] = *(const f32x4*)((const float*)xin + off + bj * HALF); xf[XF32 ? m : 0][bj][1] = *(const f32x4*)((const float*)xin + off + bj * HALF + 4); }
                    else xb[m][bj] = *(const u32x4*)((const bf16_t*)xin + off + bj * HALF); } }
            asm volatile("" ::: "memory");
#pragma unroll
            for (int m = 0; m < 4; ++m) { const size_t off = (size_t)(u.pm * BM + ai * HALF + wr * 64 + m * 16 + fr) * 2048 + col0;
#pragma unroll
                for (int bj = 0; bj < 2; ++bj) { f32x4 x0, x1;
                    if (XF32) { x0 = xf[XF32 ? m : 0][bj][0]; x1 = xf[XF32 ? m : 0][bj][1]; }
                    else { const u32x4 w = xb[m][bj];
                        x0 = (f32x4){__builtin_bit_cast(float, w.x << 16), __builtin_bit_cast(float, w.x & 0xffff0000u), __builtin_bit_cast(float, w.y << 16), __builtin_bit_cast(float, w.y & 0xffff0000u)};
                        x1 = (f32x4){__builtin_bit_cast(float, w.z << 16), __builtin_bit_cast(float, w.z & 0xffff0000u), __builtin_bit_cast(float, w.w << 16), __builtin_bit_cast(float, w.w & 0xffff0000u)}; }
                    const f32x4 y0 = x0 + gv[bj][0] * acc[ai][bj][m][0], y1 = x1 + gv[bj][1] * acc[ai][bj][m][1];
                    u32x4 o; o.x = cvt_pk_bf16(y0[0], y0[1]); o.y = cvt_pk_bf16(y0[2], y0[3]); o.z = cvt_pk_bf16(y1[0], y1[1]); o.w = cvt_pk_bf16(y1[2], y1[3]);
                    *(u32x4*)(out + off + bj * HALF) = o; } }
            asm volatile("" ::: "memory");
        }
    }
};


__device__ __forceinline__ float dpp_shr1(float oldv, float src) { return __builtin_bit_cast(float, __builtin_amdgcn_update_dpp(__builtin_bit_cast(int, oldv), __builtin_bit_cast(int, src), 0x111, 0xF, 0xF, false)); }
__device__ __forceinline__ float dpp_shr2(float oldv, float src) { return __builtin_bit_cast(float, __builtin_amdgcn_update_dpp(__builtin_bit_cast(int, oldv), __builtin_bit_cast(int, src), 0x112, 0xF, 0xF, false)); }
__device__ __forceinline__ float dpp_ror1(float src) { return __builtin_bit_cast(float, __builtin_amdgcn_update_dpp(0, __builtin_bit_cast(int, src), 0x121, 0xF, 0xF, true)); }
__device__ __forceinline__ float dpp_ror2(float src) { return __builtin_bit_cast(float, __builtin_amdgcn_update_dpp(0, __builtin_bit_cast(int, src), 0x122, 0xF, 0xF, true)); }
struct EpiUp {
    static constexpr bool PERM = true, AFTER_DRAIN = false;
    bf16_t* act; const float* wconv; const float* bconv; float* glast; float* gfirst; float* ufirst; PG8_LAS float* bnd;
    __device__ __forceinline__ void operator()(const f32x4 (&acc)[2][2][4][2], const Unit& u, int wr, int wc, int fr, int fq) const {
        const int cl = wc * 32 + 8 * fq, c0 = u.pn * 128 + cl;
        f32x4 w0[2], w1[2], w2[2], cb[2];
#pragma unroll
        for (int n = 0; n < 2; ++n) { w0[n] = *(const f32x4*)(wconv + c0 + 4 * n); w1[n] = *(const f32x4*)(wconv + 5632 + c0 + 4 * n); w2[n] = *(const f32x4*)(wconv + 2 * 5632 + c0 + 4 * n); cb[n] = *(const f32x4*)(bconv + c0 + 4 * n); }
        if (fr >= 14) {
#pragma unroll
            for (int ai = 0; ai < 2; ++ai)
#pragma unroll
                for (int n = 0; n < 2; ++n) *(PG8_LAS f32x4*)(bnd + ((2 * ai + wr) * 2 + (fr - 14)) * 128 + cl + 4 * n) = acc[ai][1][3][n];
            if (wr == 1) {
#pragma unroll
                for (int n = 0; n < 2; ++n) *(f32x4*)(glast + ((size_t)u.pm * 2 + (fr - 14)) * 5632 + c0 + 4 * n) = acc[1][1][3][n]; }
        }
        if (wr == 0 && fr < 2) {
#pragma unroll
            for (int n = 0; n < 2; ++n) { *(f32x4*)(gfirst + ((size_t)u.pm * 2 + fr) * 5632 + c0 + 4 * n) = acc[0][1][0][n]; *(f32x4*)(ufirst + ((size_t)u.pm * 2 + fr) * 5632 + c0 + 4 * n) = acc[0][0][0][n]; }
        }
        asm volatile("s_waitcnt lgkmcnt(0)" ::: "memory"); __builtin_amdgcn_s_barrier(); asm volatile("" ::: "memory");
        const bool is15 = (fr == 15), ge14 = (fr >= 14), is14 = (fr == 14);
        float one_ = 1.0f, b5_ = 0.5307027145f; asm volatile("" : "+v"(one_), "+v"(b5_));
#pragma unroll
        for (int ai = 0; ai < 2; ++ai) {
            const int bp = 2 * ai + wr - 1;
            f32x4 h1[2], h2[2];
#pragma unroll
            for (int n = 0; n < 2; ++n) { if (bp >= 0) { h1[n] = *(const PG8_LAS f32x4*)(bnd + (bp * 2 + 1) * 128 + cl + 4 * n); h2[n] = *(const PG8_LAS f32x4*)(bnd + (bp * 2 + 0) * 128 + cl + 4 * n); } else { h1[n] = (f32x4){0.f, 0.f, 0.f, 0.f}; h2[n] = (f32x4){0.f, 0.f, 0.f, 0.f}; } }
#pragma unroll
            for (int m = 0; m < 4; ++m) {
                unsigned pk[4];
#pragma unroll
                for (int n = 0; n < 2; ++n) {
                    float a[4];
#if defined(GELU_POLY) || defined(GELU_PK)
#pragma unroll
                    for (int e = 0; e < 4; ++e) {
                        const float cur = acc[ai][1][m][n][e];
                        const float p1 = (m == 0) ? h1[n][e] : acc[ai][1][m - 1][n][e];
                        const float p2 = (m == 0) ? (is14 ? h2[n][e] : h1[n][e]) : acc[ai][1][m - 1][n][e];
                        const float g1 = dpp_ror1(is15 ? p1 : cur), g2 = dpp_ror2(ge14 ? p2 : cur);
                        a[e] = w0[n][e] * g2 + w1[n][e] * g1 + w2[n][e] * cur + cb[n][e];
                    }
#else
                    { float g1[4], g2[4];
#pragma unroll
                      for (int e = 0; e < 4; ++e) {
                        const float cur = acc[ai][1][m][n][e];
                        const float p1 = (m == 0) ? h1[n][e] : acc[ai][1][m - 1][n][e];
                        const float p2 = (m == 0) ? (is14 ? h2[n][e] : h1[n][e]) : acc[ai][1][m - 1][n][e];
                        g1[e] = dpp_ror1(is15 ? p1 : cur); g2[e] = dpp_ror2(ge14 ? p2 : cur); }
#pragma unroll
                      for (int e = 0; e < 4; ++e) a[e] = fma_s(w0[n][e], g2[e], cb[n][e]);
#pragma unroll
                      for (int e = 0; e < 4; ++e) a[e] = fma_s(w1[n][e], g1[e], a[e]);
#pragma unroll
                      for (int e = 0; e < 4; ++e) a[e] = fma_s(w2[n][e], acc[ai][1][m][n][e], a[e]); }
#endif
#if defined(GELU_POLY)
                    f32x2 ga, gb; gelu_pk3x2((f32x2){a[0], a[1]}, (f32x2){a[2], a[3]}, ga, gb);
                    pk[2 * n] = cvt_pk_bf16(ga.x * acc[ai][0][m][n][0], ga.y * acc[ai][0][m][n][1]); pk[2 * n + 1] = cvt_pk_bf16(gb.x * acc[ai][0][m][n][2], gb.y * acc[ai][0][m][n][3]);
#elif defined(GELU_PK)
                    const f32x2 ga = gelu_pk2((f32x2){a[0], a[1]}), gb = gelu_pk2((f32x2){a[2], a[3]});
                    pk[2 * n] = cvt_pk_bf16(ga.x * acc[ai][0][m][n][0], ga.y * acc[ai][0][m][n][1]); pk[2 * n + 1] = cvt_pk_bf16(gb.x * acc[ai][0][m][n][2], gb.y * acc[ai][0][m][n][3]);
#else
                    float gg[4]; gelu_s4(a, gg, one_, b5_);
#pragma unroll
                    for (int e = 0; e < 4; ++e) gg[e] = mul_s(gg[e], acc[ai][0][m][n][e]);
                    pk[2 * n] = cvt_pk_bf16(gg[0], gg[1]); pk[2 * n + 1] = cvt_pk_bf16(gg[2], gg[3]);
#endif
                }
                u32x4 w; w.x = pk[0]; w.y = pk[1]; w.z = pk[2]; w.w = pk[3];
                *(u32x4*)(act + (size_t)(u.pm * BM + ai * HALF + wr * 64 + m * 16 + fr) * 5632 + c0) = w;
                asm volatile("" ::: "memory");
            }
        }
    }
};

struct EpiNull {
    static constexpr bool PERM = true, AFTER_DRAIN = false;
    __device__ __forceinline__ void operator()(const f32x4 (&acc)[2][2][4][2], const Unit&, int, int, int, int) const {
#pragma unroll
        for (int ai = 0; ai < 2; ++ai)
#pragma unroll
            for (int bj = 0; bj < 2; ++bj)
#pragma unroll
                for (int m = 0; m < 4; ++m)
#pragma unroll
                    for (int n = 0; n < 2; ++n) asm volatile("" :: "v"(acc[ai][bj][m][n]));
    }
};
template <class Epi, class Sched, bool ALIGN_EPI = false, bool SP2 = false>
__device__ __forceinline__ void gemm_phase(PG8_LAS unsigned char* lds, const Gemm g, const Sched& S, const Epi& E) {
    int tid_o = threadIdx.x; asm volatile("" : "+v"(tid_o));
    const int tid = tid_o, wid = __builtin_amdgcn_readfirstlane(tid >> 6), lane = tid & 63, wr = wid >> 2, wc = wid & 3, fr = lane & 15, fq = lane >> 4;
    const int K = g.K, nt = K / BK;
    unsigned voffA[2], voffB[2];
#pragma unroll
    for (int i = 0; i < 2; ++i) { int R, C; stage_rc(tid * 16 + i * 8192, R, C); const int Rb = Epi::PERM ? ((R & ~31) + perm32(R & 31)) : R;
        voffA[i] = (unsigned)(R * K + C) * 2u; voffB[i] = (unsigned)(Rb * K + C) * 2u; }
    const size_t kstep = (size_t)(BK * 2);
    const size_t hstep = (size_t)HALF * K * 2;
    const size_t tstep = 2 * hstep;
    const unsigned ldsw = (unsigned)wid * 1024u;
    const int aoff = lds_byte(wr * 64 + fr, fq * 8), boff = lds_byte(wc * 32 + fr, fq * 8);
#define PG8_SA(b, h) (((b) * 2 + (h)) * HTB)
#define PG8_SB(b, h) ((4 + (b) * 2 + (h)) * HTB)
#define PG8_STAGE(bufoff, gbase, voff) do { _Pragma("unroll") for (int _i = 0; _i < 2; ++_i) \
        __builtin_amdgcn_global_load_lds((const unsigned*)((const char*)(gbase) + (voff)[_i]), (PG8_LAS unsigned*)(lds + (bufoff) + ldsw + _i * 8192), 16, 0, 0); } while (0)
#define PG8_LDA(dst, b, h) do { _Pragma("unroll") for (int m = 0; m < 4; ++m) _Pragma("unroll") for (int k = 0; k < 2; ++k) dst[m][k] = *(const PG8_LAS bf16x8*)(lds + PG8_SA(b, h) + aoff + m * 2048 + k * 1024); } while (0)
#define PG8_LDB(dst, b, h) do { _Pragma("unroll") for (int n = 0; n < 2; ++n) _Pragma("unroll") for (int k = 0; k < 2; ++k) dst[n][k] = *(const PG8_LAS bf16x8*)(lds + PG8_SB(b, h) + boff + n * 2048 + k * 1024); } while (0)
#define PG8_MMA(ai, bj, At, Bt) do { __builtin_amdgcn_s_setprio(1); _Pragma("unroll") for (int m = 0; m < 4; ++m) _Pragma("unroll") for (int n = 0; n < 2; ++n) _Pragma("unroll") for (int k = 0; k < 2; ++k) \
        acc[ai][bj][m][n] = __builtin_amdgcn_mfma_f32_16x16x32_bf16(Bt[n][k], At[m][k], acc[ai][bj][m][n], 0, 0, 0); __builtin_amdgcn_s_setprio(0); } while (0)
#define PG8_WAIT_V(n) asm volatile("s_waitcnt vmcnt(" #n ")" ::: "memory")
#define PG8_WAIT_L(n) asm volatile("s_waitcnt lgkmcnt(" #n ")" ::: "memory")
#define PG8_BAR __builtin_amdgcn_s_barrier()
#define PG8_SCHED __builtin_amdgcn_sched_barrier(0)
    Unit cur, nxt; int ui = 0;
    if (!S.next(0, cur)) return;
    f32x4 acc[2][2][4][2];
#pragma unroll
    for (int a = 0; a < 2; ++a)
#pragma unroll
        for (int b = 0; b < 2; ++b)
#pragma unroll
            for (int m = 0; m < 4; ++m)
#pragma unroll
                for (int n = 0; n < 2; ++n) acc[a][b][m][n] = (f32x4){0.f, 0.f, 0.f, 0.f};
    bf16x8 At[4][2], B0[2][2], B1[2][2];
    const char* cA = (const char*)g.A + (size_t)cur.pm * tstep; const char* cB = (const char*)g.Bt + (size_t)cur.pn * tstep;
    S.a_ready(cur);
    if constexpr (SP2) {
        PG8_STAGE(PG8_SB(0, 0), cB, voffB); PG8_STAGE(PG8_SB(0, 1), cB + hstep, voffB); PG8_STAGE(PG8_SA(0, 0), cA, voffA); PG8_STAGE(PG8_SA(0, 1), cA + hstep, voffA);
        if (wr == 1) PG8_BAR;
        PG8_WAIT_V(2); PG8_BAR;
        PG8_STAGE(PG8_SB(1, 0), cB + kstep, voffB); PG8_STAGE(PG8_SA(1, 0), cA + kstep, voffA); PG8_STAGE(PG8_SB(1, 1), cB + hstep + kstep, voffB);
        PG8_WAIT_V(6); PG8_BAR;
    } else {
        PG8_STAGE(PG8_SB(0, 0), cB, voffB); PG8_STAGE(PG8_SA(0, 0), cA, voffA); PG8_STAGE(PG8_SB(0, 1), cB + hstep, voffB); PG8_STAGE(PG8_SA(0, 1), cA + hstep, voffA);
        if (wr == 1) PG8_BAR;
        PG8_WAIT_V(4); PG8_BAR;
        PG8_STAGE(PG8_SB(1, 0), cB + kstep, voffB); PG8_STAGE(PG8_SA(1, 0), cA + kstep, voffA); PG8_STAGE(PG8_SB(1, 1), cB + hstep + kstep, voffB);
        PG8_WAIT_V(6); PG8_BAR;
    }
    for (;;) {
        const bool has_next = S.next(ui + 1, nxt);
        const char* nA = has_next ? (const char*)g.A + (size_t)nxt.pm * tstep : cA; const char* nB = has_next ? (const char*)g.Bt + (size_t)nxt.pn * tstep : cB;
        for (int t = 0; t < nt; t += 2) {
            const bool last = (t == nt - 2);
            const char* a1 = cA + (size_t)(t + 1) * kstep;
            const char* a2 = last ? nA : cA + (size_t)(t + 2) * kstep; const char* b2 = last ? nB : cB + (size_t)(t + 2) * kstep;
            const char* a3 = a2 + kstep; const char* b3 = b2 + kstep;
            if (last && has_next) S.a_ready(nxt);
            if constexpr (SP2) {
            PG8_LDB(B0, 0, 0); PG8_LDB(B1, 0, 1); PG8_SCHED; PG8_LDA(At, 0, 0); PG8_STAGE(PG8_SA(1, 1), a1 + hstep, voffA);
            PG8_WAIT_V(8); PG8_WAIT_L(0); PG8_BAR; PG8_MMA(0, 0, At, B0); PG8_MMA(0, 1, At, B1); PG8_BAR; PG8_SCHED;
            PG8_LDA(At, 0, 1); PG8_STAGE(PG8_SB(0, 0), b2, voffB); PG8_STAGE(PG8_SB(0, 1), b2 + hstep, voffB); PG8_STAGE(PG8_SA(0, 0), a2, voffA);
            PG8_WAIT_V(8); PG8_WAIT_L(0); PG8_BAR; PG8_MMA(1, 0, At, B0); PG8_MMA(1, 1, At, B1); PG8_BAR; PG8_SCHED;
            PG8_LDB(B0, 1, 0); PG8_LDB(B1, 1, 1); PG8_SCHED; PG8_LDA(At, 1, 0); PG8_STAGE(PG8_SA(0, 1), a2 + hstep, voffA);
            PG8_WAIT_V(8); PG8_WAIT_L(0); PG8_BAR; PG8_MMA(0, 0, At, B0); PG8_MMA(0, 1, At, B1); PG8_BAR; PG8_SCHED;
            PG8_LDA(At, 1, 1); PG8_STAGE(PG8_SB(1, 0), b3, voffB); PG8_STAGE(PG8_SB(1, 1), b3 + hstep, voffB); PG8_STAGE(PG8_SA(1, 0), a3, voffA);
            PG8_WAIT_V(8); PG8_WAIT_L(0); PG8_BAR; PG8_MMA(1, 0, At, B0); PG8_MMA(1, 1, At, B1); PG8_BAR; PG8_SCHED;
            } else {
            PG8_LDB(B0, 0, 0); PG8_SCHED; PG8_LDA(At, 0, 0); PG8_STAGE(PG8_SA(1, 1), a1 + hstep, voffA);
            PG8_WAIT_L(8); PG8_BAR; PG8_WAIT_L(0); PG8_MMA(0, 0, At, B0); PG8_BAR; PG8_SCHED;
            PG8_LDB(B1, 0, 1); PG8_STAGE(PG8_SB(0, 0), b2, voffB);
            PG8_BAR; PG8_WAIT_L(0); PG8_MMA(0, 1, At, B1); PG8_BAR;
            PG8_LDA(At, 0, 1); PG8_STAGE(PG8_SA(0, 0), a2, voffA);
            PG8_BAR; PG8_WAIT_L(0); PG8_MMA(1, 0, At, B0); PG8_BAR; PG8_SCHED;
            PG8_STAGE(PG8_SB(0, 1), b2 + hstep, voffB);
            PG8_WAIT_V(6); PG8_BAR; PG8_MMA(1, 1, At, B1); PG8_BAR;
            PG8_LDB(B0, 1, 0); PG8_SCHED; PG8_LDA(At, 1, 0); PG8_STAGE(PG8_SA(0, 1), a2 + hstep, voffA);
            PG8_WAIT_L(8); PG8_BAR; PG8_WAIT_L(0); PG8_MMA(0, 0, At, B0); PG8_BAR; PG8_SCHED;
            PG8_LDB(B1, 1, 1); PG8_STAGE(PG8_SB(1, 0), b3, voffB);
            PG8_BAR; PG8_WAIT_L(0); PG8_MMA(0, 1, At, B1); PG8_BAR;
            PG8_LDA(At, 1, 1); PG8_STAGE(PG8_SA(1, 0), a3, voffA);
            PG8_BAR; PG8_WAIT_L(0); PG8_MMA(1, 0, At, B0); PG8_BAR; PG8_SCHED;
            PG8_STAGE(PG8_SB(1, 1), b3 + hstep, voffB);
            PG8_WAIT_V(6); PG8_BAR; PG8_MMA(1, 1, At, B1); PG8_BAR;
            }
        }
        if constexpr (ALIGN_EPI) { if (wr == 0) PG8_BAR; }
        if constexpr (!Epi::AFTER_DRAIN) { E(acc, cur, wr, wc, fr, fq); S.done(cur); }
        if (!has_next) break;
#pragma unroll
        for (int a = 0; a < 2; ++a)
#pragma unroll
            for (int b = 0; b < 2; ++b)
#pragma unroll
                for (int m = 0; m < 4; ++m)
#pragma unroll
                    for (int n = 0; n < 2; ++n) acc[a][b][m][n] = (f32x4){0.f, 0.f, 0.f, 0.f};
        cur = nxt; cA = nA; cB = nB; ++ui;
        if constexpr (ALIGN_EPI) { if (wr == 1) PG8_BAR; }
    }
    PG8_WAIT_V(0);
    if constexpr (!ALIGN_EPI) { if (wr == 0) PG8_BAR; }
    PG8_BAR;
    if constexpr (Epi::AFTER_DRAIN) { E.fused(acc, cur, wr, wc, fr, fq, lds, wid, lane); S.done(cur); }
#undef PG8_SA
#undef PG8_SB
#undef PG8_STAGE
#undef PG8_LDA
#undef PG8_LDB
#undef PG8_MMA
#undef PG8_WAIT_V
#undef PG8_WAIT_L
#undef PG8_BAR
#undef PG8_SCHED
}
}

constexpr int NB = 16, T = 2048, D = 2048, M = NB * T, NP = 6656, NIN = 6160, FF = 5632, NUP = 2 * FF, NMOD = 12288;
constexpr float EPS = 1e-6f, LOG2E = 1.4426950408889634f;
constexpr int NWAVES = 8;
constexpr size_t MiB = 1u << 20;
constexpr size_t WS_CTL = 0, CTL_ZERO_BYTES = 1 * MiB;
constexpr size_t WS_MOD = 1 * MiB;
constexpr size_t WS_SCAL = 3 * MiB;
constexpr size_t WS_NRM = 3 * MiB + 256 * 1024;
constexpr size_t WS_WIN = 4 * MiB;
constexpr size_t WS_WO = 56 * MiB;
constexpr size_t WS_WUP = 72 * MiB;
constexpr size_t WS_WDN = 160 * MiB;
constexpr size_t WS_HALO = 204 * MiB;
constexpr size_t HALO_ONE = (size_t)128 * 2 * 5632 * 4;
constexpr size_t WS_HN = 224 * MiB;
constexpr size_t WS_PROJ = 352 * MiB;
constexpr size_t WS_XB = 768 * MiB;
constexpr size_t WS_END = 896 * MiB;
static_assert(WS_WIN + (size_t)2 * NP * D * 2 <= WS_WO && WS_WO + (size_t)2 * D * D * 2 <= WS_WUP && WS_WUP + (size_t)2 * NUP * D * 2 <= WS_WDN && WS_WDN + (size_t)2 * D * FF * 2 <= WS_HALO &&
              WS_HALO + 3 * HALO_ONE <= WS_HN && WS_HN + (size_t)M * D * 2 <= WS_PROJ && WS_PROJ + (size_t)M * NP * 2 <= WS_XB && WS_XB + (size_t)M * D * 2 <= WS_END, "d_ws map");
constexpr int CW_TMO = 0, CW_CODE = 1, CW_BAR = 4096, CW_QUEUE = 16384;
constexpr int RING_OFF = 0, RING_BYTES = 131072, BND_OFF = RING_BYTES, LDSCTL_OFF = BND_OFF + 4096, LDS_BYTES = 147456;

#define GAS __attribute__((address_space(1)))
#define LAS __attribute__((address_space(3)))
typedef unsigned short bf16;
typedef unsigned v4u __attribute__((ext_vector_type(4)));
typedef unsigned v2u __attribute__((ext_vector_type(2)));
typedef float f32x4 __attribute__((ext_vector_type(4)));
typedef GAS unsigned gu32;
#define RLX_AGENT __ATOMIC_RELAXED, __HIP_MEMORY_SCOPE_AGENT
#define LDS_WAIT() asm volatile("s_waitcnt lgkmcnt(0)" ::: "memory")
__device__ __forceinline__ unsigned f2bf(float f) { unsigned u = __builtin_bit_cast(unsigned, f); return (u + 0x7fffu + ((u >> 16) & 1u)) >> 16; }
__device__ __forceinline__ unsigned pk2(float lo, float hi) { unsigned r; asm volatile("v_cvt_pk_bf16_f32 %0, %1, %2" : "=v"(r) : "v"(lo), "v"(hi)); return r; }
__device__ __forceinline__ float bf2f(unsigned short h) { return __builtin_bit_cast(float, (unsigned)h << 16); }
__device__ __forceinline__ float bflo(unsigned w) { return __builtin_bit_cast(float, w << 16); }
__device__ __forceinline__ float bfhi(unsigned w) { return __builtin_bit_cast(float, w & 0xffff0000u); }
#define DPPF(v, ctrl) __builtin_bit_cast(float, __builtin_amdgcn_update_dpp(0, __builtin_bit_cast(int, (v)), (ctrl), 0xF, 0xF, true))
__device__ __forceinline__ float wave_sum(float v) {
    v += DPPF(v, 0xB1);
    v += DPPF(v, 0x4E);
    v += DPPF(v, 0x141);
    v += DPPF(v, 0x140);
    v += __builtin_bit_cast(float, __builtin_amdgcn_ds_swizzle(__builtin_bit_cast(int, v), 0x401F));
    float a = v, b = v;
    asm volatile("s_nop 1\n\tv_permlane32_swap_b32_e32 %0, %1\n\ts_nop 1" : "+v"(a), "+v"(b));
    return a + b;
}
struct Args { const float* in[18]; float* out; unsigned char* ws; int ph_lo, ph_hi, pad0, pad1; };
typedef const __attribute__((address_space(4))) Args CArgs;
#define ARGS() ({ CArgs* p_ = (CArgs*)__builtin_amdgcn_kernarg_segment_ptr(); asm volatile("" : "+s"(p_)); p_; })
#define XB_TMO      128
#define XB_XCNT(j)  (256  + 64 * (j))
#define XB_XSUB(j)  (1280 + 64 * (j))
#define XB_XGEN(j)  (2304 + 64 * (j))
#define XB_TOP      3328
#define XB_TOPGEN   3392
#define XCD_BAR_WORDS 3456
#define XB_SPIN_CAP (1u << 18)

__device__ __forceinline__ unsigned xb_ld(unsigned* p)              { return __hip_atomic_load(p, __ATOMIC_RELAXED, __HIP_MEMORY_SCOPE_AGENT); }
__device__ __forceinline__ unsigned xb_add(unsigned* p, unsigned v) { return __hip_atomic_fetch_add(p, v, __ATOMIC_RELAXED, __HIP_MEMORY_SCOPE_AGENT); }
__device__ __forceinline__ unsigned xb_xcc_id() { return (unsigned)__builtin_amdgcn_s_getreg((3 << 11) | 20) & 0xFu; }
#define XB_SPIN(cond, bar) do { unsigned _sp = 0; while (cond) { __builtin_amdgcn_s_sleep(1); \
    if ((++_sp & 255u) == 0u) { if (xb_ld(&(bar)[XB_TMO])) break; if (_sp > XB_SPIN_CAP) { atomicAdd(&(bar)[XB_TMO], 1u); break; } } } } while (0)

struct XcdBarrier {
    unsigned* bar; unsigned x;
    volatile LAS unsigned* st;
};

__device__ __forceinline__ XcdBarrier xcd_barrier_post(unsigned* bar, volatile LAS unsigned* st) {
    XcdBarrier b; b.bar = bar; b.x = xb_xcc_id(); b.st = st;
    if (threadIdx.x == 0) (void)xb_add(&bar[XB_XCNT(b.x)], 1u);
    return b;
}
__device__ __forceinline__ void xcd_barrier_complete(unsigned* bar, unsigned x, unsigned& nloc, unsigned& nx) {
    const unsigned G = gridDim.x * gridDim.y * gridDim.z;
    unsigned sum, cnt, mine, sp = 0u;
    for (;;) {
        sum = 0u; cnt = 0u; mine = 0u;
#pragma unroll
        for (unsigned j = 0; j < 16; ++j) { const unsigned c = xb_ld(&bar[XB_XCNT(j)]); sum += c; cnt += (c > 0u) ? 1u : 0u; mine = (j == x) ? c : mine; }
        if (sum == G) break;
        __builtin_amdgcn_s_sleep(1);
        if ((++sp & 255u) == 0u) { if (xb_ld(&bar[XB_TMO])) break; if (sp > XB_SPIN_CAP) { atomicAdd(&bar[XB_TMO], 1u); break; } }
    }
    nloc = mine > 0u ? mine : 1u; nx = cnt > 0u ? cnt : 1u;
}

__device__ __forceinline__ void xcd_barrier(const XcdBarrier& b) {
    asm volatile("s_waitcnt vmcnt(0)" ::: "memory");
    __syncthreads();
    if (threadIdx.x == 0) {
        unsigned* bar = b.bar;
        __builtin_amdgcn_s_waitcnt(0);
        unsigned nloc = b.st[0], nx = b.st[1];
        if (nloc == 0u) { xcd_barrier_complete(bar, b.x, nloc, nx); b.st[0] = nloc; b.st[1] = nx; }
        const unsigned old = xb_add(&bar[XB_XSUB(b.x)], 1u);
        const unsigned gen = old / nloc;
        if (old + 1u == (gen + 1u) * nloc) {
            __builtin_amdgcn_fence(__ATOMIC_RELEASE, "agent");
            asm volatile("s_waitcnt vmcnt(0)" ::: "memory");
            const unsigned og = xb_add(&bar[XB_TOP], 1u);
            const unsigned tg = og / nx;
            if (og + 1u == (tg + 1u) * nx) xb_add(&bar[XB_TOPGEN], 1u);
            else XB_SPIN(xb_ld(&bar[XB_TOPGEN]) == tg, bar);
            __builtin_amdgcn_fence(__ATOMIC_ACQUIRE, "agent");
            xb_add(&bar[XB_XGEN(b.x)], 1u);
            asm volatile("s_waitcnt vmcnt(0)" ::: "memory");
        } else {
            XB_SPIN(xb_ld(&bar[XB_XGEN(b.x)]) == gen, bar);
            __builtin_amdgcn_fence(__ATOMIC_ACQUIRE, "agent");
            asm volatile("s_waitcnt vmcnt(0)" ::: "memory");
        }
    }
    __syncthreads();
}


__device__ __forceinline__ void p0_write_item(bf16* WT, int K, int dst_row, int k0, LAS float* scr, int lane) {
    LDS_WAIT(); asm volatile("" ::: "memory");
    int ln = lane; asm volatile("" : "+v"(ln));
    const int c = ln & 7, n = ln >> 3; const LAS float* s0 = scr + (8 * c) * 33 + n;
    bf16* op = WT + (size_t)(dst_row + n) * K + k0 + 8 * c; const size_t ost = (size_t)8 * K;
#pragma unroll
    for (int j = 0; j < 4; ++j) { const LAS float* s = s0 + 8 * j;
        v4u o; o.x = pk2(s[0 * 33], s[1 * 33]); o.y = pk2(s[2 * 33], s[3 * 33]); o.z = pk2(s[4 * 33], s[5 * 33]); o.w = pk2(s[6 * 33], s[7 * 33]);
        *(GAS v4u*)op = o; op += ost; }
    LDS_WAIT(); asm volatile("" ::: "memory");
}
__device__ __forceinline__ void p0_transpose_item(const float* W, int ldw, int K, bf16* WT, int dst_row, int k0, int n0, LAS float* scr, int lane) {
    float wv[32];
#pragma unroll
    for (int i = 0; i < 32; ++i) wv[i] = W[(size_t)(k0 + 2 * i + (lane >> 5)) * ldw + n0 + (lane & 31)];
#pragma unroll
    for (int i = 0; i < 32; ++i) scr[(2 * i + (lane >> 5)) * 33 + (lane & 31)] = wv[i];
    p0_write_item(WT, K, dst_row, k0, scr, lane);
}
__device__ __forceinline__ void p0_weff_item(const float* Win, const float* Wgk, bf16* WT, int k0, int n0, LAS float* scr, int lane) {
    const int n = lane & 31;
    float g[16];
#pragma unroll
    for (int r = 0; r < 16; ++r) g[r] = Wgk[r * 512 + n0 + n];
#pragma unroll 4
    for (int i = 0; i < 32; ++i) { const int kk = 2 * i + (lane >> 5); const float* wr = Win + (size_t)(k0 + kk) * NIN + 6144; float s = 0.f;
#pragma unroll
        for (int r = 0; r < 16; ++r) s += wr[r] * g[r];
        scr[kk * 33 + n] = s; }
    p0_write_item(WT, D, 6144 + n0, k0, scr, lane);
}

__device__ __forceinline__ void p0_prologue(const CArgs* ap, LAS unsigned char* lds, int tid, int lane, int wave, int vcu, int G) {
    unsigned char* ws = ap->ws;
    float* MOD = (float*)(ws + WS_MOD); float* SCAL = (float*)(ws + WS_SCAL);
    if (blockIdx.x < 192) {
        const int item = blockIdx.x >> 1, kh = blockIdx.x & 1, l = item / 48, cg = item % 48, kbase = 1024 * kh + 128 * wave;
        LAS float* cs = (LAS float*)(lds + wave * 16384);
        const float* c = ap->in[1];
        for (int i = 0; i < 32; ++i) { const int e = lane + 64 * i, bb = e & 15, kk = e >> 4; const float cv = c[bb * D + kbase + kk]; cs[kk * 16 + bb] = cv / (1.f + __expf(-cv)); }
        LDS_WAIT(); asm volatile("" ::: "memory");
        const float* W = ap->in[2] + (size_t)l * D * NMOD + (size_t)kbase * NMOD + 256 * cg + 4 * lane;
        f32x4 acc[16];
#pragma unroll
        for (int i = 0; i < 16; ++i) acc[i] = (f32x4){0.f, 0.f, 0.f, 0.f};
#pragma unroll 16
        for (int kk = 0; kk < 128; ++kk) { const f32x4 w = __builtin_nontemporal_load((const f32x4*)(W + (size_t)kk * NMOD));
#pragma unroll
            for (int q4 = 0; q4 < 4; ++q4) { const f32x4 c4 = *(const LAS f32x4*)(cs + kk * 16 + 4 * q4);
                acc[4 * q4 + 0] += c4.x * w; acc[4 * q4 + 1] += c4.y * w; acc[4 * q4 + 2] += c4.z * w; acc[4 * q4 + 3] += c4.w * w; } }
        __syncthreads();
        LAS float* red = (LAS float*)lds;
#pragma unroll
        for (int bb = 0; bb < 16; ++bb) *(LAS f32x4*)(red + (wave * 16 + bb) * 256 + 4 * lane) = acc[bb];
        __syncthreads();
        for (int i = 0; i < 8; ++i) { const int o = tid + 512 * i, bb = o >> 8, col = o & 255; float s = (kh == 0) ? ap->in[3][l * NMOD + 256 * cg + col] : 0.f;
#pragma unroll
            for (int w = 0; w < 8; ++w) s += red[(w * 16 + bb) * 256 + col];
            atomicAdd(MOD + (size_t)(l * 16 + bb) * NMOD + 256 * cg + col, s); }
        __syncthreads();
    }
    if (blockIdx.x == 200 && wave == 0) {
        for (int l = 0; l < 2; ++l) { const float* dl = ap->in[6] + l * 256; float s1 = dl[lane] * dl[64 + lane], s2 = dl[128 + lane] * dl[192 + lane];
            s1 = wave_sum(s1); s2 = wave_sum(s2);
            if (lane == 0) SCAL[l] = __expf(s1) - __expf(s2) + (l == 0 ? 0.2f : 0.35550906759096926f); }
    }
    LAS float* scr = (LAS float*)(lds + wave * 16384);
    const int gw = vcu * NWAVES + wave, NGW = G * NWAVES;
    constexpr int I_IN = 32 * 192, I_EFF = 32 * 16, I_O = 32 * 64, I_UP = 32 * 352, I_DN = 88 * 64, I_L = I_IN + I_EFF + I_O + I_UP + I_DN;
#define P0_DECODE(IT, W_, WT_, LDW_, K_, DST_, K0_, N0_, KIND_) do { const int it_ = (IT); if (it_ >= 2 * I_L) { KIND_ = -1; } else { const int l_ = it_ / I_L; int r_ = it_ % I_L; KIND_ = 0; \
        if (r_ < I_IN) { const int kb = r_ / 192, nb = r_ % 192; W_ = ap->in[5] + (size_t)l_ * D * NIN; LDW_ = NIN; K_ = D; WT_ = (bf16*)(ws + WS_WIN) + (size_t)l_ * NP * D; DST_ = 32 * nb; K0_ = 64 * kb; N0_ = 32 * nb; } \
        else if ((r_ -= I_IN) < I_EFF) { const int kb = r_ / 16, nb = r_ % 16; KIND_ = 1; W_ = ap->in[5] + (size_t)l_ * D * NIN; LDW_ = l_; K_ = D; WT_ = (bf16*)(ws + WS_WIN) + (size_t)l_ * NP * D; DST_ = 0; K0_ = 64 * kb; N0_ = 32 * nb; } \
        else if ((r_ -= I_EFF) < I_O) { const int kb = r_ / 64, nb = r_ % 64; W_ = ap->in[11] + (size_t)l_ * D * D; LDW_ = D; K_ = D; WT_ = (bf16*)(ws + WS_WO) + (size_t)l_ * D * D; DST_ = 32 * nb; K0_ = 64 * kb; N0_ = 32 * nb; } \
        else if ((r_ -= I_O) < I_UP) { const int kb = r_ / 352, nb = r_ % 352, n0_ = 32 * nb, n1_ = n0_ < FF ? n0_ : n0_ - FF; W_ = ap->in[13] + (size_t)l_ * D * NUP; LDW_ = NUP; K_ = D; WT_ = (bf16*)(ws + WS_WUP) + (size_t)l_ * NUP * D; \
            DST_ = 256 * (n1_ / 128) + (n1_ % 128) + (n0_ < FF ? 0 : 128); K0_ = 64 * kb; N0_ = n0_; } \
        else { r_ -= I_UP; const int kb = r_ / 64, nb = r_ % 64; W_ = ap->in[16] + (size_t)l_ * FF * D; LDW_ = D; K_ = FF; WT_ = (bf16*)(ws + WS_WDN) + (size_t)l_ * D * FF; DST_ = 32 * nb; K0_ = 64 * kb; N0_ = 32 * nb; } } } while (0)
#define P0_LOAD(DSTV, W_, LDW_, K0_, N0_) do { int ln_ = lane; asm volatile("" : "+v"(ln_)); const float* p_ = (W_) + (size_t)((K0_) + (ln_ >> 5)) * (LDW_) + (N0_) + (ln_ & 31); const size_t st_ = (size_t)2 * (LDW_); \
        _Pragma("unroll") for (int i = 0; i < 32; ++i) { DSTV[i] = *p_; p_ += st_; } } while (0)
    const float* cW = nullptr; bf16* cWT = nullptr; int cldw = 0, cK = 0, cdst = 0, ck0 = 0, cn0 = 0, ckind = -1;
#ifndef PRO_WA
#define PRO_WA 4
#define PRO_WO 10
#endif
    const bool wdeal = (G == 256), ada = blockIdx.x < 192;
    const int wgt = wdeal ? (ada ? PRO_WA : PRO_WO) : 1;
    const int cls = wdeal ? (ada ? 192 * NWAVES : 64 * NWAVES) : NGW;
    const int slot0 = wdeal ? (ada ? ((int)blockIdx.x * NWAVES + wave) : 192 * NWAVES * PRO_WA + (((int)blockIdx.x - 192) * NWAVES + wave)) : gw;
    const int srn = wdeal ? (192 * NWAVES * PRO_WA + 64 * NWAVES * PRO_WO) : NGW;
    int it = slot0, jw = 0, itn;
#define P0_NEXT(IT_) do { if (++jw == wgt) { jw = 0; IT_ += srn - (wgt - 1) * cls; } else IT_ += cls; } while (0)
    P0_DECODE(it, cW, cWT, cldw, cK, cdst, ck0, cn0, ckind);
    float wv[32];
    if (ckind == 0) P0_LOAD(wv, cW, cldw, ck0, cn0);
    for (; ckind >= 0; it = itn) {
        const float* nW = nullptr; bf16* nWT = nullptr; int nldw = 0, nK = 0, ndst = 0, nk0 = 0, nn0 = 0, nkind = -1;
        itn = it; P0_NEXT(itn);
        P0_DECODE(itn, nW, nWT, nldw, nK, ndst, nk0, nn0, nkind);
        float wn[32];
        if (nkind == 0) P0_LOAD(wn, nW, nldw, nk0, nn0);
        if (ckind == 0) {
            int ln = lane; asm volatile("" : "+v"(ln));
#pragma unroll
            for (int i = 0; i < 32; ++i) scr[(2 * i + (ln >> 5)) * 33 + (ln & 31)] = wv[i];
            p0_write_item(cWT, cK, cdst, ck0, scr, lane);
        } else p0_weff_item(cW, ap->in[8] + (size_t)cldw * 16 * 512, cWT, ck0, cn0, scr, lane);
        cW = nW; cWT = nWT; cldw = nldw; cK = nK; cdst = ndst; ck0 = nk0; cn0 = nn0; ckind = nkind;
#pragma unroll
        for (int i = 0; i < 32; ++i) wv[i] = wn[i];
    }
#undef P0_DECODE
#undef P0_LOAD
#undef P0_NEXT
}

__device__ __forceinline__ void norm_phase(const float* xin, const float* g, const float* modl, int sh_chunk, int sc_chunk, bf16* outp, int gw, int NGW, int lane) {
    for (int rb = gw; rb < M / 16; rb += NGW) {
        const int b = rb >> 7; const float* mb = modl + (size_t)b * NMOD;
        f32x4 A[8], S[8];
#pragma unroll
        for (int j = 0; j < 8; ++j) { const int col = 4 * lane + 256 * j; const f32x4 gv = *(const f32x4*)(g + col), sc = *(const f32x4*)(mb + sc_chunk * D + col); A[j] = gv * (1.f + sc); S[j] = *(const f32x4*)(mb + sh_chunk * D + col); }
        for (int r = 0; r < 16; r += 2) {
            const size_t row = (size_t)rb * 16 + r; const GAS f32x4* xr = (const GAS f32x4*)(xin + row * D) + lane;
            f32x4 v[8], u[8]; float s0 = 0.f, s1 = 0.f;
#pragma unroll
            for (int j = 0; j < 8; ++j) { v[j] = xr[64 * j]; u[j] = xr[64 * j + D / 4]; }
#pragma unroll
            for (int j = 0; j < 8; ++j) { s0 += (v[j].x * v[j].x + v[j].y * v[j].y) + (v[j].z * v[j].z + v[j].w * v[j].w); s1 += (u[j].x * u[j].x + u[j].y * u[j].y) + (u[j].z * u[j].z + u[j].w * u[j].w); }
            const float r0 = 1.f / sqrtf(wave_sum(s0) * (1.f / D) + EPS), r1 = 1.f / sqrtf(wave_sum(s1) * (1.f / D) + EPS);
            GAS v2u* o8 = (GAS v2u*)(outp + row * D) + lane;
#pragma unroll
            for (int j = 0; j < 8; ++j) { const f32x4 y = v[j] * r0 * A[j] + S[j], z = u[j] * r1 * A[j] + S[j]; v2u w; w.x = pk2(y.x, y.y); w.y = pk2(y.z, y.w); o8[64 * j] = w; w.x = pk2(z.x, z.y); w.y = pk2(z.z, z.w); o8[64 * j + D / 4] = w; }
        }
    }
}
__device__ __forceinline__ void final_norm_phase(float* x, const float* g, int gw, int NGW, int lane) {
    f32x4 A[8];
#pragma unroll
    for (int j = 0; j < 8; ++j) A[j] = *(const f32x4*)(g + 4 * lane + 256 * j);
    for (int row = gw; row < M; row += NGW) {
        GAS f32x4* xr = (GAS f32x4*)(x + (size_t)row * D) + lane;
        f32x4 v[8]; float s = 0.f;
#pragma unroll
        for (int j = 0; j < 8; ++j) { v[j] = xr[64 * j]; s += (v[j].x * v[j].x + v[j].y * v[j].y) + (v[j].z * v[j].z + v[j].w * v[j].w); }
        const float rstd = 1.f / sqrtf(wave_sum(s) * (1.f / D) + EPS);
#pragma unroll
        for (int j = 0; j < 8; ++j) xr[64 * j] = v[j] * rstd * A[j];
    }
}

__device__ __forceinline__ void norm_phase_b(const bf16* xin, const float* g, const float* modl, int sh_chunk, int sc_chunk, bf16* outp, int gw, int NGW, int lane) {
    for (int rb = gw; rb < M / 16; rb += NGW) {
        const int b = rb >> 7; const float* mb = modl + (size_t)b * NMOD;
        f32x4 A[8], S[8];
#pragma unroll
        for (int j = 0; j < 8; ++j) { const int col = 8 * lane + 512 * (j >> 1) + 4 * (j & 1); const f32x4 gv = *(const f32x4*)(g + col), sc = *(const f32x4*)(mb + sc_chunk * D + col); A[j] = gv * (1.f + sc); S[j] = *(const f32x4*)(mb + sh_chunk * D + col); }
        for (int r = 0; r < 16; r += 2) {
            const size_t row = (size_t)rb * 16 + r; const GAS v4u* xr = (const GAS v4u*)(xin + row * D) + lane;
            v4u w0[4], w1[4];
#pragma unroll
            for (int j = 0; j < 4; ++j) { w0[j] = xr[64 * j]; w1[j] = xr[64 * j + D / 8]; }
            float s0 = 0.f, s1 = 0.f;
#pragma unroll
            for (int j = 0; j < 4; ++j) { s0 += (bflo(w0[j].x) * bflo(w0[j].x) + bfhi(w0[j].x) * bfhi(w0[j].x)) + (bflo(w0[j].y) * bflo(w0[j].y) + bfhi(w0[j].y) * bfhi(w0[j].y)) + (bflo(w0[j].z) * bflo(w0[j].z) + bfhi(w0[j].z) * bfhi(w0[j].z)) + (bflo(w0[j].w) * bflo(w0[j].w) + bfhi(w0[j].w) * bfhi(w0[j].w));
                                           s1 += (bflo(w1[j].x) * bflo(w1[j].x) + bfhi(w1[j].x) * bfhi(w1[j].x)) + (bflo(w1[j].y) * bflo(w1[j].y) + bfhi(w1[j].y) * bfhi(w1[j].y)) + (bflo(w1[j].z) * bflo(w1[j].z) + bfhi(w1[j].z) * bfhi(w1[j].z)) + (bflo(w1[j].w) * bflo(w1[j].w) + bfhi(w1[j].w) * bfhi(w1[j].w)); }
            const float r0 = 1.f / sqrtf(wave_sum(s0) * (1.f / D) + EPS), r1 = 1.f / sqrtf(wave_sum(s1) * (1.f / D) + EPS);
            GAS v4u* o16 = (GAS v4u*)(outp + row * D) + lane;
#pragma unroll
            for (int j = 0; j < 4; ++j) {
                { const f32x4 v0 = (f32x4){bflo(w0[j].x), bfhi(w0[j].x), bflo(w0[j].y), bfhi(w0[j].y)}, v1 = (f32x4){bflo(w0[j].z), bfhi(w0[j].z), bflo(w0[j].w), bfhi(w0[j].w)};
                  const f32x4 y0 = v0 * r0 * A[2 * j] + S[2 * j], y1 = v1 * r0 * A[2 * j + 1] + S[2 * j + 1]; v4u w; w.x = pk2(y0.x, y0.y); w.y = pk2(y0.z, y0.w); w.z = pk2(y1.x, y1.y); w.w = pk2(y1.z, y1.w); o16[64 * j] = w; }
                { const f32x4 v0 = (f32x4){bflo(w1[j].x), bfhi(w1[j].x), bflo(w1[j].y), bfhi(w1[j].y)}, v1 = (f32x4){bflo(w1[j].z), bfhi(w1[j].z), bflo(w1[j].w), bfhi(w1[j].w)};
                  const f32x4 y0 = v0 * r1 * A[2 * j] + S[2 * j], y1 = v1 * r1 * A[2 * j + 1] + S[2 * j + 1]; v4u w; w.x = pk2(y0.x, y0.y); w.y = pk2(y0.z, y0.w); w.z = pk2(y1.x, y1.y); w.w = pk2(y1.z, y1.w); o16[64 * j + D / 8] = w; }
            }
        }
    }
}
__device__ __forceinline__ void final_norm_phase_b(const bf16* x, float* out, const float* g, int gw, int NGW, int lane) {
    f32x4 A[8];
#pragma unroll
    for (int j = 0; j < 8; ++j) A[j] = *(const f32x4*)(g + 8 * lane + 512 * (j >> 1) + 4 * (j & 1));
    for (int rp = gw; rp < M / 2; rp += NGW) {
        const size_t row = (size_t)rp * 2; const GAS v4u* xr = (const GAS v4u*)(x + row * D) + lane;
        v4u w0[4], w1[4];
#pragma unroll
        for (int j = 0; j < 4; ++j) { w0[j] = xr[64 * j]; w1[j] = xr[64 * j + D / 8]; }
        f32x4 v[8], u[8]; float s0 = 0.f, s1 = 0.f;
#pragma unroll
        for (int j = 0; j < 4; ++j) { v[2 * j] = (f32x4){bflo(w0[j].x), bfhi(w0[j].x), bflo(w0[j].y), bfhi(w0[j].y)}; v[2 * j + 1] = (f32x4){bflo(w0[j].z), bfhi(w0[j].z), bflo(w0[j].w), bfhi(w0[j].w)};
                                       u[2 * j] = (f32x4){bflo(w1[j].x), bfhi(w1[j].x), bflo(w1[j].y), bfhi(w1[j].y)}; u[2 * j + 1] = (f32x4){bflo(w1[j].z), bfhi(w1[j].z), bflo(w1[j].w), bfhi(w1[j].w)}; }
#pragma unroll
        for (int j = 0; j < 8; ++j) { s0 += (v[j].x * v[j].x + v[j].y * v[j].y) + (v[j].z * v[j].z + v[j].w * v[j].w); s1 += (u[j].x * u[j].x + u[j].y * u[j].y) + (u[j].z * u[j].z + u[j].w * u[j].w); }
        const float r0 = 1.f / sqrtf(wave_sum(s0) * (1.f / D) + EPS), r1 = 1.f / sqrtf(wave_sum(s1) * (1.f / D) + EPS);
        GAS f32x4* o = (GAS f32x4*)(out + row * D) + 2 * lane;
#pragma unroll
        for (int j = 0; j < 4; ++j) { o[128 * j] = v[2 * j] * r0 * A[2 * j]; o[128 * j + 1] = v[2 * j + 1] * r0 * A[2 * j + 1]; o[128 * j + D / 4] = u[2 * j] * r1 * A[2 * j]; o[128 * j + 1 + D / 4] = u[2 * j + 1] * r1 * A[2 * j + 1]; }
    }
}
__device__ __forceinline__ void fixup_panel(const float* glast, const float* gfirst, const float* ufirst, const float* wconv, const float* bconv, bf16* act, int pm, int tid) {
    constexpr int PER_ROW = FF / 4;
    for (int idx = tid; idx < 2 * PER_ROW; idx += NWAVES * 64) {
        const int c = (idx % PER_ROW) * 4, rr = idx / PER_ROW;
        const f32x4 gl0 = *(const f32x4*)(glast + ((size_t)(pm - 1) * 2 + 0) * FF + c), gl1 = *(const f32x4*)(glast + ((size_t)(pm - 1) * 2 + 1) * FF + c);
        const f32x4 gf0 = *(const f32x4*)(gfirst + ((size_t)pm * 2 + 0) * FF + c), gf1 = *(const f32x4*)(gfirst + ((size_t)pm * 2 + 1) * FF + c);
        const f32x4 uu = *(const f32x4*)(ufirst + ((size_t)pm * 2 + rr) * FF + c);
        const f32x4 w0 = *(const f32x4*)(wconv + c), w1 = *(const f32x4*)(wconv + FF + c), w2 = *(const f32x4*)(wconv + 2 * FF + c), cb = *(const f32x4*)(bconv + c);
        const f32x4 y = rr == 0 ? (w0 * gl0 + w1 * gl1 + w2 * gf0 + cb) : (w0 * gl1 + w1 * gf0 + w2 * gf1 + cb);
        const pg8::f32x2 ga = pg8::gelu_pk((pg8::f32x2){y.x, y.y}), gb = pg8::gelu_pk((pg8::f32x2){y.z, y.w});
        v2u w; w.x = pk2(ga.x * uu.x, ga.y * uu.y); w.y = pk2(gb.x * uu.z, gb.y * uu.w);
        *(GAS v2u*)(act + (size_t)(256 * pm + rr) * FF + c) = w;
    }
}
__device__ __forceinline__ void fixup_phase(const float* glast, const float* gfirst, const float* ufirst, const float* wconv, const float* bconv, bf16* act, int gtid, int nthreads) {
    constexpr int PER_ROW = FF / 4, TOTAL = 112 * 2 * PER_ROW;
    for (int idx = gtid; idx < TOTAL; idx += nthreads) {
        const int c = (idx % PER_ROW) * 4, rr = (idx / PER_ROW) & 1, pmi = idx / (2 * PER_ROW), pm = (pmi / 7) * 8 + (pmi % 7) + 1;
        const f32x4 gl0 = *(const f32x4*)(glast + ((size_t)(pm - 1) * 2 + 0) * FF + c), gl1 = *(const f32x4*)(glast + ((size_t)(pm - 1) * 2 + 1) * FF + c);
        const f32x4 gf0 = *(const f32x4*)(gfirst + ((size_t)pm * 2 + 0) * FF + c), gf1 = *(const f32x4*)(gfirst + ((size_t)pm * 2 + 1) * FF + c);
        const f32x4 uu = *(const f32x4*)(ufirst + ((size_t)pm * 2 + rr) * FF + c);
        const f32x4 w0 = *(const f32x4*)(wconv + c), w1 = *(const f32x4*)(wconv + FF + c), w2 = *(const f32x4*)(wconv + 2 * FF + c), cb = *(const f32x4*)(bconv + c);
        const f32x4 y = rr == 0 ? (w0 * gl0 + w1 * gl1 + w2 * gf0 + cb) : (w0 * gl1 + w1 * gf0 + w2 * gf1 + cb);
        const pg8::f32x2 ga = pg8::gelu_pk((pg8::f32x2){y.x, y.y}), gb = pg8::gelu_pk((pg8::f32x2){y.z, y.w});
        v2u w; w.x = pk2(ga.x * uu.x, ga.y * uu.y); w.y = pk2(gb.x * uu.z, gb.y * uu.w);
        *(GAS v2u*)(act + (size_t)(256 * pm + rr) * FF + c) = w;
    }
}

__device__ __forceinline__ void attn_naive_unit(const bf16* P, bf16* CAT, int b, int h, int qb, float lam, float subscale, const float* gsub, LAS float* xch, int tid) {
    const int wave = tid >> 6, lane = tid & 63, mp = wave >> 2, dvh = (wave >> 1) & 1, rloc = (wave & 1) * 64 + lane, row = 128 * qb + rloc;
    const float slope2 = exp2f(-(float)(h + 1)) * LOG2E;
    const bf16* prow = P + (size_t)(b * T + row) * NP + h * 128 + mp * 64;
    float q[64];
#pragma unroll
    for (int d8 = 0; d8 < 8; ++d8) { const v4u w = *(const v4u*)(prow + 8 * d8); q[8 * d8 + 0] = bflo(w.x); q[8 * d8 + 1] = bfhi(w.x); q[8 * d8 + 2] = bflo(w.y); q[8 * d8 + 3] = bfhi(w.y); q[8 * d8 + 4] = bflo(w.z); q[8 * d8 + 5] = bfhi(w.z); q[8 * d8 + 6] = bflo(w.w); q[8 * d8 + 7] = bfhi(w.w); }
    float o[64];
#pragma unroll
    for (int i = 0; i < 64; ++i) o[i] = 0.f;
    float m = -1e30f, l = 0.f;
    const int kmax = __builtin_amdgcn_readfirstlane(128 * qb + (wave & 1) * 64 + 63);
    const bf16* kbase = P + (size_t)(b * T) * NP + 1024 + h * 128 + mp * 64;
    const bf16* vbase = P + (size_t)(b * T) * NP + 2048 + h * 128 + dvh * 64;
    for (int kv = 0; kv <= kmax; ++kv) {
        const bf16* kr = kbase + (size_t)kv * NP; float s = 0.f;
#pragma unroll
        for (int d8 = 0; d8 < 8; ++d8) { const v4u w = *(const v4u*)(kr + 8 * d8);
            s += q[8 * d8 + 0] * bflo(w.x) + q[8 * d8 + 1] * bfhi(w.x) + q[8 * d8 + 2] * bflo(w.y) + q[8 * d8 + 3] * bfhi(w.y) + q[8 * d8 + 4] * bflo(w.z) + q[8 * d8 + 5] * bfhi(w.z) + q[8 * d8 + 6] * bflo(w.w) + q[8 * d8 + 7] * bfhi(w.w); }
        s += slope2 * (float)(kv - row);
        if (kv <= row) {
            if (s > m) { const float al = exp2f(m - s); l *= al;
#pragma unroll
                for (int i = 0; i < 64; ++i) o[i] *= al;
                m = s; }
            const float p = exp2f(s - m); l += p;
            const bf16* vr = vbase + (size_t)kv * NP;
#pragma unroll
            for (int d8 = 0; d8 < 8; ++d8) { const v4u w = *(const v4u*)(vr + 8 * d8);
                o[8 * d8 + 0] += p * bflo(w.x); o[8 * d8 + 1] += p * bfhi(w.x); o[8 * d8 + 2] += p * bflo(w.y); o[8 * d8 + 3] += p * bfhi(w.y); o[8 * d8 + 4] += p * bflo(w.z); o[8 * d8 + 5] += p * bfhi(w.z); o[8 * d8 + 6] += p * bflo(w.w); o[8 * d8 + 7] += p * bfhi(w.w); }
        }
    }
    const float inv = 1.f / l;
    LAS float* ssx = xch + 128 * 128;
    if (mp == 1) {
#pragma unroll
        for (int i = 0; i < 64; ++i) xch[(dvh * 64 + i) * 128 + rloc] = o[i] * inv; }
    __syncthreads();
    if (mp == 0) {
        float ss = 0.f;
#pragma unroll
        for (int i = 0; i < 64; ++i) { o[i] = o[i] * inv - lam * xch[(dvh * 64 + i) * 128 + rloc]; ss += o[i] * o[i]; }
        ssx[dvh * 128 + rloc] = ss;
    }
    __syncthreads();
    if (mp == 0) {
        const float rstd = subscale / sqrtf((ssx[rloc] + ssx[128 + rloc]) * (1.f / 128.f) + EPS);
        bf16* orow = CAT + (size_t)(b * T + row) * D + h * 128 + dvh * 64; const float* gs = gsub + dvh * 64;
#pragma unroll
        for (int d8 = 0; d8 < 8; ++d8) { v4u w; w.x = pk2(o[8 * d8 + 0] * rstd * gs[8 * d8 + 0], o[8 * d8 + 1] * rstd * gs[8 * d8 + 1]); w.y = pk2(o[8 * d8 + 2] * rstd * gs[8 * d8 + 2], o[8 * d8 + 3] * rstd * gs[8 * d8 + 3]);
            w.z = pk2(o[8 * d8 + 4] * rstd * gs[8 * d8 + 4], o[8 * d8 + 5] * rstd * gs[8 * d8 + 5]); w.w = pk2(o[8 * d8 + 6] * rstd * gs[8 * d8 + 6], o[8 * d8 + 7] * rstd * gs[8 * d8 + 7]);
            *(GAS v4u*)(orow + 8 * d8) = w; }
    }
    __syncthreads();
}
__device__ __forceinline__ void gla_naive_unit(const bf16* P, bf16* CAT, int b, int h, float ogs, const float* gn, LAS float* lf, int tid) {
    const int e = tid & 255, dh = tid >> 8, wave = tid >> 6, lane = tid & 63;
    LAS float* sa = lf; LAS float* sk = lf + 2048; LAS float* sq = lf + 4096; LAS float* op = lf + 6144; LAS float* wss = lf + 6144 + 8192; LAS float* sv = lf + 6144 + 8192 + 64;
    float S[64];
#pragma unroll
    for (int i = 0; i < 64; ++i) S[i] = 0.f;
    const float gne = gn[e] * ogs;
    for (int t0 = 0; t0 < T; t0 += 16) {
        const bf16* pr0 = P + (size_t)(b * T + t0) * NP;
#pragma unroll
        for (int i = 0; i < 4; ++i) { const int idx = tid + 512 * i, tt = idx >> 7, d = idx & 127; const bf16* pr = pr0 + (size_t)tt * NP;
            sa[idx] = exp2f(LOG2E * bf2f(pr[6144 + h * 128 + d])); sk[idx] = bf2f(pr[3584 + h * 128 + d]); sq[idx] = bf2f(pr[3072 + h * 128 + d]); }
#pragma unroll
        for (int i = 0; i < 8; ++i) { const int tt = 2 * i + dh; sv[tt * 256 + e] = bf2f(pr0[(size_t)tt * NP + 4096 + h * 256 + e]); }
        __syncthreads();
#pragma unroll 1
        for (int tt = 0; tt < 16; ++tt) { float acc = 0.f; const float vv = sv[tt * 256 + e];
#pragma unroll
            for (int d4 = 0; d4 < 16; ++d4) { const f32x4 a4 = *(const LAS f32x4*)(sa + tt * 128 + 64 * dh + 4 * d4), k4 = *(const LAS f32x4*)(sk + tt * 128 + 64 * dh + 4 * d4), q4 = *(const LAS f32x4*)(sq + tt * 128 + 64 * dh + 4 * d4);
#pragma unroll
                for (int c = 0; c < 4; ++c) { S[4 * d4 + c] = a4[c] * S[4 * d4 + c] + k4[c] * vv; acc += q4[c] * S[4 * d4 + c]; } }
            op[(dh * 16 + tt) * 256 + e] = acc; }
        __syncthreads();
        if (dh == 0) {
#pragma unroll 1
            for (int tt = 0; tt < 16; ++tt) { const float o = op[tt * 256 + e] + op[(16 + tt) * 256 + e]; const float s2 = wave_sum(o * o); if (lane == 0) wss[wave * 16 + tt] = s2; } }
        __syncthreads();
        if (dh == 0) {
#pragma unroll 1
            for (int tt = 0; tt < 16; ++tt) { const float o = op[tt * 256 + e] + op[(16 + tt) * 256 + e];
                const float tot = (wss[tt] + wss[16 + tt]) + (wss[32 + tt] + wss[48 + tt]); const float rstd = 1.f / sqrtf(tot * (1.f / 256.f) + EPS);
                const float gate = bf2f(pr0[(size_t)tt * NP + 5120 + h * 256 + e]);
                CAT[(size_t)(b * T + t0 + tt) * D + 1024 + h * 256 + e] = (bf16)f2bf(o * rstd * gne * gate); } }
    }
    __syncthreads();
}

typedef short bf16x8v __attribute__((ext_vector_type(8)));
typedef short s16x4v __attribute__((ext_vector_type(4)));
typedef float f32x16 __attribute__((ext_vector_type(16)));
__device__ __forceinline__ int crow16(int r, int hh) { return (r & 3) + 8 * (r >> 2) + 4 * hh; }
__device__ __forceinline__ s16x4v tr_rd(const LAS unsigned char* p) { return __builtin_bit_cast(s16x4v, __builtin_amdgcn_ds_read_tr16_b64_v4i16((LAS s16x4v*)p)); }
__device__ __forceinline__ void half_swap(float& a, float& b) { asm volatile("s_nop 1\n\tv_permlane32_swap_b32_e32 %0, %1\n\ts_nop 1" : "+v"(a), "+v"(b)); }
__device__ __forceinline__ float half_sum(float v) { float a = v, b = v; half_swap(a, b); return a + b; }
__device__ __forceinline__ float half_max(float v) { float a = v, b = v; half_swap(a, b); return __builtin_fmaxf(a, b); }
__device__ __forceinline__ unsigned cvtpk(float lo, float hi) { unsigned r; asm volatile("v_cvt_pk_bf16_f32 %0, %1, %2" : "=v"(r) : "v"(lo), "v"(hi)); return r; }
__device__ __forceinline__ bf16x8v pack8(const f32x16& p, int s) {
    v4u w; w.x = cvtpk(p[8 * s + 0], p[8 * s + 1]); w.y = cvtpk(p[8 * s + 2], p[8 * s + 3]); w.z = cvtpk(p[8 * s + 4], p[8 * s + 5]); w.w = cvtpk(p[8 * s + 6], p[8 * s + 7]);
    return __builtin_bit_cast(bf16x8v, w);
}
__device__ __forceinline__ float max3f(float a, float b, float c) { float r; asm("v_max3_f32 %0, %1, %2, %3" : "=v"(r) : "v"(a), "v"(b), "v"(c)); return r; }
__device__ __forceinline__ float max2f(float a, float b) { float r; asm("v_max_f32_e32 %0, %1, %2" : "=v"(r) : "v"(a), "v"(b)); return r; }
__device__ __forceinline__ float fadd_s(float a, float b) { float r; asm("v_add_f32_e32 %0, %1, %2" : "=v"(r) : "v"(a), "v"(b)); return r; }
__device__ __forceinline__ float fmul_s(float a, float b) { float r; asm("v_mul_f32_e32 %0, %1, %2" : "=v"(r) : "v"(a), "v"(b)); return r; }
__device__ __forceinline__ float fsub_s(float a, float b) { float r; asm("v_sub_f32_e32 %0, %1, %2" : "=v"(r) : "v"(a), "v"(b)); return r; }
#define AT_FMAMK(dst, s, KHEX, add) asm("v_fmamk_f32 %0, %1, " KHEX ", %2" : "=v"(dst) : "v"(s), "v"(add))
constexpr int AT_KP = 272, AT_VP = 320, AT_KBYTES = 64 * AT_KP, AT_STAGE = AT_KBYTES + 64 * AT_VP;
constexpr float AT_THR = 6.f;
#ifndef AT_GATE_V
#define AT_GATE_V 24.f
#endif
constexpr float AT_GATE = AT_GATE_V;

__device__ __forceinline__ void attn_unit(const bf16* P, const float* NRM, bf16* CAT, int b, int h, int qb, float lam, float subscale, const float* gsub, LAS unsigned char* lds, int tid, gu32* qctr, unsigned& nxt) {
    asm volatile("" : "+v"(tid));
    const int lane = tid & 63, wave = __builtin_amdgcn_readfirstlane(tid >> 6), mp = wave >> 2, wq = wave & 3, r32 = lane & 31, hh = lane >> 5;
    const int q0 = 128 * qb, NT = 2 * qb + 2, qg = q0 + 32 * wq + r32;
    const float slope2 = exp2f(-(float)(h + 1)) * LOG2E;
    const bf16* qrow = P + (size_t)(b * T + qg) * NP + h * 128 + mp * 64 + 8 * hh;
    bf16x8v qf[4];
#pragma unroll
    for (int ds = 0; ds < 4; ++ds) qf[ds] = *(const bf16x8v*)(qrow + 16 * ds);
    const int srow = tid >> 3, sseg = tid & 7;
    const bf16* gk = P + (size_t)(b * T + srow) * NP + 1024 + h * 128 + sseg * 16;
    LAS unsigned char* kdst = lds + srow * AT_KP + sseg * 32; LAS unsigned char* vdst = lds + AT_KBYTES + srow * AT_VP + sseg * 32;
    f32x16 O[4]; float m_ref, l; v4u sa[4], sb_[4];
    { const bf16* g0_ = gk + (size_t)(NT - 1) * 64 * NP; sa[0] = *(const v4u*)g0_; sa[1] = *(const v4u*)(g0_ + 8); sa[2] = *(const v4u*)(g0_ + 1024); sa[3] = *(const v4u*)(g0_ + 1032);
      const bf16* g1_ = gk + (size_t)(NT - 2) * 64 * NP; sb_[0] = *(const v4u*)g1_; sb_[1] = *(const v4u*)(g1_ + 8); sb_[2] = *(const v4u*)(g1_ + 1024); sb_[3] = *(const v4u*)(g1_ + 1032); }
    int t_min;
    {
        LAS float* nl = (LAS float*)(lds + 3 * AT_STAGE);
        const int tt = tid >> 4, g = tid & 15;
        float gsv = (tid < 128) ? gsub[tid] : 0.f, v = (tt < NT) ? NRM[(size_t)(b * 32 + tt) * 256 + 128 + 16 * h + g] : 0.f, w = (tid < 32) ? NRM[(size_t)(b * 32 + 2 * qb + tt) * 256 + 16 * h + g] : 0.f;
        asm volatile("" : "+v"(gsv), "+v"(v), "+v"(w));
        if (tid < 128) ((LAS float*)(lds + 3 * AT_STAGE + 512))[tid] = gsv;
        v += DPPF(v, 0xB1); v += DPPF(v, 0x4E); v += DPPF(v, 0x141);
        if ((g & 7) == 0) nl[(g >> 3) * 32 + tt] = sqrtf(v);
        w += DPPF(w, 0xB1); w += DPPF(w, 0x4E); w += DPPF(w, 0x141);
        if (tid < 32 && (g & 7) == 0) nl[64 + (g >> 3) * 2 + tt] = sqrtf(w);
        *(LAS v4u*)kdst = sa[0]; *(LAS v4u*)(kdst + 16) = sa[1]; *(LAS v4u*)vdst = sa[2]; *(LAS v4u*)(vdst + 16) = sa[3];
        __syncthreads();
        const float qn0 = __builtin_fmaxf(nl[64], nl[65]), qn1 = __builtin_fmaxf(nl[66], nl[67]);
        const float L0 = -qn0 * __builtin_fmaxf(nl[NT - 2], nl[NT - 1]) - 40.f, L1 = -qn1 * __builtin_fmaxf(nl[32 + NT - 2], nl[32 + NT - 1]) - 40.f;
        const int tl = lane & 31; const float bias = slope2 * (float)(64 * tl + 63 - q0);
        const bool skip = (tl < NT - 2) && (qn0 * nl[tl] + bias < L0) && (qn1 * nl[32 + tl] + bias < L1);
        const unsigned sm = (unsigned)__ballot(skip);
        t_min = __builtin_amdgcn_readfirstlane(__builtin_ctz(~sm | 0x80000000u));
    }
#pragma unroll
    for (int d = 0; d < 4; ++d)
#pragma unroll
        for (int r = 0; r < 16; ++r) O[d][r] = 0.f;
    m_ref = slope2 * (float)(64 * (NT - 1) - q0) - 64.f; l = 0.f;
    const float qnw = ((const LAS float*)(lds + 3 * AT_STAGE))[64 + 2 * mp + (wq >> 1)];
    const LAS unsigned char* kbase = lds + r32 * AT_KP + mp * 128 + hh * 16;
    const int g4 = lane >> 4, i16 = lane & 15;
    const LAS unsigned char* vbase = lds + AT_KBYTES + (4 * (g4 >> 1) + (i16 >> 2)) * AT_VP + (16 * (g4 & 1) + 4 * (i16 & 3)) * 2;
    asm volatile("" :: "v"(qf[0]), "v"(qf[1]), "v"(qf[2]), "v"(qf[3]));
    bf16x8v pb[4];
    bool act_prev = false; int so_prev = 0, so_cur = 0;
#ifndef AT_NOSETPRIO
#define AT_PRIO(x) __builtin_amdgcn_s_setprio(x)
#else
#define AT_PRIO(x) do { } while (0)
#endif
#define AT_VLOAD(DST, SO, G) do { const LAS unsigned char* vp_ = vbase + (SO) + (32 * ((G) >> 1) + 16 * ((G) & 1)) * AT_VP; \
            _Pragma("unroll") for (int d = 0; d < 4; ++d) { const s16x4v lo = tr_rd(vp_ + d * 64), hi = tr_rd(vp_ + 8 * AT_VP + d * 64); \
                DST[d] = (bf16x8v){lo[0], lo[1], lo[2], lo[3], hi[0], hi[1], hi[2], hi[3]}; } } while (0)
#define AT_PV(SO) do { bf16x8v va_[2][4]; AT_VLOAD(va_[0], SO, 0); \
            _Pragma("unroll") for (int g = 0; g < 4; ++g) { if (g < 3) AT_VLOAD(va_[(g + 1) & 1], SO, g + 1); \
                __builtin_amdgcn_sched_barrier(0); AT_PRIO(1); \
                _Pragma("unroll") for (int d = 0; d < 4; ++d) O[d] = __builtin_amdgcn_mfma_f32_32x32x16_bf16(va_[g & 1][d], pb[g], O[d], 0, 0, 0); \
                AT_PRIO(0); __builtin_amdgcn_sched_barrier(0); } } while (0)
    auto body = [&](const int t, v4u (&ld)[4], v4u (&sv)[4]) __attribute__((always_inline)) {
        const int so_next = (so_cur == 2 * AT_STAGE) ? 0 : so_cur + AT_STAGE;
        { const bf16* gn = gk + (size_t)((t - 2 > 0) ? t - 2 : 0) * 64 * NP; ld[0] = *(const v4u*)gn; ld[1] = *(const v4u*)(gn + 8); ld[2] = *(const v4u*)(gn + 1024); ld[3] = *(const v4u*)(gn + 1032); }
#ifdef AT_DUP_PV
        if (mp == 1 && act_prev) { bf16x8v pbs_[4]; _Pragma("unroll") for (int g = 0; g < 4; ++g) { pbs_[g] = pb[g]; pb[g] = (bf16x8v){0, 0, 0, 0, 0, 0, 0, 0}; asm volatile("" : "+v"(pb[g])); } AT_PV(so_prev); _Pragma("unroll") for (int g = 0; g < 4; ++g) pb[g] = pbs_[g]; }
#endif
        if (mp == 1 && act_prev) AT_PV(so_prev);
        const bool act = (t >= t_min) && (64 * t <= q0 + 32 * wq + 31);
        if (act) {
            const int so = so_cur;
            f32x16 p0, p1;
            const float tb = slope2 * (float)(64 * t - q0 + 4 * hh) - m_ref, tb1 = tb + 32.f * slope2;
#ifdef AT_DUP_QK
            { bf16x8v kf[2][4];
#pragma unroll
            for (int ds = 0; ds < 4; ++ds) { kf[0][ds] = *(const LAS bf16x8v*)(kbase + so + ds * 32); kf[1][ds] = *(const LAS bf16x8v*)(kbase + so + 32 * AT_KP + ds * 32); }
            __builtin_amdgcn_sched_barrier(0);
#pragma unroll
            for (int r = 0; r < 16; ++r) { p0[r] = slope2 * (float)((r & 3) + 8 * (r >> 2)) + tb; p1[r] = slope2 * (float)((r & 3) + 8 * (r >> 2)) + tb1; }
            __builtin_amdgcn_sched_barrier(0);
#pragma unroll
            for (int ds = 0; ds < 4; ++ds) {
                p0 = __builtin_amdgcn_mfma_f32_32x32x16_bf16(kf[0][ds], qf[ds], p0, 0, 0, 0);
                p1 = __builtin_amdgcn_mfma_f32_32x32x16_bf16(kf[1][ds], qf[ds], p1, 0, 0, 0);
            }
            asm volatile("" :: "v"(p0), "v"(p1) : "memory");
            __builtin_amdgcn_sched_barrier(0); }
#endif
            bf16x8v kf[2][4];
#pragma unroll
            for (int ds = 0; ds < 4; ++ds) { kf[0][ds] = *(const LAS bf16x8v*)(kbase + so + ds * 32); kf[1][ds] = *(const LAS bf16x8v*)(kbase + so + 32 * AT_KP + ds * 32); }
            __builtin_amdgcn_sched_barrier(0);
#define AT_PI(r, KHEX) AT_FMAMK(p0[r], slope2, KHEX, tb); AT_FMAMK(p1[r], slope2, KHEX, tb1)
            AT_PI(0, "0x0"); AT_PI(1, "0x3f800000"); AT_PI(2, "0x40000000"); AT_PI(3, "0x40400000"); AT_PI(4, "0x41000000"); AT_PI(5, "0x41100000"); AT_PI(6, "0x41200000"); AT_PI(7, "0x41300000");
            AT_PI(8, "0x41800000"); AT_PI(9, "0x41880000"); AT_PI(10, "0x41900000"); AT_PI(11, "0x41980000"); AT_PI(12, "0x41c00000"); AT_PI(13, "0x41c80000"); AT_PI(14, "0x41d00000"); AT_PI(15, "0x41d80000");
#undef AT_PI
            __builtin_amdgcn_sched_barrier(0); asm volatile("s_nop 1" : "+v"(p0), "+v"(p1)); AT_PRIO(1);
#pragma unroll
            for (int ds = 0; ds < 4; ++ds) {
                p0 = __builtin_amdgcn_mfma_f32_32x32x16_bf16(kf[0][ds], qf[ds], p0, 0, 0, 0);
                p1 = __builtin_amdgcn_mfma_f32_32x32x16_bf16(kf[1][ds], qf[ds], p1, 0, 0, 0);
            }
            AT_PRIO(0); __builtin_amdgcn_sched_barrier(0);
            asm volatile("s_nop 11" : "+v"(p0), "+v"(p1));
            __builtin_amdgcn_sched_barrier(0);
            if (t >= NT - 2) {
#pragma unroll
                for (int r = 0; r < 16; ++r) { const int kvg = 64 * t + crow16(r, hh); if (kvg > qg) p0[r] = -1e30f; if (kvg + 32 > qg) p1[r] = -1e30f; }
            }
            const float ubt = qnw * ((const LAS float*)(lds + 3 * AT_STAGE))[32 * mp + t] + slope2 * (float)(((64 * t + 63 < q0 + 32 * wq + 31) ? 64 * t + 63 : q0 + 32 * wq + 31) - q0);
            if (__any(ubt - m_ref > AT_GATE)) {
            float rm;
            { float mx[4];
#pragma unroll
              for (int c = 0; c < 4; ++c) mx[c] = max3f(p0[4 * c], p0[4 * c + 1], p0[4 * c + 2]);
#pragma unroll
              for (int c = 0; c < 4; ++c) mx[c] = max3f(mx[c], p0[4 * c + 3], p1[4 * c]);
#pragma unroll
              for (int c = 0; c < 4; ++c) mx[c] = max3f(mx[c], p1[4 * c + 1], p1[4 * c + 2]);
#pragma unroll
              for (int c = 0; c < 4; ++c) mx[c] = max2f(mx[c], p1[4 * c + 3]);
              float x = max2f(max3f(mx[0], mx[1], mx[2]), mx[3]), y = x; half_swap(x, y); rm = max2f(x, y); }
            if (__any(rm > AT_THR)) {
                const float mn = max2f(rm, 0.f); float al = __builtin_amdgcn_exp2f(-mn);
                asm volatile("s_nop 0" : "+v"(al));
                asm volatile("s_nop 11" : "+v"(O[0]), "+v"(O[1]), "+v"(O[2]), "+v"(O[3]));
                l = fmul_s(l, al); m_ref = fadd_s(m_ref, mn);
#pragma unroll
                for (int d = 0; d < 4; ++d)
#pragma unroll
                    for (int r = 0; r < 16; ++r) O[d][r] = fmul_s(O[d][r], al);
#pragma unroll
                for (int r = 0; r < 16; ++r) { p0[r] = fsub_s(p0[r], mn); p1[r] = fsub_s(p1[r], mn); }
            }
            }
#pragma unroll
            for (int r = 0; r < 16; ++r) { p0[r] = __builtin_amdgcn_exp2f(p0[r]); p1[r] = __builtin_amdgcn_exp2f(p1[r]); }
            asm volatile("s_nop 0" : "+v"(p0), "+v"(p1));
            __builtin_amdgcn_sched_barrier(0);
            { float sm[4] = {p0[0], p0[1], p1[0], p1[1]};
#pragma unroll
              for (int r = 2; r < 16; r += 2) { sm[0] = fadd_s(sm[0], p0[r]); sm[1] = fadd_s(sm[1], p0[r + 1]); sm[2] = fadd_s(sm[2], p1[r]); sm[3] = fadd_s(sm[3], p1[r + 1]); }
              sm[0] = fadd_s(sm[0], sm[1]); sm[2] = fadd_s(sm[2], sm[3]); l = fadd_s(l, fadd_s(sm[0], sm[2])); }
            pb[0] = pack8(p0, 0); pb[1] = pack8(p0, 1); pb[2] = pack8(p1, 0); pb[3] = pack8(p1, 1);
#ifdef AT_DUP_PV
            if (mp == 0) { bf16x8v pbs_[4]; _Pragma("unroll") for (int g = 0; g < 4; ++g) { pbs_[g] = pb[g]; pb[g] = (bf16x8v){0, 0, 0, 0, 0, 0, 0, 0}; asm volatile("" : "+v"(pb[g])); } AT_PV(so); _Pragma("unroll") for (int g = 0; g < 4; ++g) pb[g] = pbs_[g]; }
#endif
            if (mp == 0) AT_PV(so);
        }
        act_prev = act; so_prev = so_cur;
        if (t - 1 >= t_min) { *(LAS v4u*)(kdst + so_next) = sv[0]; *(LAS v4u*)(kdst + so_next + 16) = sv[1]; *(LAS v4u*)(vdst + so_next) = sv[2]; *(LAS v4u*)(vdst + so_next + 16) = sv[3]; }
#ifdef AT_DUP_BAR_UNUSED
        __syncthreads();
        if (t + 1 < NT) { asm volatile("" ::: "memory"); *(LAS v4u*)(kdst + so_next) = sv[0]; *(LAS v4u*)(kdst + so_next + 16) = sv[1]; *(LAS v4u*)(vdst + so_next) = sv[2]; *(LAS v4u*)(vdst + so_next + 16) = sv[3]; }
#endif
        so_cur = so_next;
        __syncthreads();
    };
    for (int t = NT - 1; t >= t_min - 1; t -= 2) {
        body(t, sa, sb_);
        if (t - 1 >= t_min - 1) body(t - 1, sb_, sa);
    }
#undef AT_PV
#undef AT_VLOAD
    if (tid == 0) nxt = __hip_atomic_fetch_add(qctr, 1u, RLX_AGENT);
    l = half_sum(l);
    const float inv = 1.f / l;
    LAS float* xch = (LAS float*)lds;
    if (mp == 1) {
#pragma unroll
        for (int d = 0; d < 4; ++d)
#pragma unroll
            for (int r = 0; r < 16; ++r) xch[((wq * 64 + d * 16 + r) * 64) + lane] = O[d][r] * inv; }
    __syncthreads();
    if (mp == 0) {
        float ss = 0.f;
#pragma unroll
        for (int d = 0; d < 4; ++d)
#pragma unroll
            for (int r = 0; r < 16; ++r) { const float o = O[d][r] * inv - lam * xch[((wq * 64 + d * 16 + r) * 64) + lane]; O[d][r] = o; ss += o * o; }
        ss = half_sum(ss);
        const float rstd = subscale / sqrtf(ss * (1.f / 128.f) + EPS);
        bf16* orow = CAT + (size_t)(b * T + qg) * D + h * 128;
#pragma unroll
        for (int d = 0; d < 4; ++d)
#pragma unroll
            for (int ip = 0; ip < 2; ++ip) {
                unsigned ev[2], od[2];
#pragma unroll
                for (int par = 0; par < 2; ++par) { const int i = 2 * ip + par; const int dv0 = 32 * d + 8 * i + 4 * hh; const f32x4 gg = *(const LAS f32x4*)((const LAS float*)(lds + 3 * AT_STAGE + 512) + dv0);
                    const unsigned lo = pk2(O[d][4 * i + 0] * rstd * gg.x, O[d][4 * i + 1] * rstd * gg.y), hi2 = pk2(O[d][4 * i + 2] * rstd * gg.z, O[d][4 * i + 3] * rstd * gg.w);
                    if (par == 0) { ev[0] = lo; ev[1] = hi2; } else { od[0] = lo; od[1] = hi2; } }
                asm volatile("s_nop 1\n\tv_permlane32_swap_b32_e32 %0, %1\n\tv_permlane32_swap_b32_e32 %2, %3\n\ts_nop 1" : "+v"(ev[0]), "+v"(od[0]), "+v"(ev[1]), "+v"(od[1]));
                v4u w; w.x = ev[0]; w.y = ev[1]; w.z = od[0]; w.w = od[1];
                *(GAS v4u*)(orow + 32 * d + 8 * (2 * ip + hh)) = w;
            }
    }
    __syncthreads();
}

constexpr int GL_QT = 0, GL_KT = 24576, GL_KH = 49152, GL_V = 67584, GL_A = 104448, GL_SEG = 113664, GL_BL = 115712, GL_SS = 116224, GL_OT = 0;
constexpr int GL_QP = 192, GL_KHP = 144, GL_VP = 576, GL_AP = 144, GL_OP = 144;
static_assert(GL_SS + 2048 + 1024 <= RING_BYTES && GL_KH + 128 * GL_KHP == GL_V && GL_V + 64 * GL_VP == GL_A && GL_A + 64 * GL_AP == GL_SEG, "GLA LDS map");

__device__ __forceinline__ void gla_unit(const bf16* P, bf16* CAT, int b, int h, const float* gn, LAS unsigned char* lds, int tid, gu32* qctr, unsigned& nxt) {
    asm volatile("" : "+v"(tid));
    const int lane = tid & 63, wave = __builtin_amdgcn_readfirstlane(tid >> 6), r32 = lane & 31, hh = lane >> 5, g4 = lane >> 4, i16 = lane & 15;
    const int dk = tid & 127, jg = __builtin_amdgcn_readfirstlane(tid >> 7);
    const int vrow = tid >> 3, vseg = tid & 7;
    f32x16 S[4];
#pragma unroll
    for (int d = 0; d < 4; ++d)
#pragma unroll
        for (int r = 0; r < 16; ++r) S[d][r] = 0.f;
    const int trr = i16 >> 2, trc = 16 * (g4 & 1) + 4 * (i16 & 3);
    LAS float* seg = (LAS float*)(lds + GL_SEG); LAS float* ebl = (LAS float*)(lds + GL_BL); LAS float* ssp = (LAS float*)(lds + GL_SS);
    LAS float* gnl = (LAS float*)(lds + GL_SS + 2048);
    if (tid < 256) gnl[tid] = gn[tid];
    unsigned la_p[8], q_p[8], k_p[8]; v4u raw[6], v_r[4];
    const int srow = tid >> 3, sseg = tid & 7;
#define GL_LOADS(RB) do { const bf16* pr_ = (RB) + (size_t)srow * NP + h * 128 + sseg * 16; \
        raw[0] = *(const v4u*)(pr_ + 6144); raw[1] = *(const v4u*)(pr_ + 6144 + 8); raw[2] = *(const v4u*)(pr_ + 3072); raw[3] = *(const v4u*)(pr_ + 3072 + 8); raw[4] = *(const v4u*)(pr_ + 3584); raw[5] = *(const v4u*)(pr_ + 3584 + 8); \
        const bf16* pv_ = (RB) + (size_t)vrow * NP + 4096 + h * 256 + vseg * 32; v_r[0] = *(const v4u*)pv_; v_r[1] = *(const v4u*)(pv_ + 8); v_r[2] = *(const v4u*)(pv_ + 16); v_r[3] = *(const v4u*)(pv_ + 24); } while (0)
#define GL_STAGE() do { LAS unsigned char* sd_ = lds + GL_KH + srow * 256 + sseg * 32; \
        *(LAS v4u*)sd_ = raw[0]; *(LAS v4u*)(sd_ + 16) = raw[1]; *(LAS v4u*)(sd_ + 16384) = raw[2]; *(LAS v4u*)(sd_ + 16384 + 16) = raw[3]; *(LAS v4u*)(sd_ + 32768) = raw[4]; *(LAS v4u*)(sd_ + 32768 + 16) = raw[5]; } while (0)
#define GL_COLS() do { const LAS unsigned short* sc_ = (const LAS unsigned short*)(lds + GL_KH) + (16 * jg) * 128 + dk; unsigned short t0_[16], t1_[16], t2_[16]; \
        _Pragma("unroll") for (int j = 0; j < 16; ++j) { t0_[j] = sc_[j * 128]; t1_[j] = sc_[8192 + j * 128]; t2_[j] = sc_[16384 + j * 128]; } \
        __builtin_amdgcn_sched_barrier(0);     \
        _Pragma("unroll") for (int j2 = 0; j2 < 8; ++j2) { la_p[j2] = (unsigned)t0_[2 * j2] | ((unsigned)t0_[2 * j2 + 1] << 16); \
            q_p[j2] = (unsigned)t1_[2 * j2] | ((unsigned)t1_[2 * j2 + 1] << 16); k_p[j2] = (unsigned)t2_[2 * j2] | ((unsigned)t2_[2 * j2 + 1] << 16); } } while (0)
    static_assert(GL_KH + 3 * 16384 <= GL_SEG, "GLA staging images inside the k^ | v | A regions");
    GL_LOADS(P + (size_t)(b * T) * NP);
    GL_STAGE();
    __syncthreads();
    GL_COLS();
    __syncthreads();
#ifdef DBG_GLA_PH
    unsigned long long gst[8] = {0,0,0,0,0,0,0,0}; unsigned long long gt_ = __builtin_amdgcn_s_memrealtime();
#define GST(k) do { const unsigned long long n_ = __builtin_amdgcn_s_memrealtime(); gst[k] += n_ - gt_; gt_ = n_; } while (0)
#else
#define GST(k) do { } while (0)
#endif
    for (int c = 0; c < T / 64; ++c) {
        const bf16* rowbase = P + (size_t)(b * T + 64 * c) * NP;
        if (c == T / 64 - 1 && tid == 0) nxt = __hip_atomic_fetch_add(qctr, 1u, RLX_AGENT);
        float la[16], qv[16], kv[16];
#pragma unroll
        for (int j2 = 0; j2 < 8; ++j2) { la[2 * j2] = bflo(la_p[j2]); la[2 * j2 + 1] = bfhi(la_p[j2]); qv[2 * j2] = bflo(q_p[j2]); qv[2 * j2 + 1] = bfhi(q_p[j2]); kv[2 * j2] = bflo(k_p[j2]); kv[2 * j2 + 1] = bfhi(k_p[j2]); }
        { LAS unsigned char* vd = lds + GL_V + vrow * GL_VP + vseg * 64; *(LAS v4u*)vd = v_r[0]; *(LAS v4u*)(vd + 16) = v_r[1]; *(LAS v4u*)(vd + 32) = v_r[2]; *(LAS v4u*)(vd + 48) = v_r[3]; }
#pragma unroll
        for (int jj = 1; jj < 16; ++jj) la[jj] += la[jj - 1];
        seg[jg * 128 + dk] = la[15];
        __syncthreads(); GST(0);
        { float pre = 0.f, tot = 0.f;
#pragma unroll
          for (int g = 0; g < 4; ++g) { const float sv = seg[g * 128 + dk]; tot += sv; if (g < jg) pre += sv; }
          const float eb_last = __builtin_amdgcn_exp2f(LOG2E * tot);
          float qt[16], kt[16], kh[16];
#pragma unroll
          for (int jj = 0; jj < 16; ++jj) { const float e = __builtin_amdgcn_exp2f(LOG2E * (pre + la[jj])), ri = __builtin_amdgcn_rcpf(e); qt[jj] = qv[jj] * e; kt[jj] = kv[jj] * ri; kh[jj] = kt[jj] * eb_last; }
          v4u w;
#define GL_PACK8(src, o) w.x = pk2(src[o + 0], src[o + 1]); w.y = pk2(src[o + 2], src[o + 3]); w.z = pk2(src[o + 4], src[o + 5]); w.w = pk2(src[o + 6], src[o + 7])
          GL_PACK8(qt, 0); *(LAS v4u*)(lds + GL_QT + dk * GL_QP + jg * 32) = w; GL_PACK8(qt, 8); *(LAS v4u*)(lds + GL_QT + dk * GL_QP + jg * 32 + 16) = w;
          GL_PACK8(kt, 0); *(LAS v4u*)(lds + GL_KT + dk * GL_QP + jg * 32) = w; GL_PACK8(kt, 8); *(LAS v4u*)(lds + GL_KT + dk * GL_QP + jg * 32 + 16) = w;
          GL_PACK8(kh, 0); *(LAS v4u*)(lds + GL_KH + dk * GL_KHP + jg * 32) = w; GL_PACK8(kh, 8); *(LAS v4u*)(lds + GL_KH + dk * GL_KHP + jg * 32 + 16) = w;
#undef GL_PACK8
          if (jg == 0) ebl[dk] = eb_last; }
        asm volatile("" ::: "memory");
        if (c + 1 < T / 64) { GL_LOADS(rowbase + (size_t)64 * NP); }
        __syncthreads(); GST(1);
        if (wave < 3) {
            const int jb = wave >> 1, ib = (wave + 1) >> 1;
            f32x16 at;
#pragma unroll
            for (int r = 0; r < 16; ++r) at[r] = 0.f;
            const LAS unsigned char* ka = lds + GL_KT + (8 * hh + trr) * GL_QP + (32 * jb + trc) * 2;
            const LAS unsigned char* qa = lds + GL_QT + (8 * hh + trr) * GL_QP + (32 * ib + trc) * 2;
            s16x4v fr_[2][4];
#define GL_G3LD(B, s) do { fr_[B][0] = tr_rd(ka + (s) * 16 * GL_QP); fr_[B][1] = tr_rd(ka + ((s) * 16 + 4) * GL_QP); fr_[B][2] = tr_rd(qa + (s) * 16 * GL_QP); fr_[B][3] = tr_rd(qa + ((s) * 16 + 4) * GL_QP); } while (0)
            GL_G3LD(0, 0);
#pragma unroll
            for (int s = 0; s < 8; ++s) {
                if (s < 7) GL_G3LD((s + 1) & 1, s + 1);
                __builtin_amdgcn_sched_barrier(0);
                const s16x4v k0 = fr_[s & 1][0], k1 = fr_[s & 1][1], q0 = fr_[s & 1][2], q1 = fr_[s & 1][3];
                const bf16x8v af = (bf16x8v){k0[0], k0[1], k0[2], k0[3], k1[0], k1[1], k1[2], k1[3]}, bfr = (bf16x8v){q0[0], q0[1], q0[2], q0[3], q1[0], q1[1], q1[2], q1[3]};
                at = __builtin_amdgcn_mfma_f32_32x32x16_bf16(af, bfr, at, 0, 0, 0);
                __builtin_amdgcn_sched_barrier(0);
            }
#undef GL_G3LD
            asm volatile("s_nop 11" : "+v"(at));
            if (jb == ib) {
#pragma unroll
                for (int r = 0; r < 16; ++r) if (crow16(r, hh) > r32) at[r] = 0.f; }
            LAS unsigned char* ad = lds + GL_A + (32 * ib + r32) * GL_AP + (32 * jb + 4 * hh) * 2;
#pragma unroll
            for (int g = 0; g < 4; ++g) { v2u w; w.x = pk2(at[4 * g + 0], at[4 * g + 1]); w.y = pk2(at[4 * g + 2], at[4 * g + 3]); *(LAS v2u*)(ad + 16 * g) = w; }
        }
        __syncthreads(); GST(2);
        f32x16 o[2];
        {
            bf16x8v vf[4];
            const LAS unsigned char* va = lds + GL_V + (8 * hh + trr) * GL_VP + (32 * wave + trc) * 2;
#pragma unroll
            for (int s = 0; s < 4; ++s) { const s16x4v a0 = tr_rd(va + s * 16 * GL_VP), a1 = tr_rd(va + (s * 16 + 4) * GL_VP); vf[s] = (bf16x8v){a0[0], a0[1], a0[2], a0[3], a1[0], a1[1], a1[2], a1[3]}; }
#pragma unroll
            for (int ib = 0; ib < 2; ++ib) {
#pragma unroll
                for (int r = 0; r < 16; ++r) o[ib][r] = 0.f;
                const LAS unsigned char* aa = lds + GL_A + (32 * ib + r32) * GL_AP + 16 * hh;
#pragma unroll
                for (int s = 0; s < 2 + 2 * ib; ++s) o[ib] = __builtin_amdgcn_mfma_f32_32x32x16_bf16(*(const LAS bf16x8v*)(aa + 32 * s), vf[s], o[ib], 0, 0, 0);
            }
            {
                s16x4v qq[2][4];
#define GL_ICLD(B, st) do { const LAS unsigned char* qa_ = lds + GL_QT + (16 * (st) + 4 * hh + trr) * GL_QP + trc * 2; \
                    qq[B][0] = tr_rd(qa_); qq[B][1] = tr_rd(qa_ + 8 * GL_QP); qq[B][2] = tr_rd(qa_ + 64); qq[B][3] = tr_rd(qa_ + 8 * GL_QP + 64); } while (0)
                GL_ICLD(0, 0);
#pragma unroll
                for (int st = 0; st < 8; ++st) {
                    if (st < 7) GL_ICLD((st + 1) & 1, st + 1);
                    const bf16x8v sb = pack8(S[st >> 1], st & 1);
                    __builtin_amdgcn_sched_barrier(0);
                    const s16x4v a0 = qq[st & 1][0], a1 = qq[st & 1][1], b0 = qq[st & 1][2], b1 = qq[st & 1][3];
                    o[0] = __builtin_amdgcn_mfma_f32_32x32x16_bf16((bf16x8v){a0[0], a0[1], a0[2], a0[3], a1[0], a1[1], a1[2], a1[3]}, sb, o[0], 0, 0, 0);
                    o[1] = __builtin_amdgcn_mfma_f32_32x32x16_bf16((bf16x8v){b0[0], b0[1], b0[2], b0[3], b1[0], b1[1], b1[2], b1[3]}, sb, o[1], 0, 0, 0);
                    __builtin_amdgcn_sched_barrier(0);
                }
#undef GL_ICLD
            }
            asm volatile("" ::: "memory");
#pragma unroll
            for (int s = 0; s < 4; ++s) { const s16x4v a0 = tr_rd(va + s * 16 * GL_VP), a1 = tr_rd(va + (s * 16 + 4) * GL_VP); vf[s] = (bf16x8v){a0[0], a0[1], a0[2], a0[3], a1[0], a1[1], a1[2], a1[3]}; }
#pragma unroll
            for (int d = 0; d < 4; ++d) {
                const LAS unsigned char* ha = lds + GL_KH + (32 * d + r32) * GL_KHP + 16 * hh;
                bf16x8v hf_[4];
#pragma unroll
                for (int s = 0; s < 4; ++s) hf_[s] = *(const LAS bf16x8v*)(ha + 32 * s);
#pragma unroll
                for (int g = 0; g < 4; ++g) { const f32x4 e4 = *(const LAS f32x4*)(ebl + 32 * d + 8 * g + 4 * hh); S[d][4 * g + 0] *= e4.x; S[d][4 * g + 1] *= e4.y; S[d][4 * g + 2] *= e4.z; S[d][4 * g + 3] *= e4.w; }
                __builtin_amdgcn_sched_barrier(0);
#pragma unroll
                for (int s = 0; s < 4; ++s) S[d] = __builtin_amdgcn_mfma_f32_32x32x16_bf16(hf_[s], vf[s], S[d], 0, 0, 0);
                __builtin_amdgcn_sched_barrier(0);
            }
        }
        __syncthreads(); GST(3);
        v4u gate_r[4];
        { const bf16* gp = rowbase + (size_t)lane * NP + 5120 + h * 256 + 32 * wave;
#pragma unroll
          for (int q4 = 0; q4 < 4; ++q4) gate_r[q4] = *(const v4u*)(gp + 8 * q4); }
        if (c + 1 < T / 64) GL_STAGE();
        { LAS unsigned char* od = lds + GL_OT + (32 * wave + r32) * GL_OP + 8 * hh;
#pragma unroll
          for (int ib = 0; ib < 2; ++ib)
#pragma unroll
              for (int g = 0; g < 4; ++g) { v2u w; w.x = pk2(o[ib][4 * g + 0], o[ib][4 * g + 1]); w.y = pk2(o[ib][4 * g + 2], o[ib][4 * g + 3]); *(LAS v2u*)(od + 64 * ib + 16 * g) = w; } }
        __syncthreads(); GST(4);
        if (c + 1 < T / 64) GL_COLS();
        { float ov[32]; float ss = 0.f;
          const LAS unsigned short* op = (const LAS unsigned short*)(lds + GL_OT + (32 * wave) * GL_OP) + lane;
#pragma unroll
          for (int e = 0; e < 0; ++e) {}
          unsigned short or_[32];
#pragma unroll
          for (int e = 0; e < 32; ++e) or_[e] = op[e * (GL_OP / 2)];
          __builtin_amdgcn_sched_barrier(0);
#pragma unroll
          for (int e = 0; e < 32; ++e) { ov[e] = bf2f(or_[e]); ss += ov[e] * ov[e]; }
          ssp[wave * 64 + lane] = ss;
          __syncthreads(); GST(5);
          float tot = 0.f;
#pragma unroll
          for (int w8 = 0; w8 < 8; ++w8) tot += ssp[w8 * 64 + lane];
          const float rstd = 1.f / sqrtf(tot * (1.f / 256.f) + EPS);
          bf16* cp = CAT + (size_t)(b * T + 64 * c + lane) * D + 1024 + h * 256 + 32 * wave;
#pragma unroll
          for (int q4 = 0; q4 < 4; ++q4) { const v4u gw = gate_r[q4]; v4u w; const f32x4 ga = *(const LAS f32x4*)(gnl + 32 * wave + 8 * q4), gb = *(const LAS f32x4*)(gnl + 32 * wave + 8 * q4 + 4);
              w.x = pk2(ov[8 * q4 + 0] * rstd * ga.x * bflo(gw.x), ov[8 * q4 + 1] * rstd * ga.y * bfhi(gw.x));
              w.y = pk2(ov[8 * q4 + 2] * rstd * ga.z * bflo(gw.y), ov[8 * q4 + 3] * rstd * ga.w * bfhi(gw.y));
              w.z = pk2(ov[8 * q4 + 4] * rstd * gb.x * bflo(gw.z), ov[8 * q4 + 5] * rstd * gb.y * bfhi(gw.z));
              w.w = pk2(ov[8 * q4 + 6] * rstd * gb.z * bflo(gw.w), ov[8 * q4 + 7] * rstd * gb.w * bfhi(gw.w));
              *(GAS v4u*)(cp + 8 * q4) = w; } }
        GST(6);
    }
#ifdef DBG_GLA_PH
    if (tid == 0) { float v_ = 10.f + floorf(4.f * log2f((float)gst[DBG_GLA_PH] + 1.f) + 0.5f); __hip_atomic_store(qctr + 7, __float_as_uint(v_), RLX_AGENT); }
#endif
#undef GL_LOADS
#undef GL_STAGE
#undef GL_COLS
    __syncthreads();
}

#ifdef DBG_CHECK
constexpr int CW_DBG = 32768;
__device__ __forceinline__ float dbg_dot(const bf16* arow, const float* w, int ldw, int K, int lane, bool roundw) {
    float s = 0.f;
    for (int k = lane; k < K; k += 64) { const float wv = w[(size_t)k * ldw]; s += bf2f(arow[k]) * (roundw ? bf2f((unsigned short)f2bf(wv)) : wv); }
    return wave_sum(s);
}
__device__ __forceinline__ void dbg_fail(gu32* ctl, int which, float got, float exp, float rtol, float atol) {
    if (!(__builtin_fabsf(got - exp) <= rtol * __builtin_fabsf(exp) + atol)) __hip_atomic_fetch_add(ctl + CW_DBG + which, 1u, RLX_AGENT);
}
__device__ __forceinline__ float dbg_logsig(float x) { return (x < 0.f ? x : 0.f) - log1pf(expf(-fabsf(x))); }
__global__ void __launch_bounds__(64) dbg_kernel(Args a, int which, int l) {
    const int lane = threadIdx.x; unsigned char* ws = a.ws; gu32* ctl = (gu32*)(ws + WS_CTL);
    const float* MOD = (const float*)(ws + WS_MOD); const bf16* HN = (const bf16*)(ws + WS_HN); const bf16* PROJ = (const bf16*)(ws + WS_PROJ); const bf16* CAT = HN; const bf16* ACT = PROJ;
    float* STASH = (float*)(ws + WS_SCAL) + 64;
    const int rows8[8] = {0, 1, 255, 256, 2047, 2048, 12345, 32767};
    if (which == 0) {
        const float t1 = wave_sum((float)(lane + 1)); dbg_fail(ctl, 0, t1, 2080.f, 0.f, 0.01f);
        { float v = (float)(lane + 1); v += DPPF(v, 0xB1); v += DPPF(v, 0x4E); v += DPPF(v, 0x141); v += DPPF(v, 0x140); const int r = lane >> 4; dbg_fail(ctl, 21, v, (float)(16 * (16 * r) + 136), 0.f, 0.01f); }
        { const float v = __builtin_bit_cast(float, __builtin_amdgcn_ds_swizzle(__builtin_bit_cast(int, (float)lane), 0x401F)); dbg_fail(ctl, 22, v, (float)(lane ^ 16), 0.f, 0.01f); }
        { float a_ = (float)lane, b_ = (float)lane; asm volatile("s_nop 1\n\tv_permlane32_swap_b32_e32 %0, %1\n\ts_nop 1" : "+v"(a_), "+v"(b_));
          dbg_fail(ctl, 23, a_ + b_, (float)((lane & 31) + (lane & 31) + 32), 0.f, 0.01f); dbg_fail(ctl, 25, a_, (float)(lane & 31), 0.f, 0.01f); }
        { const float v = __shfl_xor((float)lane, 16); dbg_fail(ctl, 24, v, (float)(lane ^ 16), 0.f, 0.01f); }
    } else if (which == 10) {
        const int bs[3] = {0, 7, 15}, js[5] = {0, 255, 256, 5000, 12287};
        for (int ll = 0; ll < 2; ++ll) for (int bi = 0; bi < 3; ++bi) for (int ji = 0; ji < 5; ++ji) { const int b = bs[bi], j = js[ji]; float s = 0.f;
            for (int k = lane; k < D; k += 64) { const float cv = a.in[1][b * D + k]; s += cv / (1.f + expf(-cv)) * a.in[2][((size_t)ll * D + k) * NMOD + j]; }
            s = wave_sum(s) + a.in[3][ll * NMOD + j];
            if (lane == 0) dbg_fail(ctl, 10, MOD[(size_t)(ll * 16 + b) * NMOD + j], s, 1e-3f, 1e-3f); }
    } else if (which == 1) {
        const float* xin = (l == 0) ? a.in[0] : a.out; const int cs[4] = {0, 5, 1000, 2047};
        for (int ri = 0; ri < 8; ++ri) { const int r = rows8[ri], b = r / T; float s = 0.f;
            for (int k = lane; k < D; k += 64) { const float v = xin[(size_t)r * D + k]; s += v * v; }
            const float rstd = 1.f / sqrtf(wave_sum(s) / D + EPS);
            for (int ci = 0; ci < 4; ++ci) { const int c = cs[ci]; const float* mb = MOD + (size_t)(l * 16 + b) * NMOD;
                const float e = xin[(size_t)r * D + c] * rstd * a.in[4][l * D + c] * (1.f + mb[D + c]) + mb[c];
                if (lane == 0) dbg_fail(ctl, 1, bf2f(HN[(size_t)r * D + c]), e, 0.01f, 0.01f); } }
    } else if (which == 2) {
        const int cs[10] = {5, 700, 1030, 2100, 3100, 3600, 4200, 5200, 1023, 6143};
        for (int ri = 0; ri < 8; ++ri) for (int ci = 0; ci < 10; ++ci) { const int r = rows8[ri], c = cs[ci];
            float e = dbg_dot(HN + (size_t)r * D, a.in[5] + (size_t)l * D * NIN + c, NIN, D, lane, true);
            if (c < 1024) e *= pg8::QSCALE; else if (c >= 3072 && c < 3584) e *= pg8::GQSCALE; else if (c >= 5120) e = e / (1.f + expf(-e));
            if (lane == 0) dbg_fail(ctl, 2, bf2f(PROJ[(size_t)r * NP + c]), e, 0.02f, 0.02f); }
    } else if (which == 3) {
        const int js[5] = {0, 6, 255, 256, 511};
        for (int ri = 0; ri < 8; ++ri) { const int r = rows8[ri]; float gl[16];
#pragma unroll
            for (int q = 0; q < 16; ++q) gl[q] = dbg_dot(HN + (size_t)r * D, a.in[5] + (size_t)l * D * NIN + 6144 + q, NIN, D, lane, false);
            for (int ji = 0; ji < 5; ++ji) { const int j = js[ji]; float xg = a.in[9][l * 512 + j];
#pragma unroll
                for (int q = 0; q < 16; ++q) xg += gl[q] * a.in[8][(size_t)l * 16 * 512 + q * 512 + j];
                if (lane == 0) dbg_fail(ctl, 3, bf2f(PROJ[(size_t)r * NP + 6144 + j]), dbg_logsig(xg) * 0.0625f, 0.05f, 1e-3f); } }
    } else if (which == 4) {
        const int bs[3] = {0, 5, 15}, ts[3] = {0, 77, 300}, hs[3] = {0, 3, 7};
        const float lam = ((const float*)(ws + WS_SCAL))[l], sub = 1.f - (l == 0 ? 0.2f : 0.35550906759096926f);
        for (int si = 0; si < 3; ++si) { const int b = bs[si], t = ts[si], h = hs[si]; const float slope = exp2f(-(float)(h + 1));
            float od0 = 0.f, od1 = 0.f;
            for (int mp = 0; mp < 2; ++mp) {
                const bf16* qrow = PROJ + (size_t)(b * T + t) * NP + h * 128 + mp * 64;
                const bf16* kb = PROJ + (size_t)(b * T) * NP + 1024 + h * 128 + mp * 64;
#define DBG_SCORE(kv) ({ const bf16* kr_ = kb + (size_t)(kv) * NP; float s_ = 0.f; for (int d = 0; d < 64; ++d) s_ += bf2f(qrow[d]) * bf2f(kr_[d]); s_ / 1.4426950408889634f - slope * (float)(t - (kv)); })
                float mx = -1e30f;
                for (int kv = lane; kv <= t; kv += 64) mx = fmaxf(mx, DBG_SCORE(kv));
                for (int o = 1; o < 64; o <<= 1) mx = fmaxf(mx, __shfl_xor(mx, o));
                float den = 0.f;
                for (int kv = lane; kv <= t; kv += 64) den += expf(DBG_SCORE(kv) - mx);
                den = wave_sum(den);
                for (int ch = 0; ch < 4; ++ch) {
                    float acc[32];
#pragma unroll
                    for (int i = 0; i < 32; ++i) acc[i] = 0.f;
                    for (int kv = lane; kv <= t; kv += 64) { const float p = expf(DBG_SCORE(kv) - mx); const bf16* vr = PROJ + (size_t)(b * T + kv) * NP + 2048 + h * 128 + ch * 32;
#pragma unroll
                        for (int i = 0; i < 32; ++i) acc[i] += p * bf2f(vr[i]); }
#pragma unroll
                    for (int i = 0; i < 32; ++i) { const float v = wave_sum(acc[i]) / den, cv = (mp == 0) ? v : -lam * v; const int idx = ch * 32 + i;
                        if (lane == (idx & 63)) { if (idx < 64) od0 += cv; else od1 += cv; } }
                }
#undef DBG_SCORE
            }
            const float rstd = sub / sqrtf(wave_sum(od0 * od0 + od1 * od1) / 128.f + EPS);
            dbg_fail(ctl, 4, bf2f(CAT[(size_t)(b * T + t) * D + h * 128 + lane]), od0 * rstd * a.in[7][l * 128 + lane], 0.03f, 0.02f);
            dbg_fail(ctl, 4, bf2f(CAT[(size_t)(b * T + t) * D + h * 128 + 64 + lane]), od1 * rstd * a.in[7][l * 128 + 64 + lane], 0.03f, 0.02f);
        }
    } else if (which == 5) {
        const int bs[3] = {0, 9, 15}, ts[3] = {0, 70, 200}, hs[3] = {0, 2, 3};
        for (int si = 0; si < 3; ++si) { const int b = bs[si], t = ts[si], h = hs[si];
            const bf16* qrow = PROJ + (size_t)(b * T + t) * NP + 3072 + h * 128; const float q0 = bf2f(qrow[lane]), q1 = bf2f(qrow[64 + lane]);
            float c0 = 0.f, c1 = 0.f, o[4] = {0.f, 0.f, 0.f, 0.f};
            for (int s = t; s >= 0; --s) { const bf16* pr = PROJ + (size_t)(b * T + s) * NP;
                const float w = wave_sum(q0 * bf2f(pr[3584 + h * 128 + lane]) * expf(c0) + q1 * bf2f(pr[3584 + h * 128 + 64 + lane]) * expf(c1));
#pragma unroll
                for (int i = 0; i < 4; ++i) o[i] += w * bf2f(pr[4096 + h * 256 + 4 * lane + i]);
                c0 += bf2f(pr[6144 + h * 128 + lane]); c1 += bf2f(pr[6144 + h * 128 + 64 + lane]); }
            const float rstd = 1.f / sqrtf(wave_sum(o[0] * o[0] + o[1] * o[1] + o[2] * o[2] + o[3] * o[3]) / 256.f + EPS);
#pragma unroll
            for (int i = 0; i < 4; ++i) { const int e = 4 * lane + i; const float gate = bf2f(PROJ[(size_t)(b * T + t) * NP + 5120 + h * 256 + e]);
                dbg_fail(ctl, 5, bf2f(CAT[(size_t)(b * T + t) * D + 1024 + h * 256 + e]), o[i] * rstd * a.in[10][l * 256 + e] * gate, 0.03f, 0.02f); }
        }
    } else if (which == 6) {
        const float* xin = (l == 0) ? a.in[0] : STASH + 256; const int cs[5] = {0, 1, 17, 300, 2047};
        for (int ri = 0; ri < 8; ++ri) for (int ci = 0; ci < 5; ++ci) { const int r = rows8[ri], c = cs[ci], b = r / T;
            const float d = dbg_dot(CAT + (size_t)r * D, a.in[11] + (size_t)l * D * D + c, D, D, lane, true);
            const float xo = (l == 0) ? xin[(size_t)r * D + c] : xin[ri * 8 + ci];
            if (lane == 0) dbg_fail(ctl, 6, a.out[(size_t)r * D + c], xo + MOD[(size_t)(l * 16 + b) * NMOD + 2 * D + c] * d, 0.01f, 0.01f); }
    } else if (which == 7) {
        const int pms[5] = {0, 1, 7, 8, 9}, lr[17] = {0, 1, 2, 15, 16, 17, 63, 64, 65, 127, 128, 129, 191, 192, 193, 254, 255}, cs[9] = {0, 3, 4, 9, 37, 100, 127, 133, 5631};
        const float* wu = a.in[13] + (size_t)l * D * NUP;
        for (int pi = 0; pi < 5; ++pi) for (int ri = 0; ri < 17; ++ri) for (int ci = 0; ci < 9; ++ci) { const int r = 256 * pms[pi] + lr[ri], c = cs[ci], t = r % T;
            const float u = dbg_dot(HN + (size_t)r * D, wu + c, NUP, D, lane, true), g0 = dbg_dot(HN + (size_t)r * D, wu + FF + c, NUP, D, lane, true);
            const float g1 = t >= 1 ? dbg_dot(HN + (size_t)(r - 1) * D, wu + FF + c, NUP, D, lane, true) : 0.f, g2 = t >= 2 ? dbg_dot(HN + (size_t)(r - 2) * D, wu + FF + c, NUP, D, lane, true) : 0.f;
            const float* wc = a.in[14] + (size_t)l * 3 * FF; const float y = wc[c] * g2 + wc[FF + c] * g1 + wc[2 * FF + c] * g0 + a.in[15][l * FF + c];
            const float e = 0.5f * y * (1.f + erff(y * 0.70710678f)) * u;
            if (lane == 0) dbg_fail(ctl, 7, bf2f(ACT[(size_t)r * FF + c]), e, 0.03f, 0.02f); }
    } else if (which == 8) {
        const int cs[5] = {0, 1, 17, 300, 2047};
        for (int ri = 0; ri < 8; ++ri) for (int ci = 0; ci < 5; ++ci) if (lane == 0) STASH[ri * 8 + ci] = a.out[(size_t)rows8[ri] * D + cs[ci]];
    } else if (which == 9) {
        const int cs[5] = {0, 1, 17, 300, 2047};
        for (int ri = 0; ri < 8; ++ri) for (int ci = 0; ci < 5; ++ci) { const int r = rows8[ri], c = cs[ci], b = r / T;
            const float d = dbg_dot(ACT + (size_t)r * FF, a.in[16] + (size_t)l * FF * D + c, D, FF, lane, true);
            if (lane == 0) { dbg_fail(ctl, 9, a.out[(size_t)r * D + c], STASH[ri * 8 + ci] + MOD[(size_t)(l * 16 + b) * NMOD + 5 * D + c] * d, 0.01f, 0.01f); STASH[256 + ri * 8 + ci] = a.out[(size_t)r * D + c]; } }
    }
}
__global__ void dbg_emit(Args a, int lo_bit) {
    gu32* ctl = (gu32*)(a.ws + WS_CTL); unsigned mask = 0;
    for (int i = 0; i < 6; ++i) if (ctl[CW_DBG + lo_bit + i]) mask |= 1u << i;
    if (threadIdx.x == 0 && blockIdx.x == 0) a.out[0] += 10.f + (float)mask;
}
#endif

#ifndef MK_PER_PHASE
#define MK_PER_PHASE 0
#endif
#ifndef DUP_MASK
#define DUP_MASK 0
#endif
#ifndef DOWN_WGM
#define DOWN_WGM 4
#endif
#ifndef WO_WGM
#define WO_WGM 4
#endif
#ifndef PROJ_WGM
#define PROJ_WGM 8
#endif
#ifndef UP_WGM
#define UP_WGM 8
#endif
#ifndef UP_DELAY_TICKS
#define UP_DELAY_TICKS 0
#endif
constexpr int N_PHASES = 18;
constexpr int GLA_UNITS = 64, ATT_UNITS = 2048, MIX_UNITS = GLA_UNITS + ATT_UNITS;

__global__ void __launch_bounds__(NWAVES * 64, 2) fwd_kernel(Args a_unused) {
    extern __shared__ __attribute__((aligned(16))) unsigned char lds_raw[];
    LAS unsigned char* lds = (LAS unsigned char*)lds_raw;
#ifdef DBG_STAMP
    unsigned st_sel = 0u, st_all = 0u; unsigned st_t = (unsigned)__builtin_amdgcn_s_memrealtime();
#define STAMP(cat) do { const unsigned n_ = (unsigned)__builtin_amdgcn_s_memrealtime(); if ((cat) == (DBG_STAMP & 3)) st_sel += n_ - st_t; st_all += n_ - st_t; st_t = n_; } while (0)
#else
#define STAMP(cat) do { } while (0)
#endif
#define TIDS() int tid = threadIdx.x; asm volatile("" : "+v"(tid)); const int lane = tid & 63, wave = __builtin_amdgcn_readfirstlane(tid >> 6); (void)lane; (void)wave
#define G_ ((int)gridDim.x)
#define BX_ ((int)blockIdx.x)
#define VCU_ ((G_ % 8 == 0) ? (BX_ % 8) * (G_ / 8) + BX_ / 8 : BX_)
#define GW_ (VCU_ * NWAVES + wave)
#define NGW_ (G_ * NWAVES)
#define MISC_ ((volatile LAS unsigned*)(lds + LDSCTL_OFF))
#ifdef DBG_BARSPREAD
    if (threadIdx.x == 0) __hip_atomic_store((gu32*)(ARGS()->ws + WS_CTL) + 131072 + 20 * 256 + blockIdx.x, (unsigned)__builtin_amdgcn_s_memrealtime(), RLX_AGENT);
#endif
    for (int u = threadIdx.x; u < (LDS_BYTES - LDSCTL_OFF) / 4; u += NWAVES * 64) ((LAS unsigned*)(lds + LDSCTL_OFF))[u] = 0u;
    __syncthreads();
#if !MK_PER_PHASE
    { CArgs* A = ARGS(); (void)xcd_barrier_post((unsigned*)((gu32*)(A->ws + WS_CTL) + CW_BAR), MISC_ + 8); }
#ifdef DBG_BARSPREAD
#define GRID_BAR() do { CArgs* A_ = ARGS(); if (threadIdx.x == 0) { volatile LAS unsigned* bi_ = MISC_ + 24; const unsigned k_ = *bi_; *bi_ = k_ + 1u; __hip_atomic_store((gu32*)(A_->ws + WS_CTL) + 131072 + k_ * 256 + blockIdx.x, (unsigned)__builtin_amdgcn_s_memrealtime(), RLX_AGENT); } \
        XcdBarrier b_; b_.bar = (unsigned*)((gu32*)(A_->ws + WS_CTL) + CW_BAR); b_.x = xb_xcc_id(); b_.st = MISC_ + 8; xcd_barrier(b_); } while (0)
#else
#define GRID_BAR() do { CArgs* A_ = ARGS(); XcdBarrier b_; b_.bar = (unsigned*)((gu32*)(A_->ws + WS_CTL) + CW_BAR); b_.x = xb_xcc_id(); b_.st = MISC_ + 8; xcd_barrier(b_); if (DUP_MASK & 256) xcd_barrier(b_); } while (0)
#endif
#define IN(k) true
#else
#define GRID_BAR() do { } while (0)
    const int lo = ARGS()->ph_lo, hi = ARGS()->ph_hi;
#define IN(k) (lo <= (k) && (k) < hi)
#endif
#ifdef ONLY_OFF
#define INL(o) ((o) == ONLY_OFF && IN(pb + (o)))
#else
#define INL(o) IN(pb + (o))
#endif

    if (IN(0)) { TIDS(); for (int rep = 0; rep < ((DUP_MASK & 128) ? 2 : 1); ++rep) { p0_prologue(ARGS(), lds, tid, lane, wave, VCU_, G_); GRID_BAR(); } STAMP(3); }

    for (int l = 0; l < 2; ++l) {
        const int pb = 1 + 8 * l;
        if (INL(0)) { TIDS(); CArgs* A = ARGS(); unsigned char* ws = A->ws;
            if (l == 0) norm_phase(A->in[0], A->in[4] + l * D, (const float*)(ws + WS_MOD) + (size_t)l * 16 * NMOD, 0, 1, (bf16*)(ws + WS_HN), GW_, NGW_, lane);
            else norm_phase_b((const bf16*)(ws + WS_XB), A->in[4] + l * D, (const float*)(ws + WS_MOD) + (size_t)l * 16 * NMOD, 0, 1, (bf16*)(ws + WS_HN), GW_, NGW_, lane); GRID_BAR(); STAMP(2); }
        if (INL(1)) { TIDS(); CArgs* A = ARGS(); unsigned char* ws = A->ws;
            pg8::Gemm g{(const bf16*)(ws + WS_HN), (const bf16*)(ws + WS_WIN) + (size_t)l * NP * D, M, NP, D}; pg8::StaticOrderT<PROJ_WGM> S; S.init(M, NP, G_, BX_);
#ifdef PROJ_DELAY_TICKS
            if (BX_ & 1) { const unsigned long long t0 = __builtin_amdgcn_s_memrealtime(); while (__builtin_amdgcn_s_memrealtime() - t0 < (unsigned long long)PROJ_DELAY_TICKS) __builtin_amdgcn_s_sleep(8); }
#endif
            pg8::EpiProj E{(bf16*)(ws + WS_PROJ), A->in[9] + l * 512, (float*)(ws + WS_NRM)};
#if DUP_MASK & 64
            { pg8::EpiNull EN; pg8::gemm_phase<pg8::EpiNull, pg8::StaticOrderT<PROJ_WGM>, true, true>(lds + RING_OFF, g, S, EN); }
#endif
            for (int rep = 0; rep < ((DUP_MASK & 2) ? 2 : 1); ++rep) pg8::gemm_phase<pg8::EpiProj, pg8::StaticOrderT<PROJ_WGM>, true, true>(lds + RING_OFF, g, S, E);
            GRID_BAR();
            STAMP(0);
        }
        if (INL(2)) { TIDS(); CArgs* A = ARGS(); unsigned char* ws = A->ws;
            const bf16* PROJ = (const bf16*)(ws + WS_PROJ); bf16* CAT = (bf16*)(ws + WS_HN); gu32* ctl = (gu32*)(ws + WS_CTL);
            const float lam = ((const float*)(ws + WS_SCAL))[l], subscale = 1.f - (l == 0 ? 0.2f : 0.35550906759096926f);
            volatile LAS unsigned* qslot = MISC_ + 16;
            gu32* qbase = ctl + CW_QUEUE + 1024 * l;
            constexpr unsigned QN = 8u + 256u;
#define MIX_CLAIM(v_) do { unsigned v__ = (v_), xq__ = qslot[1], tr__ = qslot[2]; while (v__ >= QN && tr__ < 7u) { xq__ = (xq__ + 1u) & 7u; ++tr__; v__ = __hip_atomic_fetch_add(qbase + 64 * xq__, 1u, RLX_AGENT); } \
        qslot[0] = v__; qslot[1] = xq__; qslot[2] = tr__; } while (0)
            if (tid == 0) { const unsigned x0 = xb_xcc_id() & 7u; qslot[1] = x0; qslot[2] = 0u; MIX_CLAIM(__hip_atomic_fetch_add(qbase + 64 * x0, 1u, RLX_AGENT)); }
            __syncthreads();
            unsigned u = qslot[0], xq = qslot[1];
            __syncthreads();
            while (u < QN) {
                unsigned nxt = 0u;
                gu32* qctr = qbase + 64 * xq;
                if (u < 8u) {
#ifdef DBG_STAMP
                    const unsigned long long tg0_ = __builtin_amdgcn_s_memrealtime();
#endif
#ifdef GLA_DUP
                    { unsigned dummy_ = 0u; gla_unit(PROJ, CAT, (int)(xq + 8u * (u >> 2)), (int)(u & 3u), A->in[10] + l * 256, lds + RING_OFF, tid, qctr + 33, dummy_); }
#endif
                    gla_unit(PROJ, CAT, (int)(xq + 8u * (u >> 2)), (int)(u & 3u), A->in[10] + l * 256, lds + RING_OFF, tid, qctr, nxt);
#ifdef DBG_STAMP
                    if (u == 0u && tid == 0) __hip_atomic_fetch_max(ctl + 40000, (unsigned)(__builtin_amdgcn_s_memrealtime() - tg0_), RLX_AGENT);
#endif
                } else {
                    const int j = (int)u - 8, grp = j >> 4, qb = 15 - (j & 15);
                    attn_unit(PROJ, (const float*)(ws + WS_NRM), CAT, (int)xq + 8 * (grp & 1), 7 - (grp >> 1), qb, lam, subscale, A->in[7] + l * 128, lds + RING_OFF, tid, qctr, nxt);
                }
                if (tid == 0) MIX_CLAIM(nxt);
                __syncthreads();
                u = qslot[0]; xq = qslot[1];
                __syncthreads();
            }
#undef MIX_CLAIM
            GRID_BAR();
            STAMP(1);
        }
        if (INL(3)) { TIDS(); CArgs* A = ARGS(); unsigned char* ws = A->ws;
            pg8::Gemm g{(const bf16*)(ws + WS_HN), (const bf16*)(ws + WS_WO) + (size_t)l * D * D, M, D, D}; pg8::StaticOrderT<WO_WGM> S; S.init(M, D, G_, BX_);
            const float* gt = (const float*)(ws + WS_MOD) + (size_t)l * 16 * NMOD + 2 * D;
            if (l == 0) { pg8::EpiResB<true> E{A->in[0], (bf16*)(ws + WS_XB), gt}; pg8::gemm_phase<pg8::EpiResB<true>, pg8::StaticOrderT<WO_WGM>, true, true>(lds + RING_OFF, g, S, E); }
            else { pg8::EpiResB<false> E{(const void*)(ws + WS_XB), (bf16*)(ws + WS_XB), gt}; pg8::gemm_phase<pg8::EpiResB<false>, pg8::StaticOrderT<WO_WGM>, true, true>(lds + RING_OFF, g, S, E); }
            GRID_BAR();
            STAMP(0);
        }
        if (INL(4)) { TIDS(); CArgs* A = ARGS(); unsigned char* ws = A->ws;
            norm_phase_b((const bf16*)(ws + WS_XB), A->in[12] + l * D, (const float*)(ws + WS_MOD) + (size_t)l * 16 * NMOD, 3, 4, (bf16*)(ws + WS_HN), GW_, NGW_, lane); GRID_BAR(); STAMP(2); }
        if (INL(5)) { TIDS(); CArgs* A = ARGS(); unsigned char* ws = A->ws;
            pg8::Gemm g{(const bf16*)(ws + WS_HN), (const bf16*)(ws + WS_WUP) + (size_t)l * NUP * D, M, NUP, D}; pg8::StaticOrderT<UP_WGM> S; S.init(M, NUP, G_, BX_);
            if (UP_DELAY_TICKS && (BX_ & 1)) { const unsigned long long t0 = __builtin_amdgcn_s_memrealtime(); while (__builtin_amdgcn_s_memrealtime() - t0 < (unsigned long long)UP_DELAY_TICKS) __builtin_amdgcn_s_sleep(8); }
            pg8::EpiUp E{(bf16*)(ws + WS_PROJ), A->in[14] + (size_t)l * 3 * FF, A->in[15] + l * FF, (float*)(ws + WS_HALO), (float*)(ws + WS_HALO + HALO_ONE), (float*)(ws + WS_HALO + 2 * HALO_ONE), (LAS float*)(lds + BND_OFF)};
#if DUP_MASK & 1024
            { pg8::EpiNull EN; pg8::gemm_phase<pg8::EpiNull, pg8::StaticOrderT<UP_WGM>, true, true>(lds + RING_OFF, g, S, EN); }
#endif
            for (int rep = 0; rep < ((DUP_MASK & 16) ? 2 : 1); ++rep) pg8::gemm_phase<pg8::EpiUp, pg8::StaticOrderT<UP_WGM>, true, true>(lds + RING_OFF, g, S, E);
            GRID_BAR();
            STAMP(0);
        }
        if (INL(6)) { TIDS(); CArgs* A = ARGS(); unsigned char* ws = A->ws;
            fixup_phase((const float*)(ws + WS_HALO), (const float*)(ws + WS_HALO + HALO_ONE), (const float*)(ws + WS_HALO + 2 * HALO_ONE), A->in[14] + (size_t)l * 3 * FF, A->in[15] + l * FF, (bf16*)(ws + WS_PROJ), BX_ * (NWAVES * 64) + tid, G_ * NWAVES * 64); GRID_BAR(); STAMP(2); }
        if (INL(7)) { TIDS(); CArgs* A = ARGS(); unsigned char* ws = A->ws;
            pg8::Gemm g{(const bf16*)(ws + WS_PROJ), (const bf16*)(ws + WS_WDN) + (size_t)l * D * FF, M, D, FF}; pg8::StaticOrderT<DOWN_WGM> S; S.init(M, D, G_, BX_);

            pg8::EpiResB<false> E{(const void*)(ws + WS_XB), (bf16*)(ws + WS_XB), (const float*)(ws + WS_MOD) + (size_t)l * 16 * NMOD + 5 * D};
            pg8::gemm_phase<pg8::EpiResB<false>, pg8::StaticOrderT<DOWN_WGM>, true, true>(lds + RING_OFF, g, S, E);
            GRID_BAR();
            STAMP(0);
        }
    }
    if (IN(17)) { TIDS(); CArgs* A = ARGS(); final_norm_phase_b((const bf16*)(A->ws + WS_XB), A->out, A->in[17], GW_, NGW_, lane); }
#ifdef DBG_CNT
    if (blockIdx.x == 0 && threadIdx.x == 0) { asm volatile("s_waitcnt vmcnt(0)" ::: "memory"); unsigned c_ = 0u; for (int x = 0; x < 8; ++x) c_ += __hip_atomic_load((gu32*)(ARGS()->ws + WS_CTL) + CW_QUEUE + 64 * x + 32, RLX_AGENT); ARGS()->out[0] = (float)c_ * 0.001f; }
#endif
#ifdef DBG_BARSPREAD
    GRID_BAR();
    if (blockIdx.x == 0 && threadIdx.x == 0) {
        asm volatile("s_waitcnt vmcnt(0)" ::: "memory");
        const unsigned nb_ = *(MISC_ + 24) - 1u; float s1 = 0.f, s2 = 0.f;
        for (unsigned k = 0; k < nb_; ++k) { if (!((DBG_BARMASK >> k) & 1u)) continue; int mn = 0x7fffffff, mx = -0x7fffffff; float sum = 0.f; const unsigned base_ = __hip_atomic_load((gu32*)(ARGS()->ws + WS_CTL) + 131072 + k * 256, RLX_AGENT);
            for (unsigned c = 0; c < gridDim.x; ++c) { const int d = (int)(__hip_atomic_load((gu32*)(ARGS()->ws + WS_CTL) + 131072 + k * 256 + c, RLX_AGENT) - base_); mn = d < mn ? d : mn; mx = d > mx ? d : mx; sum += (float)d; }
            s1 += (float)(mx - mn); s2 += (float)mx - sum / (float)gridDim.x; }
        float s3 = 0.f;
        for (unsigned k = 1; k < nb_; ++k) { if (!((DBG_BARMASK >> k) & 1u)) continue; const unsigned base_ = __hip_atomic_load((gu32*)(ARGS()->ws + WS_CTL) + 131072 + k * 256, RLX_AGENT); int mx = -0x7fffffff, mp = -0x7fffffff;
            for (unsigned c = 0; c < gridDim.x; ++c) { const int d = (int)(__hip_atomic_load((gu32*)(ARGS()->ws + WS_CTL) + 131072 + k * 256 + c, RLX_AGENT) - base_), e = (int)(__hip_atomic_load((gu32*)(ARGS()->ws + WS_CTL) + 131072 + (k - 1) * 256 + c, RLX_AGENT) - base_); mx = d > mx ? d : mx; mp = e > mp ? e : mp; }
            s3 += (float)(mx - mp); }
        if (DBG_BARSPREAD == 4) {
            const unsigned base_ = __hip_atomic_load((gu32*)(ARGS()->ws + WS_CTL) + 131072, RLX_AGENT); int mx = -0x7fffffff, mn = 0x7fffffff;
            for (unsigned c = 0; c < gridDim.x; ++c) { const int d = (int)(__hip_atomic_load((gu32*)(ARGS()->ws + WS_CTL) + 131072 + c, RLX_AGENT) - base_), e = (int)(__hip_atomic_load((gu32*)(ARGS()->ws + WS_CTL) + 131072 + 20 * 256 + c, RLX_AGENT) - base_); mx = d > mx ? d : mx; mn = e < mn ? e : mn; }
            s3 = (float)(mx - mn); }
        if (DBG_BARSPREAD == 5) {
            const unsigned base_ = __hip_atomic_load((gu32*)(ARGS()->ws + WS_CTL) + 131072 + nb_ * 256, RLX_AGENT); int mx = -0x7fffffff, mp = -0x7fffffff;
            for (unsigned c = 0; c < gridDim.x; ++c) { const int d = (int)(__hip_atomic_load((gu32*)(ARGS()->ws + WS_CTL) + 131072 + nb_ * 256 + c, RLX_AGENT) - base_), e = (int)(__hip_atomic_load((gu32*)(ARGS()->ws + WS_CTL) + 131072 + (nb_ - 1) * 256 + c, RLX_AGENT) - base_); mx = d > mx ? d : mx; mp = e > mp ? e : mp; }
            s3 = (float)(mx - mp); }
#ifndef DBG_BAROFF
#define DBG_BAROFF 0.f
#endif
        ARGS()->out[0] = 10.f + floorf((((DBG_BARSPREAD == 1) ? s1 : (DBG_BARSPREAD == 2) ? s2 : s3) - DBG_BAROFF) * DBG_BARSCALE + 0.5f);
    }
#endif
#ifdef DBG_STAMP
    STAMP(2);
    if (blockIdx.x == 0 && threadIdx.x == 0) { asm volatile("s_waitcnt vmcnt(0)" ::: "memory"); ARGS()->out[0] = (DBG_STAMP == 7) ? __uint_as_float(__hip_atomic_load((gu32*)(ARGS()->ws + WS_CTL) + CW_QUEUE + 7, RLX_AGENT)) : (DBG_STAMP == 8) ? floorf((float)__hip_atomic_load((gu32*)(ARGS()->ws + WS_CTL) + 40000, RLX_AGENT) * DBG_STAMP_SCALE + 0.5f) : floorf((float)(DBG_STAMP == 9 ? st_all : st_sel) * DBG_STAMP_SCALE + 0.5f); }
#endif
#undef IN
#undef INL
#undef GRID_BAR
}

extern "C" void kernel_launch(void* const* d_in, const int* in_sizes, int n_in, void* d_out, int out_size, void* d_ws, size_t ws_size, hipStream_t stream) {
    static int grid = 0;
    if (grid == 0) {
        if (n_in != 18 || in_sizes[0] != M * D || out_size != M * D || ws_size < WS_END) { fprintf(stderr, "kernel_launch: unexpected shapes / workspace (%d inputs, ws %zu); nothing launched\n", n_in, ws_size); grid = -1; return; }
        int dev = 0, cus = 0, per_cu = 0;
        if (hipGetDevice(&dev) != hipSuccess || hipDeviceGetAttribute(&cus, hipDeviceAttributeMultiprocessorCount, dev) != hipSuccess) { grid = -1; return; }
        if (hipFuncSetAttribute((const void*)fwd_kernel, hipFuncAttributeMaxDynamicSharedMemorySize, LDS_BYTES) != hipSuccess) { fprintf(stderr, "kernel_launch: hipFuncSetAttribute failed\n"); grid = -1; return; }
        if (hipOccupancyMaxActiveBlocksPerMultiprocessor(&per_cu, (const void*)fwd_kernel, NWAVES * 64, LDS_BYTES) != hipSuccess || per_cu < 1) { fprintf(stderr, "kernel_launch: occupancy query reports %d\n", per_cu); }
        (void)hipGetLastError();
        grid = cus;
    }
    if (grid < 0) return;
    if (hipMemsetAsync((char*)d_ws + WS_CTL, 0, WS_SCAL, stream) != hipSuccess) return;
    Args a{};
    for (int i = 0; i < 18; ++i) a.in[i] = (const float*)d_in[i];
    a.out = (float*)d_out; a.ws = (unsigned char*)d_ws;
#if MK_PER_PHASE
    for (int p = 0; p < N_PHASES; ++p) { a.ph_lo = p; a.ph_hi = p + 1; hipLaunchKernelGGL(fwd_kernel, dim3(grid), dim3(NWAVES * 64), LDS_BYTES, stream, a);
#ifdef DBG_CHECK
#define DBGK(w) hipLaunchKernelGGL(dbg_kernel, dim3(1), dim3(64), 0, stream, a, (w), DBG_LAYER)
        const int pb = 1 + 8 * DBG_LAYER;
        if (p == 0) { DBGK(0); DBGK(10); }
        if (p == pb + 0) DBGK(1);
        if (p == pb + 1) { DBGK(2); DBGK(3); }
        if (p == pb + 2) { DBGK(4); DBGK(5); }
        if (p == pb + 3) { DBGK(6); DBGK(8); }
        if (p == pb + 6) DBGK(7);
        if (p == pb + 7) DBGK(9);
        if (p == N_PHASES - 1) hipLaunchKernelGGL(dbg_emit, dim3(1), dim3(64), 0, stream, a, DBG_LO);
#endif
    }
#else
    a.ph_lo = 0; a.ph_hi = N_PHASES;
    hipLaunchKernelGGL(fwd_kernel, dim3(grid), dim3(NWAVES * 64), LDS_BYTES, stream, a);
#endif
}
```
